# Optimizing an MI355X kernel written in HIP

```python
import math
import jax, jax.numpy as jnp
from jax import lax
import numpy as np

D_MODEL = 2048
BATCH = 4
SEQ = 2048
DEPTH = 1
DEC_BATCH = 128
DEC_SEQ = 4
PAST_LEN = 16384
PAGE_SIZE = 128

D_MIX = D_MODEL
D_SSM = D_MIX // 2
D_RWKV = D_MIX - D_SSM
SSM_GROUP = 16
N_SSM_GROUPS = D_SSM // SSM_GROUP
SSM_STATE = 64
RWKV_HEAD = 64
N_RWKV_HEADS = D_RWKV // RWKV_HEAD
W_RANK = 64
A_RANK = 64
G_RANK = 128
D_SHIFT = 3 * D_RWKV + W_RANK + A_RANK + G_RANK
D_IN = D_SSM + D_SHIFT
N_MEM = 256
MEM_HEADS = 4
MEM_HEAD_DIM = D_MODEL // MEM_HEADS
D_FF = ((8 * D_MODEL + 3 * 256 - 1) // (3 * 256)) * 256
ALPHA = (2 * DEPTH) ** 0.25
BETA = (8 * DEPTH) ** -0.25
LN_EPS = 1e-5
GN_EPS = 64e-5

kernel_name = 'hymba_s5_rwkv7_memxattn_step'


def _layer_norm(x, g, b, eps=LN_EPS):
    xf = x.astype(jnp.float32)
    mean = jnp.mean(xf, axis=-1, keepdims=True)
    var = jnp.mean(jnp.square(xf - mean), axis=-1, keepdims=True)
    return ((xf - mean) * lax.rsqrt(var + eps) * g + b).astype(x.dtype)


def _s5_mixer(u, s0_re, s0_im, a_re, a_im, b_re, b_im, c_re, c_im, d, log_dt, w_glu, b_glu):
    bsz, t, _ = u.shape
    f32 = jnp.float32
    uf = u.astype(f32).reshape(bsz, t, N_SSM_GROUPS, SSM_GROUP)
    lam = lax.complex(a_re.astype(f32), a_im.astype(f32))
    dt = jnp.exp(log_dt.astype(f32))[:, None]
    lam_bar = jnp.exp(lam * dt)
    b_bar = ((lam_bar - 1.0) / lam)[..., None] * lax.complex(b_re.astype(f32), b_im.astype(f32))
    bu = jnp.einsum('gph,btgh->btgp', b_bar, uf.astype(jnp.complex64))
    s0 = lax.complex(s0_re.astype(f32), s0_im.astype(f32))
    bu = bu.at[:, 0].add(lam_bar * s0)
    a_seq = jnp.broadcast_to(lam_bar, bu.shape)

    def combine(left, right):
        a_l, b_l = left
        a_r, b_r = right
        return a_l * a_r, a_r * b_l + b_r

    _, states = lax.associative_scan(combine, (a_seq, bu), axis=1)
    c = lax.complex(c_re.astype(f32), c_im.astype(f32))
    y = jnp.einsum('ghp,btgp->btgh', c, states).real + d.astype(f32).reshape(N_SSM_GROUPS, SSM_GROUP) * uf
    y = jax.nn.gelu(y.reshape(bsz, t, D_SSM))
    z = y * jax.nn.sigmoid(y @ w_glu.astype(f32) + b_glu.astype(f32))
    s_last = states[:, -1]
    return z.astype(u.dtype), jnp.real(s_last), jnp.imag(s_last)


def _rwkv7_mixer(p, shift0, s0, mu, w0, w2, a0, a2, g2, k_k, k_a, r_k, lnx_g, lnx_b):
    bsz, t, _ = p.shape
    f32 = jnp.float32
    pf = p.astype(f32)
    prev = jnp.concatenate([shift0.astype(f32)[:, None], pf[:, :-1]], axis=1)
    ps = pf + (prev - pf) * mu
    i1, i2, i3 = D_RWKV, 2 * D_RWKV, 3 * D_RWKV
    i4, i5 = i3 + W_RANK, i3 + W_RANK + A_RANK
    r, k, v = ps[..., :i1], ps[..., i1:i2], ps[..., i2:i3]
    pw, pa, pg = ps[..., i3:i4], ps[..., i4:i5], ps[..., i5:]
    w_log = -jax.nn.softplus(-(w0 + jnp.tanh(pw) @ w2)) - 0.5
    decay = jnp.exp(-jnp.exp(w_log))
    a = jax.nn.sigmoid(a0 + pa @ a2)
    g = jax.nn.sigmoid(pg) @ g2

    def heads(z):
        return z.reshape(bsz, t, N_RWKV_HEADS, RWKV_HEAD)

    kk = heads(k * k_k)
    kk = kk * lax.rsqrt(jnp.maximum(jnp.sum(jnp.square(kk), axis=-1, keepdims=True), 1e-24))
    k = k * (1.0 + (a - 1.0) * k_a)
    r_h, k_h, v_h, w_h, a_h = heads(r), heads(k), heads(v), heads(decay), heads(a)

    def step(S, inp):
        r_t, w_t, k_t, v_t, kk_t, a_t = inp
        sa = jnp.einsum('bhvk,bhk->bhv', S, -kk_t)
        S = S * w_t[:, :, None, :] + sa[..., None] * (kk_t * a_t)[:, :, None, :] + v_t[..., None] * k_t[:, :, None, :]
        return S, jnp.einsum('bhvk,bhk->bhv', S, r_t)

    seq = tuple(jnp.moveaxis(z, 1, 0) for z in (r_h, w_h, k_h, v_h, kk, a_h))
    s_last, y = lax.scan(step, s0.astype(f32), seq)
    y = jnp.moveaxis(y, 0, 1)
    mean = jnp.mean(y, axis=-1, keepdims=True)
    var = jnp.mean(jnp.square(y - mean), axis=-1, keepdims=True)
    yn = ((y - mean) * lax.rsqrt(var + GN_EPS)).reshape(bsz, t, D_RWKV) * lnx_g + lnx_b
    bonus = (jnp.sum(r_h * k_h * r_k, axis=-1, keepdims=True) * v_h).reshape(bsz, t, D_RWKV)
    o = (yn + bonus) * g
    return o.astype(p.dtype), pf[:, -1], s_last


def _mem_kv(mem, w_k, w_v):
    bsz = mem.shape[0]
    k = (mem @ w_k).reshape(bsz, N_MEM, MEM_HEADS, MEM_HEAD_DIM)
    v = (mem @ w_v).reshape(bsz, N_MEM, MEM_HEADS, MEM_HEAD_DIM)
    return k, v


def _mem_attend(x, k, v, w_q, w_o):
    bsz, t, _ = x.shape
    q = (x @ w_q).reshape(bsz, t, MEM_HEADS, MEM_HEAD_DIM)
    s = jnp.einsum('bthd,bmhd->bhtm', q, k).astype(jnp.float32) * (MEM_HEAD_DIM ** -0.5)
    pr = jax.nn.softmax(s, axis=-1).astype(x.dtype)
    o = jnp.einsum('bhtm,bmhd->bthd', pr, v).reshape(bsz, t, D_MODEL)
    return o @ w_o


def _layer(x, mem_k, mem_v, ssm_re0, ssm_im0, wkv0, shift0, lp):
    h = x @ lp['w_in']
    z_ssm, ssm_re, ssm_im = _s5_mixer(h[..., :D_SSM], ssm_re0, ssm_im0, lp['ssm_a_re'], lp['ssm_a_im'],
                                      lp['ssm_b_re'], lp['ssm_b_im'], lp['ssm_c_re'], lp['ssm_c_im'],
                                      lp['ssm_d'], lp['ssm_log_dt'], lp['w_glu'], lp['b_glu'])
    o_rwkv, shift, wkv = _rwkv7_mixer(h[..., D_SSM:], shift0, wkv0, lp['rwkv_mu'], lp['rwkv_w0'], lp['rwkv_w2'],
                                      lp['rwkv_a0'], lp['rwkv_a2'], lp['rwkv_g2'], lp['rwkv_k_k'], lp['rwkv_k_a'],
                                      lp['rwkv_r_k'], lp['rwkv_lnx_g'], lp['rwkv_lnx_b'])
    mix = jnp.concatenate([z_ssm, o_rwkv], axis=-1) @ lp['w_out']
    x = _layer_norm(ALPHA * x + mix, lp['ln1_g'], lp['ln1_b'])
    x = _layer_norm(ALPHA * x + _mem_attend(x, mem_k, mem_v, lp['wq_mem'], lp['wo_mem']), lp['ln2_g'], lp['ln2_b'])
    ff = (jax.nn.silu(x @ lp['w_gate']) * (x @ lp['w_up'])) @ lp['w_down']
    x = _layer_norm(ALPHA * x + ff, lp['ln3_g'], lp['ln3_b'])
    return x, ssm_re, ssm_im, wkv, shift


def setup_inputs(seed: int = 0) -> dict:
    key = jax.random.key(seed)
    keys = iter(jax.random.split(key, 64))
    f32 = jnp.float32

    def nrm(shape, scale=1.0):
        return scale * jax.random.normal(next(keys), shape, f32)

    def unif(shape, lo, hi):
        return jax.random.uniform(next(keys), shape, f32, lo, hi)

    L, G, P, HG = DEPTH, N_SSM_GROUPS, SSM_STATE, SSM_GROUP
    H, N = N_RWKV_HEADS, RWKV_HEAD
    n_idx = jnp.arange(P, dtype=f32)
    return {
        'x_prompt': nrm((BATCH, SEQ, D_MODEL)),
        'x_sample': nrm((DEC_BATCH, DEC_SEQ, D_MODEL)),
        'mem_prompt': nrm((BATCH, N_MEM, D_MODEL)),
        'state_ssm_re': nrm((L, DEC_BATCH, G, P), 0.1),
        'state_ssm_im': nrm((L, DEC_BATCH, G, P), 0.1),
        'state_wkv': nrm((L, DEC_BATCH, H, N, N), 0.5),
        'state_shift': nrm((L, DEC_BATCH, D_SHIFT)),
        'cache_mem_k': nrm((L, DEC_BATCH, N_MEM, MEM_HEADS, MEM_HEAD_DIM)),
        'cache_mem_v': nrm((L, DEC_BATCH, N_MEM, MEM_HEADS, MEM_HEAD_DIM)),
        'w_in': nrm((L, D_MODEL, D_IN), D_MODEL ** -0.5),
        'ssm_a_re': -0.5 + nrm((L, G, P), 0.01),
        'ssm_a_im': math.pi * n_idx + nrm((L, G, P), 0.01),
        'ssm_b_re': nrm((L, G, P, HG), (2 * HG) ** -0.5),
        'ssm_b_im': nrm((L, G, P, HG), (2 * HG) ** -0.5),
        'ssm_c_re': nrm((L, G, HG, P), P ** -0.5),
        'ssm_c_im': nrm((L, G, HG, P), P ** -0.5),
        'ssm_d': nrm((L, D_SSM)),
        'ssm_log_dt': unif((L, G), math.log(1e-3), math.log(1e-1)),
        'w_glu': nrm((L, D_SSM, D_SSM), D_SSM ** -0.5),
        'b_glu': nrm((L, D_SSM), 0.01),
        'rwkv_mu': unif((L, D_SHIFT), 0.0, 1.0),
        'rwkv_w0': unif((L, D_RWKV), -6.0, -1.0),
        'rwkv_w2': nrm((L, W_RANK, D_RWKV), 0.1),
        'rwkv_a0': nrm((L, D_RWKV), 0.1),
        'rwkv_a2': nrm((L, A_RANK, D_RWKV), 0.1),
        'rwkv_g2': nrm((L, G_RANK, D_RWKV), G_RANK ** -0.5),
        'rwkv_k_k': 0.85 + nrm((L, D_RWKV), 0.02),
        'rwkv_k_a': 1.0 + nrm((L, D_RWKV), 0.02),
        'rwkv_r_k': nrm((L, H, N), 0.1),
        'rwkv_lnx_g': 1.0 + nrm((L, D_RWKV), 0.02),
        'rwkv_lnx_b': nrm((L, D_RWKV), 0.01),
        'w_out': nrm((L, D_MIX, D_MODEL), BETA * D_MIX ** -0.5),
        'ln1_g': 1.0 + nrm((L, D_MODEL), 0.02),
        'ln1_b': nrm((L, D_MODEL), 0.01),
        'wq_mem': nrm((L, D_MODEL, D_MODEL), D_MODEL ** -0.5),
        'wk_mem': nrm((L, D_MODEL, D_MODEL), D_MODEL ** -0.5),
        'wv_mem': nrm((L, D_MODEL, D_MODEL), BETA * D_MODEL ** -0.5),
        'wo_mem': nrm((L, D_MODEL, D_MODEL), BETA * D_MODEL ** -0.5),
        'ln2_g': 1.0 + nrm((L, D_MODEL), 0.02),
        'ln2_b': nrm((L, D_MODEL), 0.01),
        'w_gate': nrm((L, D_MODEL, D_FF), D_MODEL ** -0.5),
        'w_up': nrm((L, D_MODEL, D_FF), D_MODEL ** -0.5),
        'w_down': nrm((L, D_FF, D_MODEL), BETA * D_FF ** -0.5),
        'ln3_g': 1.0 + nrm((L, D_MODEL), 0.02),
        'ln3_b': nrm((L, D_MODEL), 0.01),
    }


def reference(x_prompt, x_sample, mem_prompt, state_ssm_re, state_ssm_im, state_wkv, state_shift,
              cache_mem_k, cache_mem_v, w_in, ssm_a_re, ssm_a_im, ssm_b_re, ssm_b_im, ssm_c_re, ssm_c_im,
              ssm_d, ssm_log_dt, w_glu, b_glu, rwkv_mu, rwkv_w0, rwkv_w2, rwkv_a0, rwkv_a2, rwkv_g2,
              rwkv_k_k, rwkv_k_a, rwkv_r_k, rwkv_lnx_g, rwkv_lnx_b, w_out, ln1_g, ln1_b,
              wq_mem, wk_mem, wv_mem, wo_mem, ln2_g, ln2_b, w_gate, w_up, w_down, ln3_g, ln3_b):
    f32 = jnp.float32
    bp = x_prompt.shape[0]
    y_prompt, y_sample = x_prompt, x_sample
    p_re, p_im, p_wkv, p_shift, p_mk, p_mv = [], [], [], [], [], []
    s_re, s_im, s_wkv, s_shift = [], [], [], []
    for i in range(DEPTH):
        lp = {
            'w_in': w_in[i], 'ssm_a_re': ssm_a_re[i], 'ssm_a_im': ssm_a_im[i],
            'ssm_b_re': ssm_b_re[i], 'ssm_b_im': ssm_b_im[i], 'ssm_c_re': ssm_c_re[i], 'ssm_c_im': ssm_c_im[i],
            'ssm_d': ssm_d[i], 'ssm_log_dt': ssm_log_dt[i], 'w_glu': w_glu[i], 'b_glu': b_glu[i],
            'rwkv_mu': rwkv_mu[i], 'rwkv_w0': rwkv_w0[i], 'rwkv_w2': rwkv_w2[i], 'rwkv_a0': rwkv_a0[i],
            'rwkv_a2': rwkv_a2[i], 'rwkv_g2': rwkv_g2[i], 'rwkv_k_k': rwkv_k_k[i], 'rwkv_k_a': rwkv_k_a[i],
            'rwkv_r_k': rwkv_r_k[i], 'rwkv_lnx_g': rwkv_lnx_g[i], 'rwkv_lnx_b': rwkv_lnx_b[i],
            'w_out': w_out[i], 'ln1_g': ln1_g[i], 'ln1_b': ln1_b[i],
            'wq_mem': wq_mem[i], 'wo_mem': wo_mem[i], 'ln2_g': ln2_g[i], 'ln2_b': ln2_b[i],
            'w_gate': w_gate[i], 'w_up': w_up[i], 'w_down': w_down[i], 'ln3_g': ln3_g[i], 'ln3_b': ln3_b[i],
        }
        mk, mv = _mem_kv(mem_prompt, wk_mem[i], wv_mem[i])
        y_prompt, a_re, a_im, wkv, shift = _layer(
            y_prompt, mk, mv,
            jnp.zeros((bp, N_SSM_GROUPS, SSM_STATE), f32), jnp.zeros((bp, N_SSM_GROUPS, SSM_STATE), f32),
            jnp.zeros((bp, N_RWKV_HEADS, RWKV_HEAD, RWKV_HEAD), f32), jnp.zeros((bp, D_SHIFT), f32), lp)
        p_re.append(a_re); p_im.append(a_im); p_wkv.append(wkv); p_shift.append(shift)
        p_mk.append(mk); p_mv.append(mv)
        y_sample, b_re, b_im, wkv_s, shift_s = _layer(
            y_sample, cache_mem_k[i], cache_mem_v[i], state_ssm_re[i], state_ssm_im[i],
            state_wkv[i], state_shift[i], lp)
        s_re.append(b_re); s_im.append(b_im); s_wkv.append(wkv_s); s_shift.append(shift_s)
    new_ssm_re_prompt = jnp.stack(p_re)
    new_ssm_im_prompt = jnp.stack(p_im)
    new_wkv_prompt = jnp.stack(p_wkv)
    new_shift_prompt = jnp.stack(p_shift)
    new_mem_k_prompt = jnp.stack(p_mk)
    new_mem_v_prompt = jnp.stack(p_mv)
    new_ssm_re_sample = jnp.stack(s_re)
    new_ssm_im_sample = jnp.stack(s_im)
    new_wkv_sample = jnp.stack(s_wkv)
    new_shift_sample = jnp.stack(s_shift)
    return (y_prompt, y_sample, new_ssm_re_prompt, new_ssm_im_prompt, new_wkv_prompt, new_shift_prompt,
            new_mem_k_prompt, new_mem_v_prompt, new_ssm_re_sample, new_ssm_im_sample, new_wkv_sample,
            new_shift_sample)
```

```cpp
#include <hip/hip_runtime.h>
#include <hip/hip_cooperative_groups.h>
#include <cstdio>
#include <cstdint>
namespace cg = cooperative_groups;
#define MK_COOP 0
namespace pg8 {
#define PG8_LAS __attribute__((address_space(3)))
typedef unsigned short bf16_t;
typedef short bf16x8 __attribute__((ext_vector_type(8)));
typedef float f32x4 __attribute__((ext_vector_type(4)));
typedef unsigned u32x4 __attribute__((ext_vector_type(4)));
constexpr int BM = 256, BK = 64, HALF = 128, HTB = HALF * BK * 2  , STAGE_BYTES = 8 * HTB, NXCD = 8, WGM = 8;

__host__ __device__ __forceinline__ int lds_byte(int r, int c) { const int st = (r >> 4) * 2 + (c >> 5), rr = r & 15, cc = c & 31, ob = rr * 64 + cc * 2; return st * 1024 + (ob ^ (((ob >> 9) & 1) << 5)); }
__host__ __device__ __forceinline__ void stage_rc(int b, int& R, int& C) { const int st = b / 1024, sb = b % 1024, swz = sb ^ (((sb >> 9) & 1) << 5); R = (st >> 1) * 16 + swz / 64; C = (st & 1) * 32 + (swz % 64) / 2; }
__host__ __device__ __forceinline__ int perm32(int rho) { const int n = rho >> 4, i = rho & 15; return 8 * (i >> 2) + 4 * n + (i & 3); }

struct Unit { int pm, pn; };
struct Gemm { const bf16_t* A; const bf16_t* Bt; int M, N, K; };

struct StaticOrder {
    int nM, nN, nwg, G, c;
    __host__ __device__ void init(int M, int N, int G_, int c_) { nM = M / BM; nN = N / BM; nwg = nM * nN; G = G_; c = c_; }
    __host__ __device__ bool next(int i, Unit& u) const {
        const long L = (long)i * G + c; if (L >= nwg) return false;
        int wgid = (int)L; { const int q = nwg / NXCD, r = nwg % NXCD, xcd = wgid % NXCD, off = wgid / NXCD; wgid = (xcd < r ? xcd * (q + 1) : r * (q + 1) + (xcd - r) * q) + off; }
        const int nig = WGM * nN, gid = wgid / nig, fm = gid * WGM, gsz = (nM - fm) < WGM ? (nM - fm) : WGM;
        u.pm = fm + ((wgid % nig) % gsz); u.pn = (wgid % nig) / gsz; return true;
    }
    __device__ __forceinline__ void a_ready(const Unit&) const {}
    __device__ __forceinline__ void done(const Unit&) const {}
};
typedef float f32x2_cv __attribute__((ext_vector_type(2))); typedef __bf16 bf16x2_cv __attribute__((ext_vector_type(2)));
__device__ __forceinline__ unsigned cvt_pk_bf16(float lo, float hi) { const f32x2_cv v = {lo, hi}; const bf16x2_cv b = __builtin_convertvector(v, bf16x2_cv); return __builtin_bit_cast(unsigned, b); }

__device__ __forceinline__ float bf_lo(unsigned w) { return __builtin_bit_cast(float, w << 16); }
__device__ __forceinline__ float bf_hi(unsigned w) { return __builtin_bit_cast(float, w & 0xffff0000u); }
__device__ __forceinline__ u32x4 pack8(const f32x4 a, const f32x4 b) { u32x4 w; w.x = cvt_pk_bf16(a[0], a[1]); w.y = cvt_pk_bf16(a[2], a[3]); w.z = cvt_pk_bf16(b[0], b[1]); w.w = cvt_pk_bf16(b[2], b[3]); return w; }
__device__ __forceinline__ float sigmoidf_(float x) { return 1.0f / (1.0f + __expf(-x)); }

struct EpiF32 {
    static constexpr bool PERM = true, AFTER_DRAIN = false;
    float* O; int ldc;
    __device__ __forceinline__ void operator()(const f32x4 (&acc)[2][2][4][2], const Unit& u, int wr, int wc, int fr, int fq) const {
        const int row0 = u.pm * BM + wr * 64 + fr, col0 = u.pn * BM + wc * 32 + 8 * fq;
#pragma unroll
        for (int ai = 0; ai < 2; ++ai)
#pragma unroll
            for (int m = 0; m < 4; ++m) { float* rowp = O + (size_t)(row0 + ai * HALF + m * 16) * ldc + col0;
#pragma unroll
                for (int bj = 0; bj < 2; ++bj) { *(f32x4*)(rowp + bj * HALF) = acc[ai][bj][m][0]; *(f32x4*)(rowp + bj * HALF + 4) = acc[ai][bj][m][1]; } }
    }
};
struct EpiMemKV {
    static constexpr bool PERM = true, AFTER_DRAIN = false;
    float* outK; float* outV; bf16_t* Kb;
    __device__ __forceinline__ void operator()(const f32x4 (&acc)[2][2][4][2], const Unit& u, int wr, int wc, int fr, int fq) const {
        const int row0 = u.pm * BM + wr * 64 + fr; const int colt = u.pn * BM; const bool isV = colt >= 2048;
        float* o = isV ? outV : outK; const int col0 = (isV ? colt - 2048 : colt) + wc * 32 + 8 * fq;
#pragma unroll
        for (int ai = 0; ai < 2; ++ai)
#pragma unroll
            for (int m = 0; m < 4; ++m)
#pragma unroll
                for (int bj = 0; bj < 2; ++bj) { const size_t off = (size_t)(row0 + ai * HALF + m * 16) * 2048 + col0 + bj * HALF;
                    *(f32x4*)(o + off) = acc[ai][bj][m][0]; *(f32x4*)(o + off + 4) = acc[ai][bj][m][1];
                    if (!isV) *(u32x4*)(Kb + off) = pack8(acc[ai][bj][m][0], acc[ai][bj][m][1]); }
    }
};
struct EpiBf16S {
    static constexpr bool PERM = true, AFTER_DRAIN = false;
    bf16_t* O; int ldc;
    __device__ __forceinline__ void operator()(const f32x4 (&acc)[2][2][4][2], const Unit& u, int wr, int wc, int fr, int fq) const {
        const int row0 = u.pm * BM + wr * 64 + fr, col0 = u.pn * BM + wc * 32 + 8 * fq;
#pragma unroll
        for (int ai = 0; ai < 2; ++ai)
#pragma unroll
            for (int m = 0; m < 4; ++m) { bf16_t* rowp = O + (size_t)(row0 + ai * HALF + m * 16) * ldc + col0;
#pragma unroll
                for (int bj = 0; bj < 2; ++bj) *(u32x4*)(rowp + bj * HALF) = pack8(acc[ai][bj][m][0], acc[ai][bj][m][1]); }
    }
};
struct EpiGlu {
    static constexpr bool PERM = true, AFTER_DRAIN = false;
    const bf16_t* Y; int ldy; const float* bias; bf16_t* O; int ldo;
    __device__ __forceinline__ void operator()(const f32x4 (&acc)[2][2][4][2], const Unit& u, int wr, int wc, int fr, int fq) const {
        const int row0 = u.pm * BM + wr * 64 + fr, col0 = u.pn * BM + wc * 32 + 8 * fq;
#pragma unroll
        for (int bj = 0; bj < 2; ++bj) { const f32x4 b0 = *(const f32x4*)(bias + col0 + bj * HALF), b1 = *(const f32x4*)(bias + col0 + bj * HALF + 4);
#pragma unroll
            for (int ai = 0; ai < 2; ++ai)
#pragma unroll
                for (int m = 0; m < 4; ++m) { const int row = row0 + ai * HALF + m * 16;
                    const u32x4 yv = *(const u32x4*)(Y + (size_t)row * ldy + col0 + bj * HALF);
                    const f32x4 a0 = acc[ai][bj][m][0] + b0, a1 = acc[ai][bj][m][1] + b1; f32x4 z0, z1;
                    z0[0] = bf_lo(yv.x) * sigmoidf_(a0[0]); z0[1] = bf_hi(yv.x) * sigmoidf_(a0[1]); z0[2] = bf_lo(yv.y) * sigmoidf_(a0[2]); z0[3] = bf_hi(yv.y) * sigmoidf_(a0[3]);
                    z1[0] = bf_lo(yv.z) * sigmoidf_(a1[0]); z1[1] = bf_hi(yv.z) * sigmoidf_(a1[1]); z1[2] = bf_lo(yv.w) * sigmoidf_(a1[2]); z1[3] = bf_hi(yv.w) * sigmoidf_(a1[3]);
                    *(u32x4*)(O + (size_t)row * ldo + col0 + bj * HALF) = pack8(z0, z1); } }
    }
};
struct EpiRes {
    static constexpr bool PERM = true, AFTER_DRAIN = false;
    const float* base0; const float* base1; float* O; int ld; float alpha;
    __device__ __forceinline__ void operator()(const f32x4 (&acc)[2][2][4][2], const Unit& u, int wr, int wc, int fr, int fq) const {
        const int row0 = u.pm * BM + wr * 64 + fr, col0 = u.pn * BM + wc * 32 + 8 * fq;
        const bool lo = (u.pm * BM) < 8192; const float* bp = lo ? base0 : base1; const int rsub = lo ? 0 : 8192;
#pragma unroll
        for (int ai = 0; ai < 2; ++ai)
#pragma unroll
            for (int m = 0; m < 4; ++m) { const int row = row0 + ai * HALF + m * 16; const float* brow = bp + (size_t)(row - rsub) * ld + col0; float* orow = O + (size_t)row * ld + col0;
#pragma unroll
                for (int bj = 0; bj < 2; ++bj) { const f32x4 x0 = *(const f32x4*)(brow + bj * HALF), x1 = *(const f32x4*)(brow + bj * HALF + 4);
                    *(f32x4*)(orow + bj * HALF) = x0 * alpha + acc[ai][bj][m][0]; *(f32x4*)(orow + bj * HALF + 4) = x1 * alpha + acc[ai][bj][m][1]; } }
    }
};
struct EpiSwiGLU {
    static constexpr bool PERM = true, AFTER_DRAIN = false;
    bf16_t* O; int ldo;
    __device__ __forceinline__ void operator()(const f32x4 (&acc)[2][2][4][2], const Unit& u, int wr, int wc, int fr, int fq) const {
        const int row0 = u.pm * BM + wr * 64 + fr, col0 = u.pn * HALF + wc * 32 + 8 * fq;
#pragma unroll
        for (int ai = 0; ai < 2; ++ai)
#pragma unroll
            for (int m = 0; m < 4; ++m) { f32x4 h0, h1;
#pragma unroll
                for (int j = 0; j < 4; ++j) { const float g0 = acc[ai][0][m][0][j], g1 = acc[ai][0][m][1][j];
                    h0[j] = g0 * sigmoidf_(g0) * acc[ai][1][m][0][j]; h1[j] = g1 * sigmoidf_(g1) * acc[ai][1][m][1][j]; }
                *(u32x4*)(O + (size_t)(row0 + ai * HALF + m * 16) * ldo + col0) = pack8(h0, h1); }
    }
};

template <class Epi, class Sched, bool ALIGN_EPI = false, bool SP2 = false>
__device__ __forceinline__ void gemm_phase(PG8_LAS unsigned char* lds, const Gemm g, const Sched& S, const Epi& E) {
    const int tid = threadIdx.x, wid = __builtin_amdgcn_readfirstlane(tid >> 6), lane = tid & 63, wr = wid >> 2, wc = wid & 3, fr = lane & 15, fq = lane >> 4;
    const int K = g.K, nt = K / BK;
    unsigned voffA[2], voffB[2];
#pragma unroll
    for (int i = 0; i < 2; ++i) { int R, C; stage_rc(tid * 16 + i * 8192, R, C); const int Rb = Epi::PERM ? ((R & ~31) + perm32(R & 31)) : R;
        voffA[i] = (unsigned)(R * K + C) * 2u; voffB[i] = (unsigned)(Rb * K + C) * 2u; }
    const size_t kstep = (size_t)(BK * 2);
    const size_t hstep = (size_t)HALF * K * 2;
    const size_t tstep = 2 * hstep;
    const unsigned ldsw = (unsigned)wid * 1024u;
    const int aoff = lds_byte(wr * 64 + fr, fq * 8), boff = lds_byte(wc * 32 + fr, fq * 8);
#define PG8_SA(b, h) (((b) * 2 + (h)) * HTB)
#define PG8_SB(b, h) ((4 + (b) * 2 + (h)) * HTB)
#define PG8_STAGE(bufoff, gbase, voff) do { _Pragma("unroll") for (int _i = 0; _i < 2; ++_i) \
        __builtin_amdgcn_global_load_lds((const unsigned*)((const char*)(gbase) + (voff)[_i]), (PG8_LAS unsigned*)(lds + (bufoff) + ldsw + _i * 8192), 16, 0, 0); } while (0)
#define PG8_LDA(dst, b, h) do { _Pragma("unroll") for (int m = 0; m < 4; ++m) _Pragma("unroll") for (int k = 0; k < 2; ++k) dst[m][k] = *(const PG8_LAS bf16x8*)(lds + PG8_SA(b, h) + aoff + m * 2048 + k * 1024); } while (0)
#define PG8_LDB(dst, b, h) do { _Pragma("unroll") for (int n = 0; n < 2; ++n) _Pragma("unroll") for (int k = 0; k < 2; ++k) dst[n][k] = *(const PG8_LAS bf16x8*)(lds + PG8_SB(b, h) + boff + n * 2048 + k * 1024); } while (0)
#define PG8_MMA(ai, bj, At, Bt) do { __builtin_amdgcn_s_setprio(1); _Pragma("unroll") for (int m = 0; m < 4; ++m) _Pragma("unroll") for (int n = 0; n < 2; ++n) _Pragma("unroll") for (int k = 0; k < 2; ++k) \
        acc[ai][bj][m][n] = __builtin_amdgcn_mfma_f32_16x16x32_bf16(Bt[n][k], At[m][k], acc[ai][bj][m][n], 0, 0, 0); __builtin_amdgcn_s_setprio(0); } while (0)
#define PG8_WAIT_V(n) asm volatile("s_waitcnt vmcnt(" #n ")" ::: "memory")
#define PG8_WAIT_L(n) asm volatile("s_waitcnt lgkmcnt(" #n ")" ::: "memory")
#define PG8_BAR __builtin_amdgcn_s_barrier()
#define PG8_SCHED __builtin_amdgcn_sched_barrier(0)
    Unit cur, nxt; int ui = 0;
    if (!S.next(0, cur)) return;
    f32x4 acc[2][2][4][2];
#pragma unroll
    for (int a = 0; a < 2; ++a)
#pragma unroll
        for (int b = 0; b < 2; ++b)
#pragma unroll
            for (int m = 0; m < 4; ++m)
#pragma unroll
                for (int n = 0; n < 2; ++n) acc[a][b][m][n] = (f32x4){0.f, 0.f, 0.f, 0.f};
    bf16x8 At[4][2], B0[2][2], B1[2][2];
    const char* cA = (const char*)g.A + (size_t)cur.pm * tstep; const char* cB = (const char*)g.Bt + (size_t)cur.pn * tstep;
    S.a_ready(cur);
    if constexpr (SP2) {
        PG8_STAGE(PG8_SB(0, 0), cB, voffB); PG8_STAGE(PG8_SB(0, 1), cB + hstep, voffB); PG8_STAGE(PG8_SA(0, 0), cA, voffA); PG8_STAGE(PG8_SA(0, 1), cA + hstep, voffA);
        if (wr == 1) PG8_BAR;
        PG8_WAIT_V(2); PG8_BAR;
        PG8_STAGE(PG8_SB(1, 0), cB + kstep, voffB); PG8_STAGE(PG8_SA(1, 0), cA + kstep, voffA); PG8_STAGE(PG8_SB(1, 1), cB + hstep + kstep, voffB);
        PG8_WAIT_V(6); PG8_BAR;
    } else {
        PG8_STAGE(PG8_SB(0, 0), cB, voffB); PG8_STAGE(PG8_SA(0, 0), cA, voffA); PG8_STAGE(PG8_SB(0, 1), cB + hstep, voffB); PG8_STAGE(PG8_SA(0, 1), cA + hstep, voffA);
        if (wr == 1) PG8_BAR;
        PG8_WAIT_V(4); PG8_BAR;
        PG8_STAGE(PG8_SB(1, 0), cB + kstep, voffB); PG8_STAGE(PG8_SA(1, 0), cA + kstep, voffA); PG8_STAGE(PG8_SB(1, 1), cB + hstep + kstep, voffB);
        PG8_WAIT_V(6); PG8_BAR;
    }
    for (;;) {
        const bool has_next = S.next(ui + 1, nxt);
        const char* nA = has_next ? (const char*)g.A + (size_t)nxt.pm * tstep : cA; const char* nB = has_next ? (const char*)g.Bt + (size_t)nxt.pn * tstep : cB;
        for (int t = 0; t < nt; t += 2) {
            const bool last = (t == nt - 2);
            const char* a1 = cA + (size_t)(t + 1) * kstep;
            const char* a2 = last ? nA : cA + (size_t)(t + 2) * kstep; const char* b2 = last ? nB : cB + (size_t)(t + 2) * kstep;
            const char* a3 = a2 + kstep; const char* b3 = b2 + kstep;
            if (last && has_next) S.a_ready(nxt);
            if constexpr (SP2) {
            PG8_LDB(B0, 0, 0); PG8_LDB(B1, 0, 1); PG8_SCHED; PG8_LDA(At, 0, 0); PG8_STAGE(PG8_SA(1, 1), a1 + hstep, voffA);
            PG8_WAIT_V(8); PG8_WAIT_L(0); PG8_BAR; PG8_MMA(0, 0, At, B0); PG8_MMA(0, 1, At, B1); PG8_BAR; PG8_SCHED;
            PG8_LDA(At, 0, 1); PG8_STAGE(PG8_SB(0, 0), b2, voffB); PG8_STAGE(PG8_SB(0, 1), b2 + hstep, voffB); PG8_STAGE(PG8_SA(0, 0), a2, voffA);
            PG8_WAIT_V(8); PG8_WAIT_L(0); PG8_BAR; PG8_MMA(1, 0, At, B0); PG8_MMA(1, 1, At, B1); PG8_BAR; PG8_SCHED;
            PG8_LDB(B0, 1, 0); PG8_LDB(B1, 1, 1); PG8_SCHED; PG8_LDA(At, 1, 0); PG8_STAGE(PG8_SA(0, 1), a2 + hstep, voffA);
            PG8_WAIT_V(8); PG8_WAIT_L(0); PG8_BAR; PG8_MMA(0, 0, At, B0); PG8_MMA(0, 1, At, B1); PG8_BAR; PG8_SCHED;
            PG8_LDA(At, 1, 1); PG8_STAGE(PG8_SB(1, 0), b3, voffB); PG8_STAGE(PG8_SB(1, 1), b3 + hstep, voffB); PG8_STAGE(PG8_SA(1, 0), a3, voffA);
            PG8_WAIT_V(8); PG8_WAIT_L(0); PG8_BAR; PG8_MMA(1, 0, At, B0); PG8_MMA(1, 1, At, B1); PG8_BAR; PG8_SCHED;
            } else {
            PG8_LDB(B0, 0, 0); PG8_SCHED; PG8_LDA(At, 0, 0); PG8_STAGE(PG8_SA(1, 1), a1 + hstep, voffA);
            PG8_WAIT_L(8); PG8_BAR; PG8_WAIT_L(0); PG8_MMA(0, 0, At, B0); PG8_BAR; PG8_SCHED;
            PG8_LDB(B1, 0, 1); PG8_STAGE(PG8_SB(0, 0), b2, voffB);
            PG8_BAR; PG8_WAIT_L(0); PG8_MMA(0, 1, At, B1); PG8_BAR;
            PG8_LDA(At, 0, 1); PG8_STAGE(PG8_SA(0, 0), a2, voffA);
            PG8_BAR; PG8_WAIT_L(0); PG8_MMA(1, 0, At, B0); PG8_BAR; PG8_SCHED;
            PG8_STAGE(PG8_SB(0, 1), b2 + hstep, voffB);
            PG8_WAIT_V(6); PG8_BAR; PG8_MMA(1, 1, At, B1); PG8_BAR;
            PG8_LDB(B0, 1, 0); PG8_SCHED; PG8_LDA(At, 1, 0); PG8_STAGE(PG8_SA(0, 1), a2 + hstep, voffA);
            PG8_WAIT_L(8); PG8_BAR; PG8_WAIT_L(0); PG8_MMA(0, 0, At, B0); PG8_BAR; PG8_SCHED;
            PG8_LDB(B1, 1, 1); PG8_STAGE(PG8_SB(1, 0), b3, voffB);
            PG8_BAR; PG8_WAIT_L(0); PG8_MMA(0, 1, At, B1); PG8_BAR;
            PG8_LDA(At, 1, 1); PG8_STAGE(PG8_SA(1, 0), a3, voffA);
            PG8_BAR; PG8_WAIT_L(0); PG8_MMA(1, 0, At, B0); PG8_BAR; PG8_SCHED;
            PG8_STAGE(PG8_SB(1, 1), b3 + hstep, voffB);
            PG8_WAIT_V(6); PG8_BAR; PG8_MMA(1, 1, At, B1); PG8_BAR;
            }
        }
        if constexpr (ALIGN_EPI) { if (wr == 0) PG8_BAR; }
        if constexpr (!Epi::AFTER_DRAIN) { E(acc, cur, wr, wc, fr, fq); S.done(cur); }
        if (!has_next) break;
#pragma unroll
        for (int a = 0; a < 2; ++a)
#pragma unroll
            for (int b = 0; b < 2; ++b)
#pragma unroll
                for (int m = 0; m < 4; ++m)
#pragma unroll
                    for (int n = 0; n < 2; ++n) acc[a][b][m][n] = (f32x4){0.f, 0.f, 0.f, 0.f};
        cur = nxt; cA = nA; cB = nB; ++ui;
        if constexpr (ALIGN_EPI) { if (wr == 1) PG8_BAR; }
    }
    PG8_WAIT_V(0);
    if constexpr (!ALIGN_EPI) { if (wr == 0) PG8_BAR; }
    PG8_BAR;
    if constexpr (Epi::AFTER_DRAIN) { E.fused(acc, cur, wr, wc, fr, fq, lds, wid, lane); S.done(cur); }
#undef PG8_SA
#undef PG8_SB
#undef PG8_STAGE
#undef PG8_LDA
#undef PG8_LDB
#undef PG8_MMA
#undef PG8_WAIT_V
#undef PG8_WAIT_L
#undef PG8_BAR
#undef PG8_SCHED
}
}

constexpr int NWAVES = 8, NTHR = 512;
constexpr int MT = 8704, MP = 8192, DM = 2048, DIN = 4352, DSSM = 1024, DRW = 1024, DSH = 3328, DFF = 5632, NMEM = 256;
constexpr float ALPHA = 1.189207115002721f;
constexpr float LN_EPS = 1e-5f, GN_EPS = 64e-5f;
constexpr size_t O_Y = 0, O_SRE_P = (size_t)MT * DM, O_SIM_P = O_SRE_P + 16384, O_WKV_P = O_SIM_P + 16384, O_SH_P = O_WKV_P + 262144, O_MK = O_SH_P + 4 * DSH,
                 O_MV = O_MK + 2097152, O_SRE_S = O_MV + 2097152, O_SIM_S = O_SRE_S + 524288, O_WKV_S = O_SIM_S + 524288, O_SH_S = O_WKV_S + 8388608, O_END = O_SH_S + 128 * DSH;
static_assert(O_END == 32191488, "output size");
constexpr size_t MiB = 1u << 20;
constexpr size_t WS_CTL = 0, WS_WIN = 1 * MiB, WS_WGLU = 18 * MiB, WS_WOUT = 20 * MiB, WS_WQ = 28 * MiB, WS_WKV = 36 * MiB, WS_WO = 52 * MiB, WS_WGU = 60 * MiB, WS_WDN = 104 * MiB,
                 WS_W2T = 126 * MiB, WS_A2T = WS_W2T + 131072, WS_G2T = WS_W2T + 262144, WS_KB = 127 * MiB, WS_VTB = 131 * MiB, WS_XB = 135 * MiB, WS_MB = 169 * MiB,
                 WS_H = 173 * MiB, WS_R = WS_H, WS_X = WS_H + 72 * MiB, WS_PREP = 318 * MiB, WS_BONUS = 556 * MiB, WS_QB = WS_PREP, WS_OB = WS_PREP + 34 * MiB, WS_HFF = WS_PREP + 68 * MiB,
                 WS_YR = 557 * MiB, WS_YGB = 591 * MiB, WS_MIX = 608 * MiB, WS_END = 642 * MiB;
constexpr size_t PREP_STRIDE = 34 * MiB;
constexpr int LDS_BYTES = 135168;
constexpr int MISC_OFF = 131072;
constexpr int NPHASE = 14;

#define LAS __attribute__((address_space(3)))
typedef unsigned short bf16;
typedef unsigned v4u __attribute__((ext_vector_type(4)));
typedef unsigned v2u __attribute__((ext_vector_type(2)));
typedef float f32x4 __attribute__((ext_vector_type(4)));
typedef float f32x2 __attribute__((ext_vector_type(2)));
typedef float f32x16 __attribute__((ext_vector_type(16)));
typedef short bf16x8 __attribute__((ext_vector_type(8)));
#define LDS_WAIT() asm volatile("s_waitcnt lgkmcnt(0)" ::: "memory")

__device__ __forceinline__ unsigned pk2(float lo, float hi) { return pg8::cvt_pk_bf16(lo, hi); }
__device__ __forceinline__ bf16x8 pack_bf8(const f32x4 a, const f32x4 b) { v4u w; w.x = pk2(a[0], a[1]); w.y = pk2(a[2], a[3]); w.z = pk2(b[0], b[1]); w.w = pk2(b[2], b[3]); return __builtin_bit_cast(bf16x8, w); }
__device__ __forceinline__ float wave_sum(float v) {
#pragma unroll
    for (int o = 1; o < 64; o <<= 1) v += __shfl_xor(v, o);
    return v;
}
__device__ __forceinline__ float wave_max(float v) {
#pragma unroll
    for (int o = 1; o < 64; o <<= 1) v = fmaxf(v, __shfl_xor(v, o));
    return v;
}
template <int CTRL> __device__ __forceinline__ float dpp_f(float x) { return __builtin_bit_cast(float, __builtin_amdgcn_update_dpp(0, __builtin_bit_cast(int, x), CTRL, 0xf, 0xf, false)); }
__device__ __forceinline__ float sum16(float x) { x += dpp_f<0xB1>(x); x += dpp_f<0x4E>(x); x += dpp_f<0x141>(x); x += dpp_f<0x140>(x); return x; }
__device__ __forceinline__ float sigm(float x) { return 1.0f / (1.0f + __expf(-x)); }
__device__ __forceinline__ float tanh_(float x) { return 1.0f - 2.0f / (1.0f + __expf(2.0f * x)); }
__device__ __forceinline__ float gelu_tanh(float x) { const float u = 1.5957691216057308f * (x + 0.044715f * x * x * x); return x / (1.0f + __expf(-u)); }
#define MFMA16(a, b, c) __builtin_amdgcn_mfma_f32_16x16x32_bf16((a), (b), (c), 0, 0, 0)
#define MFMA32(a, b, c) __builtin_amdgcn_mfma_f32_32x32x16_bf16((a), (b), (c), 0, 0, 0)

struct Args { const float* in[45]; float* out; unsigned char* ws; int lo, hi; };

struct Frame {
    LAS unsigned char* lds; volatile LAS unsigned* MISC;
    int tid, lane, wave, G, bid;
    const float* const* in; float* out; unsigned char* ws;
};

__device__ __forceinline__ void tr_item(const float* W, int K, int N, bf16* WT, int drow0, int k0, int n0, LAS float* scr, int lane) {
#pragma unroll 8
    for (int i = 0; i < 32; ++i) { const int kk = 2 * i + (lane >> 5); scr[kk * 33 + (lane & 31)] = W[(size_t)(k0 + kk) * N + n0 + (lane & 31)]; }
    LDS_WAIT(); asm volatile("" ::: "memory");
    const int c = lane & 7;
#pragma unroll
    for (int j = 0; j < 4; ++j) { const int n = (lane >> 3) + 8 * j; const LAS float* s = scr + (8 * c) * 33 + n;
        v4u o; o.x = pk2(s[0 * 33], s[1 * 33]); o.y = pk2(s[2 * 33], s[3 * 33]); o.z = pk2(s[4 * 33], s[5 * 33]); o.w = pk2(s[6 * 33], s[7 * 33]);
        *(v4u*)(WT + (size_t)(drow0 + n) * K + k0 + 8 * c) = o; }
    LDS_WAIT(); asm volatile("" ::: "memory");
}
__device__ __forceinline__ void p0_prologue(Frame& F) {
    LAS float* scr = (LAS float*)(F.lds + F.wave * 16384);
    const int gw = F.bid * NWAVES + F.wave, NGW = F.G * NWAVES, lane = F.lane;
    unsigned char* ws = F.ws;
#define TR_MAT(Wp, Kk, Nn, Dst, ROWMAP) { const int nblk = (Nn) / 32, cnt = ((Kk) / 64) * nblk; if (r < cnt) { const int kb = r / nblk, n0 = (r % nblk) * 32; \
        tr_item((Wp), (Kk), (Nn), (bf16*)(Dst), (ROWMAP), kb * 64, n0, scr, lane); continue; } r -= cnt; }
    constexpr int NITEMS = 32 * 136 + 16 * 32 + 5 * 32 * 64 + 2 * 32 * 176 + 88 * 64 + 32 + 32 + 64;
    for (int it = gw; it < NITEMS; it += NGW) {
        int r = it;
        TR_MAT(F.in[9], DM, DIN, ws + WS_WIN, n0)
        TR_MAT(F.in[18], DSSM, DSSM, ws + WS_WGLU, n0)
        TR_MAT(F.in[31], DM, DM, ws + WS_WOUT, n0)
        TR_MAT(F.in[34], DM, DM, ws + WS_WQ, n0)
        TR_MAT(F.in[35], DM, DM, ws + WS_WKV, n0)
        TR_MAT(F.in[36], DM, DM, ws + WS_WKV, 2048 + n0)
        TR_MAT(F.in[37], DM, DM, ws + WS_WO, n0)
        TR_MAT(F.in[40], DM, DFF, ws + WS_WGU, 256 * (n0 / 128) + (n0 % 128))
        TR_MAT(F.in[41], DM, DFF, ws + WS_WGU, 256 * (n0 / 128) + 128 + (n0 % 128))
        TR_MAT(F.in[42], DFF, DM, ws + WS_WDN, n0)
        TR_MAT(F.in[22], 64, DRW, ws + WS_W2T, n0)
        TR_MAT(F.in[24], 64, DRW, ws + WS_A2T, n0)
        TR_MAT(F.in[25], 128, DRW, ws + WS_G2T, n0)
    }
#undef TR_MAT
    const size_t gt = (size_t)F.bid * NTHR + F.tid, NGT = (size_t)F.G * NTHR;
    { const f32x4* xp = (const f32x4*)F.in[0]; const f32x4* xs = (const f32x4*)F.in[1]; v4u* xb = (v4u*)(ws + WS_XB);
      const size_t np = (size_t)MP * DM / 8, nt = (size_t)MT * DM / 8;
      for (size_t i = gt; i < nt; i += NGT) { const f32x4* s = i < np ? xp + 2 * i : xs + 2 * (i - np); const f32x4 a = s[0], b = s[1]; xb[i] = pg8::pack8(a, b); } }
    { const f32x4* mp = (const f32x4*)F.in[2]; v4u* mb = (v4u*)(ws + WS_MB); const size_t nm = (size_t)1024 * DM / 8;
      for (size_t i = gt; i < nm; i += NGT) { const f32x4 a = mp[2 * i], b = mp[2 * i + 1]; mb[i] = pg8::pack8(a, b); } }
}

__device__ __forceinline__ void p2_prep(Frame& F) {
    const float* H = (const float*)(F.ws + WS_H);
    const float* mu = F.in[20]; const float* w0 = F.in[21]; const float* a0 = F.in[23]; const float* k_k = F.in[26]; const float* k_a = F.in[27]; const float* r_k = F.in[28];
    const bf16* W2T = (const bf16*)(F.ws + WS_W2T); const bf16* A2T = (const bf16*)(F.ws + WS_A2T); const bf16* G2T = (const bf16*)(F.ws + WS_G2T);
    float* PR = (float*)(F.ws + WS_PREP); constexpr size_t PS = PREP_STRIDE / 4;
    float* BON = (float*)(F.ws + WS_BONUS);
    const int lane = F.lane, fr = lane & 15, fq = lane >> 4;
    for (int tile = F.bid; tile < MT / 16; tile += F.G) {
        const int m = tile * 16 + fr;
        const float* prow = H + (size_t)m * DIN + 1024;
        const bool prompt = m < MP; const int t = prompt ? (m & 2047) : ((m - MP) & 3);
        const float* qrow = prow - DIN; float qs = 1.0f;
        if (t == 0) { if (prompt) { qrow = prow; qs = 0.0f; } else qrow = F.in[6] + (size_t)((m - MP) >> 2) * DSH; }
#define PS4(col) ({ const f32x4 p_ = *(const f32x4*)(prow + (col)); const f32x4 q_ = *(const f32x4*)(qrow + (col)) * qs; const f32x4 m_ = *(const f32x4*)(mu + (col)); p_ + (q_ - p_) * m_; })
        bf16x8 bw[2], ba[2], bg[4];
#pragma unroll
        for (int kc = 0; kc < 2; ++kc) { f32x4 x0 = PS4(3072 + 32 * kc + 8 * fq), x1 = PS4(3072 + 32 * kc + 8 * fq + 4);
#pragma unroll
            for (int j = 0; j < 4; ++j) { x0[j] = tanh_(x0[j]); x1[j] = tanh_(x1[j]); }
            bw[kc] = pack_bf8(x0, x1);
            const f32x4 y0 = PS4(3136 + 32 * kc + 8 * fq), y1 = PS4(3136 + 32 * kc + 8 * fq + 4); ba[kc] = pack_bf8(y0, y1); }
#pragma unroll
        for (int kc = 0; kc < 4; ++kc) { f32x4 x0 = PS4(3200 + 32 * kc + 8 * fq), x1 = PS4(3200 + 32 * kc + 8 * fq + 4);
#pragma unroll
            for (int j = 0; j < 4; ++j) { x0[j] = sigm(x0[j]); x1[j] = sigm(x1[j]); }
            bg[kc] = pack_bf8(x0, x1); }
#pragma unroll 1
        for (int hi = 0; hi < 2; ++hi) {
            const int hd = 2 * F.wave + hi;
            f32x4 accW[4], accA[4], accG[4];
#pragma unroll
            for (int ct = 0; ct < 4; ++ct) { const int c = 64 * hd + 16 * ct + fr;
                accW[ct] = (f32x4){0.f, 0.f, 0.f, 0.f}; accA[ct] = accW[ct]; accG[ct] = accW[ct];
#pragma unroll
                for (int kc = 0; kc < 2; ++kc) { accW[ct] = MFMA16(*(const bf16x8*)(W2T + c * 64 + 32 * kc + 8 * fq), bw[kc], accW[ct]);
                                                  accA[ct] = MFMA16(*(const bf16x8*)(A2T + c * 64 + 32 * kc + 8 * fq), ba[kc], accA[ct]); }
#pragma unroll
                for (int kc = 0; kc < 4; ++kc) accG[ct] = MFMA16(*(const bf16x8*)(G2T + c * 128 + 32 * kc + 8 * fq), bg[kc], accG[ct]); }
            f32x4 av[4], kkr[4]; float ss = 0.f, bon = 0.f;
#pragma unroll
            for (int ct = 0; ct < 4; ++ct) { const int col = 64 * hd + 16 * ct + 4 * fq; const size_t o = (size_t)m * 1024 + col;
                const f32x4 r4 = PS4(col), k4 = PS4(1024 + col), v4 = PS4(2048 + col);
                const f32x4 w04 = *(const f32x4*)(w0 + col), a04 = *(const f32x4*)(a0 + col), kk4 = *(const f32x4*)(k_k + col), ka4 = *(const f32x4*)(k_a + col), rk4 = *(const f32x4*)(r_k + col);
                f32x4 dec, a, km;
#pragma unroll
                for (int j = 0; j < 4; ++j) { const float z = -(w04[j] + accW[ct][j]); const float sp = fmaxf(z, 0.f) + log1pf(__expf(-fabsf(z))); const float wl = -sp - 0.5f;
                    dec[j] = __expf(-__expf(wl)); a[j] = sigm(a04[j] + accA[ct][j]); km[j] = k4[j] * (1.0f + (a[j] - 1.0f) * ka4[j]);
                    const float kr = k4[j] * kk4[j]; kkr[ct][j] = kr; ss += kr * kr; bon += r4[j] * km[j] * rk4[j]; }
                av[ct] = a;
                *(f32x4*)(PR + 0 * PS + o) = r4; *(f32x4*)(PR + 1 * PS + o) = dec; *(f32x4*)(PR + 2 * PS + o) = km; *(f32x4*)(PR + 3 * PS + o) = v4; *(f32x4*)(PR + 6 * PS + o) = accG[ct]; }
            ss += __shfl_xor(ss, 16); ss += __shfl_xor(ss, 32); bon += __shfl_xor(bon, 16); bon += __shfl_xor(bon, 32);
            const float inv = rsqrtf(fmaxf(ss, 1e-24f));
#pragma unroll
            for (int ct = 0; ct < 4; ++ct) { const size_t o = (size_t)m * 1024 + 64 * hd + 16 * ct + 4 * fq; const f32x4 kk = kkr[ct] * inv;
                *(f32x4*)(PR + 4 * PS + o) = kk; *(f32x4*)(PR + 5 * PS + o) = kk * av[ct]; }
            if (fq == 0) BON[(size_t)m * 16 + hd] = bon;
        }
#undef PS4
    }
    { const int gt = F.bid * NTHR + F.tid, NGT = F.G * NTHR;
      for (int i = gt; i < 132 * (DSH / 4); i += NGT) { const int s = i / (DSH / 4), c4 = i % (DSH / 4);
          const int m = s < 4 ? s * 2048 + 2047 : MP + 4 * (s - 4) + 3;
          float* o = s < 4 ? F.out + O_SH_P + (size_t)s * DSH : F.out + O_SH_S + (size_t)(s - 4) * DSH;
          *(f32x4*)(o + 4 * c4) = *(const f32x4*)(H + (size_t)m * DIN + 1024 + 4 * c4); } }
}

__device__ __forceinline__ void rwkv_scan(Frame& F, int m0, int T, int h, int half, const float* s_in, float* s_out) {
    const float* PR = (const float*)(F.ws + WS_PREP); constexpr size_t PS = PREP_STRIDE / 4;
    float* YR = (float*)(F.ws + WS_YR);
    const int tid = F.tid, lane = F.lane, rr = lane >> 4, kq = lane & 15, v = 32 * half + 4 * F.wave + rr;
    LAS float* buf = (LAS float*)F.lds;
    f32x4 S = (f32x4){0.f, 0.f, 0.f, 0.f};
    if (s_in) S = *(const f32x4*)(s_in + v * 64 + 4 * kq);
    const int nchunk = (T + 31) >> 5, step_l = tid >> 4, part = tid & 15;
    f32x4 st[6];
#pragma unroll
    for (int q = 0; q < 6; ++q) st[q] = (f32x4){0.f, 0.f, 0.f, 0.f};
#define RW_GLOAD(c) do { const int t_ = (c) * 32 + step_l; if (t_ < T) { const size_t off_ = (size_t)(m0 + t_) * 1024 + h * 64 + 4 * part; \
        st[0] = *(const f32x4*)(PR + 1 * PS + off_); st[1] = *(const f32x4*)(PR + 4 * PS + off_); st[2] = *(const f32x4*)(PR + 5 * PS + off_); \
        st[3] = *(const f32x4*)(PR + 2 * PS + off_); st[4] = *(const f32x4*)(PR + 0 * PS + off_); st[5] = *(const f32x4*)(PR + 3 * PS + off_); } } while (0)
#define RW_LSTORE(b) do { LAS float* d_ = buf + (b) * 12288 + step_l * 384 + 4 * part; _Pragma("unroll") for (int q = 0; q < 6; ++q) *(LAS f32x4*)(d_ + q * 64) = st[q]; } while (0)
    RW_GLOAD(0); RW_LSTORE(0); __syncthreads();
    for (int c = 0; c < nchunk; ++c) {
        const int cur = c & 1;
        if (c + 1 < nchunk) RW_GLOAD(c + 1);
        const int nst = (T - 32 * c) < 32 ? (T - 32 * c) : 32;
        const LAS float* cb = buf + cur * 12288;
#pragma unroll 4
        for (int s = 0; s < nst; ++s) {
            const LAS float* sb = cb + s * 384;
            const f32x4 w4 = *(const LAS f32x4*)(sb + 4 * kq), kk4 = *(const LAS f32x4*)(sb + 64 + 4 * kq), b4 = *(const LAS f32x4*)(sb + 128 + 4 * kq),
                        k4 = *(const LAS f32x4*)(sb + 192 + 4 * kq), r4 = *(const LAS f32x4*)(sb + 256 + 4 * kq);
            const float vv = sb[320 + v];
            float sa = -((S[0] * kk4[0] + S[1] * kk4[1]) + (S[2] * kk4[2] + S[3] * kk4[3]));
            sa = sum16(sa);
            S = S * w4 + (b4 * sa + k4 * vv);
            float y = (S[0] * r4[0] + S[1] * r4[1]) + (S[2] * r4[2] + S[3] * r4[3]);
            y = sum16(y);
            if (kq == 0) YR[(size_t)(m0 + 32 * c + s) * 1024 + h * 64 + v] = y;
        }
        if (c + 1 < nchunk) RW_LSTORE(cur ^ 1);
        __syncthreads();
    }
#undef RW_GLOAD
#undef RW_LSTORE
    *(f32x4*)(s_out + v * 64 + 4 * kq) = S;
}

template <int SEG> __device__ __forceinline__ void ssm_item(Frame& F, int g, int sel) {
    const float* H = (const float*)(F.ws + WS_H);
    bf16* YG = (bf16*)(F.ws + WS_YGB);
    const int lane = F.lane, n = lane & 31, hh = lane >> 5, fr = lane & 15, fq = lane >> 4;
    LAS bf16* ldsS = (LAS bf16*)(F.lds + F.wave * 8704);
    const float dt = __expf(F.in[17][g]);
    float lr[2], li[2]; bf16x8 Bre[2], Bim[2];
#pragma unroll
    for (int pp = 0; pp < 2; ++pp) { const int p = 2 * n + pp; const float are = F.in[10][g * 64 + p], aim = F.in[11][g * 64 + p];
        const float mag = expf(are * dt), ang = aim * dt; float sn, cs; sincosf(ang, &sn, &cs); lr[pp] = mag * cs; li[pp] = mag * sn;
        const float sh = sinf(0.5f * ang); const float xr = expm1f(are * dt) * cs - 2.0f * sh * sh, xi = mag * sn;
        const float den = 1.0f / (are * are + aim * aim); const float qr = (xr * are + xi * aim) * den, qi = (xi * are - xr * aim) * den;
        const float* brp = F.in[12] + (size_t)(g * 64 + p) * 16 + 8 * hh; const float* bip = F.in[13] + (size_t)(g * 64 + p) * 16 + 8 * hh;
        const f32x4 br0 = *(const f32x4*)brp, br1 = *(const f32x4*)(brp + 4), bi0 = *(const f32x4*)bip, bi1 = *(const f32x4*)(bip + 4);
        Bre[pp] = pack_bf8(br0 * qr - bi0 * qi, br1 * qr - bi1 * qi); Bim[pp] = pack_bf8(bi0 * qr + br0 * qi, bi1 * qr + br1 * qi); }
    bf16x8 Cop[4];
#pragma unroll
    for (int kc = 0; kc < 4; ++kc) { const float* cp = (kc < 2 ? F.in[14] : F.in[15]) + (size_t)(g * 16 + fr) * 64 + 32 * (kc & 1) + 8 * fq; const float sg = kc < 2 ? 1.0f : -1.0f;
        Cop[kc] = pack_bf8(*(const f32x4*)cp * sg, *(const f32x4*)(cp + 4) * sg); }
    const f32x4 d4 = *(const f32x4*)(F.in[16] + 16 * g + 4 * fq);
    float sre[2] = {0.f, 0.f}, sim[2] = {0.f, 0.f};
    const int ntile = SEG == 16 ? 128 : 1;
    const int hr = (n >> 2) & 1, ir = 4 * (n >> 3) + (n & 3);
    for (int tile = 0; tile < ntile; ++tile) {
        const int arow = SEG == 16 ? (2 * sel + hr) * 2048 + tile * 16 + ir : MP + 4 * (8 * sel + 4 * hr + (ir >> 2)) + (ir & 3);
        const float* up = H + (size_t)arow * DIN + 16 * g + 8 * hh;
        const bf16x8 A1 = pack_bf8(*(const f32x4*)up, *(const f32x4*)(up + 4));
        const f32x16 z16 = {0.f, 0.f, 0.f, 0.f, 0.f, 0.f, 0.f, 0.f, 0.f, 0.f, 0.f, 0.f, 0.f, 0.f, 0.f, 0.f};
        f32x16 aRe[2], aIm[2];
#pragma unroll
        for (int pp = 0; pp < 2; ++pp) { aRe[pp] = MFMA32(A1, Bre[pp], z16); aIm[pp] = MFMA32(A1, Bim[pp], z16); }
#pragma unroll
        for (int i = 0; i < 16; ++i) {
            if (SEG == 4 && (i & 3) == 0) { const int batch = 8 * sel + 4 * hh + (i >> 2); const size_t so = (size_t)(batch * 64 + g) * 64 + 2 * n;
                const f32x2 a = *(const f32x2*)(F.in[3] + so), b = *(const f32x2*)(F.in[4] + so); sre[0] = a[0]; sre[1] = a[1]; sim[0] = b[0]; sim[1] = b[1]; }
#pragma unroll
            for (int pp = 0; pp < 2; ++pp) { const float nr = lr[pp] * sre[pp] - li[pp] * sim[pp] + aRe[pp][i], ni = lr[pp] * sim[pp] + li[pp] * sre[pp] + aIm[pp][i]; sre[pp] = nr; sim[pp] = ni; }
            *(LAS unsigned*)(ldsS + (16 * hh + i) * 136 + 2 * n) = pk2(sre[0], sre[1]);
            *(LAS unsigned*)(ldsS + (16 * hh + i) * 136 + 64 + 2 * n) = pk2(sim[0], sim[1]);
            if (SEG == 4 && (i & 3) == 3) { const int batch = 8 * sel + 4 * hh + (i >> 2); const size_t so = (size_t)(batch * 64 + g) * 64 + 2 * n;
                *(f32x2*)(F.out + O_SRE_S + so) = (f32x2){sre[0], sre[1]}; *(f32x2*)(F.out + O_SIM_S + so) = (f32x2){sim[0], sim[1]}; }
        }
        LDS_WAIT(); asm volatile("" ::: "memory");
#pragma unroll
        for (int rg = 0; rg < 2; ++rg) {
            f32x4 aY = (f32x4){0.f, 0.f, 0.f, 0.f};
#pragma unroll
            for (int kc = 0; kc < 4; ++kc) aY = MFMA16(Cop[kc], *(const LAS bf16x8*)(ldsS + (16 * rg + fr) * 136 + 32 * kc + 8 * fq), aY);
            const int orow = SEG == 16 ? (2 * sel + rg) * 2048 + tile * 16 + fr : MP + 4 * (8 * sel + 4 * rg + (fr >> 2)) + (fr & 3);
            const f32x4 u4 = *(const f32x4*)(H + (size_t)orow * DIN + 16 * g + 4 * fq);
            const f32x4 y = aY + d4 * u4;
            v2u w; w.x = pk2(gelu_tanh(y[0]), gelu_tanh(y[1])); w.y = pk2(gelu_tanh(y[2]), gelu_tanh(y[3]));
            *(v2u*)(YG + (size_t)orow * 1024 + 16 * g + 4 * fq) = w;
        }
        LDS_WAIT(); asm volatile("" ::: "memory");
    }
    if (SEG == 16) { const size_t so = (size_t)((2 * sel + hh) * 64 + g) * 64 + 2 * n;
        *(f32x2*)(F.out + O_SRE_P + so) = (f32x2){sre[0], sre[1]}; *(f32x2*)(F.out + O_SIM_P + so) = (f32x2){sim[0], sim[1]}; }
}

__device__ __forceinline__ void p3_scans(Frame& F) {
    unsigned* ctr = (unsigned*)(F.ws + WS_CTL);
    constexpr int N_RP = 128, N_SP = 64, N_RS = 2048, N_SS = 128, TOTAL = N_RP + N_SP + N_RS + N_SS;
    for (;;) {
        __syncthreads();
        if (F.tid == 0) F.MISC[0] = atomicAdd(ctr, 1u);
        __syncthreads();
        int it = (int)F.MISC[0];
        if (it >= TOTAL) break;
        if (it < N_RP) { const int b = it >> 5, h = (it >> 1) & 15, half = it & 1;
            rwkv_scan(F, b * 2048, 2048, h, half, nullptr, F.out + O_WKV_P + (size_t)(b * 16 + h) * 4096); continue; }
        it -= N_RP;
        if (it < N_SP) { if (F.wave < 2) ssm_item<16>(F, it, F.wave); continue; }
        it -= N_SP;
        if (it < N_RS) { const int b = it >> 4, h = it & 15; const size_t so = (size_t)(b * 16 + h) * 4096;
            rwkv_scan(F, MP + 4 * b, 4, h, 0, F.in[5] + so, F.out + O_WKV_S + so);
            rwkv_scan(F, MP + 4 * b, 4, h, 1, F.in[5] + so, F.out + O_WKV_S + so); continue; }
        it -= N_RS;
        { const int wi = it * 8 + F.wave; ssm_item<4>(F, wi >> 4, wi & 15); }
    }
}

__device__ __forceinline__ void p4_post(Frame& F) {
    unsigned* ctr = (unsigned*)(F.ws + WS_CTL) + 64;
    const float* PR = (const float*)(F.ws + WS_PREP); constexpr size_t PS = PREP_STRIDE / 4;
    const float* YR = (const float*)(F.ws + WS_YR); const float* BON = (const float*)(F.ws + WS_BONUS);
    const float* lg = F.in[29]; const float* lb = F.in[30];
    bf16* MIX = (bf16*)(F.ws + WS_MIX);
    const int lane = F.lane;
    for (;;) {
        __syncthreads();
        if (F.tid == 0) F.MISC[0] = atomicAdd(ctr, 1u);
        __syncthreads();
        const int it = (int)F.MISC[0];
        if (it >= MT / 16) break;
#pragma unroll 1
        for (int q = 0; q < 2; ++q) { const int m = it * 16 + 2 * F.wave + q;
#pragma unroll
            for (int j = 0; j < 4; ++j) { const int col = 256 * j + 4 * lane, hd = 4 * j + (lane >> 4); const size_t o = (size_t)m * 1024 + col;
                const f32x4 y = *(const f32x4*)(YR + o);
                const float mean = sum16((y[0] + y[1]) + (y[2] + y[3])) * (1.0f / 64.0f);
                const f32x4 d = y - mean;
                const float var = sum16((d[0] * d[0] + d[1] * d[1]) + (d[2] * d[2] + d[3] * d[3])) * (1.0f / 64.0f);
                const float rstd = rsqrtf(var + GN_EPS), bon = BON[(size_t)m * 16 + hd];
                const f32x4 v4 = *(const f32x4*)(PR + 3 * PS + o), g4 = *(const f32x4*)(PR + 6 * PS + o), lg4 = *(const f32x4*)(lg + col), lb4 = *(const f32x4*)(lb + col);
                const f32x4 ov = (d * rstd * lg4 + lb4 + v4 * bon) * g4;
                v2u w; w.x = pk2(ov[0], ov[1]); w.y = pk2(ov[2], ov[3]);
                *(v2u*)(MIX + (size_t)m * 2048 + 1024 + col) = w; } }
    }
}

__device__ __forceinline__ void ln_rows(Frame& F, const float* src, const float* gam, const float* bet, float* dstf, bf16* dstb) {
    const int gw = F.bid * NWAVES + F.wave, NGW = F.G * NWAVES, lane = F.lane;
    f32x4 gg[8], bb[8];
#pragma unroll
    for (int j = 0; j < 8; ++j) { gg[j] = *(const f32x4*)(gam + 4 * (lane + 64 * j)); bb[j] = *(const f32x4*)(bet + 4 * (lane + 64 * j)); }
    for (int row = gw; row < MT; row += NGW) {
        const f32x4* s = (const f32x4*)(src + (size_t)row * DM) + lane; f32x4 v[8]; float sm = 0.f;
#pragma unroll
        for (int j = 0; j < 8; ++j) { v[j] = s[64 * j]; sm += (v[j][0] + v[j][1]) + (v[j][2] + v[j][3]); }
        const float mean = wave_sum(sm) * (1.0f / DM); float s2 = 0.f;
#pragma unroll
        for (int j = 0; j < 8; ++j) { v[j] = v[j] - mean; s2 += (v[j][0] * v[j][0] + v[j][1] * v[j][1]) + (v[j][2] * v[j][2] + v[j][3] * v[j][3]); }
        const float rstd = rsqrtf(wave_sum(s2) * (1.0f / DM) + LN_EPS);
#pragma unroll
        for (int j = 0; j < 8; ++j) { const f32x4 o = v[j] * rstd * gg[j] + bb[j];
            if (dstf) *((f32x4*)(dstf + (size_t)row * DM) + lane + 64 * j) = o;
            if (dstb) { v2u w; w.x = pk2(o[0], o[1]); w.y = pk2(o[2], o[3]); *((v2u*)(dstb + (size_t)row * DM) + lane + 64 * j) = w; } }
    }
}

__device__ __forceinline__ void attn_prompt_unit(Frame& F, int b, int h, int qt) {
    const bf16* Qb = (const bf16*)(F.ws + WS_QB); const bf16* Kb = (const bf16*)(F.ws + WS_KB); const bf16* VT = (const bf16*)(F.ws + WS_VTB);
    bf16* Ob = (bf16*)(F.ws + WS_OB);
    const int lane = F.lane, fr = lane & 15, fq = lane >> 4;
    const int m = b * 2048 + qt * 128 + 16 * F.wave + fr;
    bf16x8 Qf[16];
#pragma unroll
    for (int kc = 0; kc < 16; ++kc) Qf[kc] = *(const bf16x8*)(Qb + (size_t)m * DM + h * 512 + 32 * kc + 8 * fq);
    f32x4 s[8][2];
#pragma unroll
    for (int c = 0; c < 8; ++c)
#pragma unroll
        for (int sb = 0; sb < 2; ++sb) { const int mem = 32 * c + 8 * (fr >> 2) + 4 * sb + (fr & 3);
            const bf16* krow = Kb + (size_t)(b * NMEM + mem) * DM + h * 512 + 8 * fq; f32x4 acc = (f32x4){0.f, 0.f, 0.f, 0.f};
#pragma unroll
            for (int kc = 0; kc < 16; ++kc) acc = MFMA16(*(const bf16x8*)(krow + 32 * kc), Qf[kc], acc);
            s[c][sb] = acc; }
    float mx = -3.0e38f;
#pragma unroll
    for (int c = 0; c < 8; ++c)
#pragma unroll
        for (int sb = 0; sb < 2; ++sb)
#pragma unroll
            for (int j = 0; j < 4; ++j) mx = fmaxf(mx, s[c][sb][j]);
    mx = fmaxf(mx, __shfl_xor(mx, 16)); mx = fmaxf(mx, __shfl_xor(mx, 32));
    const float sc2 = 0.044194173824159216f * 1.4426950408889634f;
    float sum = 0.f;
#pragma unroll
    for (int c = 0; c < 8; ++c)
#pragma unroll
        for (int sb = 0; sb < 2; ++sb)
#pragma unroll
            for (int j = 0; j < 4; ++j) { const float p = exp2f((s[c][sb][j] - mx) * sc2); s[c][sb][j] = p; sum += p; }
    sum += __shfl_xor(sum, 16); sum += __shfl_xor(sum, 32);
    const float inv = 1.0f / sum;
    bf16x8 Pf[8];
#pragma unroll
    for (int c = 0; c < 8; ++c) Pf[c] = pack_bf8(s[c][0] * inv, s[c][1] * inv);
#pragma unroll 4
    for (int dt = 0; dt < 32; ++dt) { const bf16* vrow = VT + (size_t)(h * 512 + 16 * dt + fr) * 1024 + b * NMEM + 8 * fq; f32x4 acc = (f32x4){0.f, 0.f, 0.f, 0.f};
#pragma unroll
        for (int c = 0; c < 8; ++c) acc = MFMA16(*(const bf16x8*)(vrow + 32 * c), Pf[c], acc);
        v2u w; w.x = pk2(acc[0], acc[1]); w.y = pk2(acc[2], acc[3]);
        *(v2u*)(Ob + (size_t)m * DM + h * 512 + 16 * dt + 4 * fq) = w; }
}
__device__ __forceinline__ void attn_sample_unit(Frame& F, int b, int h) {
    const bf16* Qb = (const bf16*)(F.ws + WS_QB); bf16* Ob = (bf16*)(F.ws + WS_OB);
    const float* CK = F.in[7]; const float* CV = F.in[8];
    LAS float* sc = (LAS float*)F.lds; LAS float* Pm = (LAS float*)(F.lds + 4096); LAS float* red = (LAS float*)(F.lds + 8192);
    const int lane = F.lane, fr = lane & 15, fq = lane >> 4, w = F.wave, tid = F.tid;
    bf16x8 Qf[16];
#pragma unroll
    for (int kc = 0; kc < 16; ++kc) { const bf16x8 z = {0, 0, 0, 0, 0, 0, 0, 0};
        Qf[kc] = fr < 4 ? *(const bf16x8*)(Qb + (size_t)(MP + 4 * b + fr) * DM + h * 512 + 32 * kc + 8 * fq) : z; }
#pragma unroll
    for (int tl = 0; tl < 2; ++tl) { const int mem = 32 * w + 16 * tl + fr; const float* krow = CK + (size_t)(b * NMEM + mem) * DM + h * 512 + 8 * fq; f32x4 acc = (f32x4){0.f, 0.f, 0.f, 0.f};
#pragma unroll
        for (int kc = 0; kc < 16; ++kc) acc = MFMA16(pack_bf8(*(const f32x4*)(krow + 32 * kc), *(const f32x4*)(krow + 32 * kc + 4)), Qf[kc], acc);
        if (fr < 4) *(LAS f32x4*)(sc + fr * 256 + 32 * w + 16 * tl + 4 * fq) = acc * 0.044194173824159216f; }
    __syncthreads();
    if (w < 4) { const f32x4 v = *(const LAS f32x4*)(sc + w * 256 + 4 * lane);
        const float mx = wave_max(fmaxf(fmaxf(v[0], v[1]), fmaxf(v[2], v[3])));
        f32x4 e; e[0] = __expf(v[0] - mx); e[1] = __expf(v[1] - mx); e[2] = __expf(v[2] - mx); e[3] = __expf(v[3] - mx);
        const float inv = 1.0f / wave_sum((e[0] + e[1]) + (e[2] + e[3]));
#pragma unroll
        for (int j = 0; j < 4; ++j) Pm[(4 * lane + j) * 4 + w] = e[j] * inv; }
    __syncthreads();
    f32x4 a0[4], a1[4];
#pragma unroll
    for (int q = 0; q < 4; ++q) { a0[q] = (f32x4){0.f, 0.f, 0.f, 0.f}; a1[q] = a0[q]; }
#pragma unroll 8
    for (int i = 0; i < 32; ++i) { const int mem = 32 * w + i; const float* vrow = CV + (size_t)(b * NMEM + mem) * DM + h * 512;
        const f32x4 v0 = *(const f32x4*)(vrow + 4 * lane), v1 = *(const f32x4*)(vrow + 256 + 4 * lane); const f32x4 p4 = *(const LAS f32x4*)(Pm + mem * 4);
#pragma unroll
        for (int q = 0; q < 4; ++q) { a0[q] += v0 * p4[q]; a1[q] += v1 * p4[q]; } }
#pragma unroll
    for (int q = 0; q < 4; ++q) { *(LAS f32x4*)(red + (w * 4 + q) * 512 + 4 * lane) = a0[q]; *(LAS f32x4*)(red + (w * 4 + q) * 512 + 256 + 4 * lane) = a1[q]; }
    __syncthreads();
    { const int q = tid >> 7, d4 = (tid & 127) * 4; f32x4 o = (f32x4){0.f, 0.f, 0.f, 0.f};
#pragma unroll
      for (int ww = 0; ww < 8; ++ww) o += *(const LAS f32x4*)(red + (ww * 4 + q) * 512 + d4);
      v2u pw; pw.x = pk2(o[0], o[1]); pw.y = pk2(o[2], o[3]);
      *(v2u*)(Ob + (size_t)(MP + 4 * b + q) * DM + h * 512 + d4) = pw; }
    __syncthreads();
}
__device__ __forceinline__ void p8_attn(Frame& F) {
#ifndef MK_ATT_SKIP
#define MK_ATT_SKIP 0
#endif
    if (MK_ATT_SKIP != 1) for (int u = F.bid; u < 512; u += F.G) attn_sample_unit(F, u >> 2, u & 3);
    if (MK_ATT_SKIP != 2) for (int u = F.bid; u < 256; u += F.G) attn_prompt_unit(F, u >> 6, (u >> 4) & 3, u & 15);
}

template <bool COOP>
__global__ void __launch_bounds__(NTHR, 2) mk_fwd(Args args) {
    extern __shared__ __attribute__((aligned(16))) unsigned char lds_raw[];
    Frame F;
    F.lds = (LAS unsigned char*)lds_raw; F.MISC = (volatile LAS unsigned*)(F.lds + MISC_OFF);
    F.tid = threadIdx.x; F.lane = F.tid & 63; F.wave = __builtin_amdgcn_readfirstlane(F.tid >> 6); F.G = gridDim.x; F.bid = blockIdx.x;
    F.in = args.in; F.out = args.out; F.ws = args.ws;
    unsigned char* ws = args.ws;
    const int lo = args.lo, hi = args.hi, bid = F.bid, G = F.G;
#define IN(k) (lo <= (k) && (k) < hi)
#define SEAM(k) do { if (COOP) { if (IN(k) && IN((k) + 1)) cg::this_grid().sync(); } } while (0)
    using pg8::Gemm; using pg8::StaticOrder; using pg8::gemm_phase;
    bf16* XB = (bf16*)(ws + WS_XB); float* Hh = (float*)(ws + WS_H); float* R = (float*)(ws + WS_R); float* X = (float*)(ws + WS_X);

    if (IN(0)) { p0_prologue(F); } SEAM(0);
    if (IN(1)) {
        { Gemm g{XB, (const bf16*)(ws + WS_WIN), MT, DIN, DM}; StaticOrder S; S.init(MT, DIN, G, bid); pg8::EpiF32 E{Hh, DIN};
          gemm_phase<pg8::EpiF32, StaticOrder, true, true>(F.lds, g, S, E); }
        { Gemm g{(const bf16*)(ws + WS_MB), (const bf16*)(ws + WS_WKV), 1024, 4096, DM}; StaticOrder S; S.init(1024, 4096, G, (bid + G - 66) % G);
          pg8::EpiMemKV E{F.out + O_MK, F.out + O_MV, (bf16*)(ws + WS_KB)};
          gemm_phase<pg8::EpiMemKV, StaticOrder, true, true>(F.lds, g, S, E); }
        { Gemm g{(const bf16*)(ws + WS_WKV) + (size_t)2048 * DM, (const bf16*)(ws + WS_MB), 2048, 1024, DM}; StaticOrder S; S.init(2048, 1024, G, (bid + G - 130) % G);
          pg8::EpiBf16S E{(bf16*)(ws + WS_VTB), 1024};
          gemm_phase<pg8::EpiBf16S, StaticOrder, true, true>(F.lds, g, S, E); }
    } SEAM(1);
    if (IN(2)) { p2_prep(F); } SEAM(2);
    if (IN(3)) { p3_scans(F); } SEAM(3);
    if (IN(4)) {
        { Gemm g{(const bf16*)(ws + WS_YGB), (const bf16*)(ws + WS_WGLU), MT, DSSM, DSSM}; StaticOrder S; S.init(MT, DSSM, G, bid);
          pg8::EpiGlu E{(const bf16*)(ws + WS_YGB), 1024, F.in[19], (bf16*)(ws + WS_MIX), 2048};
          gemm_phase<pg8::EpiGlu, StaticOrder, true, true>(F.lds, g, S, E); }
        p4_post(F);
    } SEAM(4);
    if (IN(5)) { Gemm g{(const bf16*)(ws + WS_MIX), (const bf16*)(ws + WS_WOUT), MT, DM, DM}; StaticOrder S; S.init(MT, DM, G, bid);
        pg8::EpiRes E{F.in[0], F.in[1], R, DM, ALPHA};
        gemm_phase<pg8::EpiRes, StaticOrder, true, true>(F.lds, g, S, E); } SEAM(5);
    if (IN(6)) { ln_rows(F, R, F.in[32], F.in[33], X, XB); } SEAM(6);
    if (IN(7)) { Gemm g{XB, (const bf16*)(ws + WS_WQ), MT, DM, DM}; StaticOrder S; S.init(MT, DM, G, bid);
        pg8::EpiBf16S E{(bf16*)(ws + WS_QB), DM};
        gemm_phase<pg8::EpiBf16S, StaticOrder, true, true>(F.lds, g, S, E); } SEAM(7);
    if (IN(8)) { p8_attn(F); } SEAM(8);
    if (IN(9)) { Gemm g{(const bf16*)(ws + WS_OB), (const bf16*)(ws + WS_WO), MT, DM, DM}; StaticOrder S; S.init(MT, DM, G, bid);
        pg8::EpiRes E{X, X + (size_t)MP * DM, R, DM, ALPHA};
        gemm_phase<pg8::EpiRes, StaticOrder, true, true>(F.lds, g, S, E); } SEAM(9);
    if (IN(10)) { ln_rows(F, R, F.in[38], F.in[39], X, XB); } SEAM(10);
    if (IN(11)) { Gemm g{XB, (const bf16*)(ws + WS_WGU), MT, 2 * DFF, DM}; StaticOrder S; S.init(MT, 2 * DFF, G, bid);
        pg8::EpiSwiGLU E{(bf16*)(ws + WS_HFF), DFF};
        gemm_phase<pg8::EpiSwiGLU, StaticOrder, true, true>(F.lds, g, S, E); } SEAM(11);
    if (IN(12)) { Gemm g{(const bf16*)(ws + WS_HFF), (const bf16*)(ws + WS_WDN), MT, DM, DFF}; StaticOrder S; S.init(MT, DM, G, bid);
        pg8::EpiRes E{X, X + (size_t)MP * DM, R, DM, ALPHA};
        gemm_phase<pg8::EpiRes, StaticOrder, true, true>(F.lds, g, S, E); } SEAM(12);
    if (IN(13)) { ln_rows(F, R, F.in[43], F.in[44], F.out + O_Y, nullptr); }
#undef IN
#undef SEAM
}

#ifndef MK_COOP
#define MK_COOP 0
#endif
#ifndef MK_PH_HI
#define MK_PH_HI NPHASE
#endif
extern "C" void kernel_launch(void* const* d_in, const int* in_sizes, int n_in, void* d_out, int out_size, void* d_ws, size_t ws_size, hipStream_t stream) {
    static int grid = 0;
    if (grid == 0) {
        if (n_in != 45 || out_size != (int)O_END || ws_size < WS_END) { fprintf(stderr, "kernel_launch: unexpected shapes (n_in %d out %d ws %zu)\n", n_in, out_size, ws_size); grid = -1; return; }
        int dev = 0, cus = 0, per_cu = 0;
        (void)hipGetDevice(&dev); (void)hipDeviceGetAttribute(&cus, hipDeviceAttributeMultiprocessorCount, dev);
        (void)hipFuncSetAttribute((const void*)mk_fwd<true>, hipFuncAttributeMaxDynamicSharedMemorySize, LDS_BYTES);
        (void)hipFuncSetAttribute((const void*)mk_fwd<false>, hipFuncAttributeMaxDynamicSharedMemorySize, LDS_BYTES);
        (void)hipOccupancyMaxActiveBlocksPerMultiprocessor(&per_cu, (const void*)mk_fwd<true>, NTHR, LDS_BYTES);
        (void)hipGetLastError();
        if (per_cu < 1) { fprintf(stderr, "kernel_launch: occupancy query says %d blocks per CU\n", per_cu); per_cu = 1; }
        grid = cus;
    }
    if (grid < 0) return;
    (void)hipMemsetAsync((char*)d_ws + WS_CTL, 0, 4096, stream);
    if (MK_PH_HI < NPHASE) (void)hipMemsetAsync(d_out, 0, (size_t)out_size * 4, stream);
#ifdef MK_DUMP_OFF
#ifndef MK_DUMP_BYTES
#define MK_DUMP_BYTES ((size_t)MT * DM * 4)
#endif
#define MK_DUMP_AFTER (void)hipMemcpyAsync(d_out, (char*)d_ws + (MK_DUMP_OFF), MK_DUMP_BYTES, hipMemcpyDeviceToDevice, stream);
#else
#define MK_DUMP_AFTER
#endif
    Args a{};
    for (int i = 0; i < 45; ++i) a.in[i] = (const float*)d_in[i];
    a.out = (float*)d_out; a.ws = (unsigned char*)d_ws;
#if MK_COOP
    a.lo = 0; a.hi = MK_PH_HI;
    void* kargs[] = {&a};
    hipError_t e = hipLaunchCooperativeKernel((const void*)mk_fwd<true>, dim3(grid), dim3(NTHR), kargs, LDS_BYTES, stream);
    if (e != hipSuccess) fprintf(stderr, "cooperative launch failed: %s (grid %d)\n", hipGetErrorString(e), grid);
#else
    for (int p = 0; p < MK_PH_HI; ++p) { a.lo = p; a.hi = p + 1; hipLaunchKernelGGL(mk_fwd<false>, dim3(grid), dim3(NTHR), LDS_BYTES, stream, a); }
#endif
    MK_DUMP_AFTER
}
```

```cpp
#include <hip/hip_runtime.h>
#include <hip/hip_cooperative_groups.h>
#include <cstdio>
#include <cstdint>
namespace cg = cooperative_groups;
#define MK_COOP 1
namespace pg8 {
#define PG8_LAS __attribute__((address_space(3)))
typedef unsigned short bf16_t;
typedef short bf16x8 __attribute__((ext_vector_type(8)));
typedef float f32x4 __attribute__((ext_vector_type(4)));
typedef unsigned u32x4 __attribute__((ext_vector_type(4)));
constexpr int BM = 256, BK = 64, HALF = 128, HTB = HALF * BK * 2  , STAGE_BYTES = 8 * HTB, NXCD = 8, WGM = 8;

__host__ __device__ __forceinline__ int lds_byte(int r, int c) { const int st = (r >> 4) * 2 + (c >> 5), rr = r & 15, cc = c & 31, ob = rr * 64 + cc * 2; return st * 1024 + (ob ^ (((ob >> 9) & 1) << 5)); }
__host__ __device__ __forceinline__ void stage_rc(int b, int& R, int& C) { const int st = b / 1024, sb = b % 1024, swz = sb ^ (((sb >> 9) & 1) << 5); R = (st >> 1) * 16 + swz / 64; C = (st & 1) * 32 + (swz % 64) / 2; }
__host__ __device__ __forceinline__ int perm32(int rho) { const int n = rho >> 4, i = rho & 15; return 8 * (i >> 2) + 4 * n + (i & 3); }

struct Unit { int pm, pn; };
struct Gemm { const bf16_t* A; const bf16_t* Bt; int M, N, K; };

struct StaticOrder {
    int nM, nN, nwg, G, c;
    __host__ __device__ void init(int M, int N, int G_, int c_) { nM = M / BM; nN = N / BM; nwg = nM * nN; G = G_; c = c_; }
    __host__ __device__ bool next(int i, Unit& u) const {
        const long L = (long)i * G + c; if (L >= nwg) return false;
        int wgid = (int)L; { const int q = nwg / NXCD, r = nwg % NXCD, xcd = wgid % NXCD, off = wgid / NXCD; wgid = (xcd < r ? xcd * (q + 1) : r * (q + 1) + (xcd - r) * q) + off; }
        const int nig = WGM * nN, gid = wgid / nig, fm = gid * WGM, gsz = (nM - fm) < WGM ? (nM - fm) : WGM;
        u.pm = fm + ((wgid % nig) % gsz); u.pn = (wgid % nig) / gsz; return true;
    }
    __device__ __forceinline__ void a_ready(const Unit&) const {}
    __device__ __forceinline__ void done(const Unit&) const {}
};
typedef float f32x2_cv __attribute__((ext_vector_type(2))); typedef __bf16 bf16x2_cv __attribute__((ext_vector_type(2)));
__device__ __forceinline__ unsigned cvt_pk_bf16(float lo, float hi) { const f32x2_cv v = {lo, hi}; const bf16x2_cv b = __builtin_convertvector(v, bf16x2_cv); return __builtin_bit_cast(unsigned, b); }

__device__ __forceinline__ float bf_lo(unsigned w) { return __builtin_bit_cast(float, w << 16); }
__device__ __forceinline__ float bf_hi(unsigned w) { return __builtin_bit_cast(float, w & 0xffff0000u); }
__device__ __forceinline__ u32x4 pack8(const f32x4 a, const f32x4 b) { u32x4 w; w.x = cvt_pk_bf16(a[0], a[1]); w.y = cvt_pk_bf16(a[2], a[3]); w.z = cvt_pk_bf16(b[0], b[1]); w.w = cvt_pk_bf16(b[2], b[3]); return w; }
__device__ __forceinline__ float sigmoidf_(float x) { return 1.0f / (1.0f + __expf(-x)); }

struct EpiF32 {
    static constexpr bool PERM = true, AFTER_DRAIN = false;
    float* O; int ldc;
    __device__ __forceinline__ void operator()(const f32x4 (&acc)[2][2][4][2], const Unit& u, int wr, int wc, int fr, int fq) const {
        const int row0 = u.pm * BM + wr * 64 + fr, col0 = u.pn * BM + wc * 32 + 8 * fq;
#pragma unroll
        for (int ai = 0; ai < 2; ++ai)
#pragma unroll
            for (int m = 0; m < 4; ++m) { float* rowp = O + (size_t)(row0 + ai * HALF + m * 16) * ldc + col0;
#pragma unroll
                for (int bj = 0; bj < 2; ++bj) { *(f32x4*)(rowp + bj * HALF) = acc[ai][bj][m][0]; *(f32x4*)(rowp + bj * HALF + 4) = acc[ai][bj][m][1]; } }
    }
};
struct EpiMemKV {
    static constexpr bool PERM = true, AFTER_DRAIN = false;
    float* outK; float* outV; bf16_t* Kb;
    __device__ __forceinline__ void operator()(const f32x4 (&acc)[2][2][4][2], const Unit& u, int wr, int wc, int fr, int fq) const {
        const int row0 = u.pm * BM + wr * 64 + fr; const int colt = u.pn * BM; const bool isV = colt >= 2048;
        float* o = isV ? outV : outK; const int col0 = (isV ? colt - 2048 : colt) + wc * 32 + 8 * fq;
#pragma unroll
        for (int ai = 0; ai < 2; ++ai)
#pragma unroll
            for (int m = 0; m < 4; ++m)
#pragma unroll
                for (int bj = 0; bj < 2; ++bj) { const size_t off = (size_t)(row0 + ai * HALF + m * 16) * 2048 + col0 + bj * HALF;
                    *(f32x4*)(o + off) = acc[ai][bj][m][0]; *(f32x4*)(o + off + 4) = acc[ai][bj][m][1];
                    if (!isV) *(u32x4*)(Kb + off) = pack8(acc[ai][bj][m][0], acc[ai][bj][m][1]); }
    }
};
struct EpiBf16S {
    static constexpr bool PERM = true, AFTER_DRAIN = false;
    bf16_t* O; int ldc;
    __device__ __forceinline__ void operator()(const f32x4 (&acc)[2][2][4][2], const Unit& u, int wr, int wc, int fr, int fq) const {
        const int row0 = u.pm * BM + wr * 64 + fr, col0 = u.pn * BM + wc * 32 + 8 * fq;
#pragma unroll
        for (int ai = 0; ai < 2; ++ai)
#pragma unroll
            for (int m = 0; m < 4; ++m) { bf16_t* rowp = O + (size_t)(row0 + ai * HALF + m * 16) * ldc + col0;
#pragma unroll
                for (int bj = 0; bj < 2; ++bj) *(u32x4*)(rowp + bj * HALF) = pack8(acc[ai][bj][m][0], acc[ai][bj][m][1]); }
    }
};
struct EpiGlu {
    static constexpr bool PERM = true, AFTER_DRAIN = false;
    const bf16_t* Y; int ldy; const float* bias; bf16_t* O; int ldo;
    __device__ __forceinline__ void operator()(const f32x4 (&acc)[2][2][4][2], const Unit& u, int wr, int wc, int fr, int fq) const {
        const int row0 = u.pm * BM + wr * 64 + fr, col0 = u.pn * BM + wc * 32 + 8 * fq;
#pragma unroll
        for (int bj = 0; bj < 2; ++bj) { const f32x4 b0 = *(const f32x4*)(bias + col0 + bj * HALF), b1 = *(const f32x4*)(bias + col0 + bj * HALF + 4);
#pragma unroll
            for (int ai = 0; ai < 2; ++ai)
#pragma unroll
                for (int m = 0; m < 4; ++m) { const int row = row0 + ai * HALF + m * 16;
                    const u32x4 yv = *(const u32x4*)(Y + (size_t)row * ldy + col0 + bj * HALF);
                    const f32x4 a0 = acc[ai][bj][m][0] + b0, a1 = acc[ai][bj][m][1] + b1; f32x4 z0, z1;
                    z0[0] = bf_lo(yv.x) * sigmoidf_(a0[0]); z0[1] = bf_hi(yv.x) * sigmoidf_(a0[1]); z0[2] = bf_lo(yv.y) * sigmoidf_(a0[2]); z0[3] = bf_hi(yv.y) * sigmoidf_(a0[3]);
                    z1[0] = bf_lo(yv.z) * sigmoidf_(a1[0]); z1[1] = bf_hi(yv.z) * sigmoidf_(a1[1]); z1[2] = bf_lo(yv.w) * sigmoidf_(a1[2]); z1[3] = bf_hi(yv.w) * sigmoidf_(a1[3]);
                    *(u32x4*)(O + (size_t)row * ldo + col0 + bj * HALF) = pack8(z0, z1); } }
    }
};
struct EpiRes {
    static constexpr bool PERM = true, AFTER_DRAIN = false;
    const float* base0; const float* base1; float* O; int ld; float alpha;
    __device__ __forceinline__ void operator()(const f32x4 (&acc)[2][2][4][2], const Unit& u, int wr, int wc, int fr, int fq) const {
        const int row0 = u.pm * BM + wr * 64 + fr, col0 = u.pn * BM + wc * 32 + 8 * fq;
        const bool lo = (u.pm * BM) < 8192; const float* bp = lo ? base0 : base1; const int rsub = lo ? 0 : 8192;
#pragma unroll
        for (int ai = 0; ai < 2; ++ai)
#pragma unroll
            for (int m = 0; m < 4; ++m) { const int row = row0 + ai * HALF + m * 16; const float* brow = bp + (size_t)(row - rsub) * ld + col0; float* orow = O + (size_t)row * ld + col0;
#pragma unroll
                for (int bj = 0; bj < 2; ++bj) { const f32x4 x0 = *(const f32x4*)(brow + bj * HALF), x1 = *(const f32x4*)(brow + bj * HALF + 4);
                    *(f32x4*)(orow + bj * HALF) = x0 * alpha + acc[ai][bj][m][0]; *(f32x4*)(orow + bj * HALF + 4) = x1 * alpha + acc[ai][bj][m][1]; } }
    }
};
struct EpiSwiGLU {
    static constexpr bool PERM = true, AFTER_DRAIN = false;
    bf16_t* O; int ldo;
    __device__ __forceinline__ void operator()(const f32x4 (&acc)[2][2][4][2], const Unit& u, int wr, int wc, int fr, int fq) const {
        const int row0 = u.pm * BM + wr * 64 + fr, col0 = u.pn * HALF + wc * 32 + 8 * fq;
#pragma unroll
        for (int ai = 0; ai < 2; ++ai)
#pragma unroll
            for (int m = 0; m < 4; ++m) { f32x4 h0, h1;
#pragma unroll
                for (int j = 0; j < 4; ++j) { const float g0 = acc[ai][0][m][0][j], g1 = acc[ai][0][m][1][j];
                    h0[j] = g0 * sigmoidf_(g0) * acc[ai][1][m][0][j]; h1[j] = g1 * sigmoidf_(g1) * acc[ai][1][m][1][j]; }
                *(u32x4*)(O + (size_t)(row0 + ai * HALF + m * 16) * ldo + col0) = pack8(h0, h1); }
    }
};

template <class Epi, class Sched, bool ALIGN_EPI = false, bool SP2 = false>
__device__ __forceinline__ void gemm_phase(PG8_LAS unsigned char* lds, const Gemm g, const Sched& S, const Epi& E) {
    const int tid = threadIdx.x, wid = __builtin_amdgcn_readfirstlane(tid >> 6), lane = tid & 63, wr = wid >> 2, wc = wid & 3, fr = lane & 15, fq = lane >> 4;
    const int K = g.K, nt = K / BK;
    unsigned voffA[2], voffB[2];
#pragma unroll
    for (int i = 0; i < 2; ++i) { int R, C; stage_rc(tid * 16 + i * 8192, R, C); const int Rb = Epi::PERM ? ((R & ~31) + perm32(R & 31)) : R;
        voffA[i] = (unsigned)(R * K + C) * 2u; voffB[i] = (unsigned)(Rb * K + C) * 2u; }
    const size_t kstep = (size_t)(BK * 2);
    const size_t hstep = (size_t)HALF * K * 2;
    const size_t tstep = 2 * hstep;
    const unsigned ldsw = (unsigned)wid * 1024u;
    const int aoff = lds_byte(wr * 64 + fr, fq * 8), boff = lds_byte(wc * 32 + fr, fq * 8);
#define PG8_SA(b, h) (((b) * 2 + (h)) * HTB)
#define PG8_SB(b, h) ((4 + (b) * 2 + (h)) * HTB)
#define PG8_STAGE(bufoff, gbase, voff) do { _Pragma("unroll") for (int _i = 0; _i < 2; ++_i) \
        __builtin_amdgcn_global_load_lds((const unsigned*)((const char*)(gbase) + (voff)[_i]), (PG8_LAS unsigned*)(lds + (bufoff) + ldsw + _i * 8192), 16, 0, 0); } while (0)
#define PG8_LDA(dst, b, h) do { _Pragma("unroll") for (int m = 0; m < 4; ++m) _Pragma("unroll") for (int k = 0; k < 2; ++k) dst[m][k] = *(const PG8_LAS bf16x8*)(lds + PG8_SA(b, h) + aoff + m * 2048 + k * 1024); } while (0)
#define PG8_LDB(dst, b, h) do { _Pragma("unroll") for (int n = 0; n < 2; ++n) _Pragma("unroll") for (int k = 0; k < 2; ++k) dst[n][k] = *(const PG8_LAS bf16x8*)(lds + PG8_SB(b, h) + boff + n * 2048 + k * 1024); } while (0)
#define PG8_MMA(ai, bj, At, Bt) do { __builtin_amdgcn_s_setprio(1); _Pragma("unroll") for (int m = 0; m < 4; ++m) _Pragma("unroll") for (int n = 0; n < 2; ++n) _Pragma("unroll") for (int k = 0; k < 2; ++k) \
        acc[ai][bj][m][n] = __builtin_amdgcn_mfma_f32_16x16x32_bf16(Bt[n][k], At[m][k], acc[ai][bj][m][n], 0, 0, 0); __builtin_amdgcn_s_setprio(0); } while (0)
#define PG8_WAIT_V(n) asm volatile("s_waitcnt vmcnt(" #n ")" ::: "memory")
#define PG8_WAIT_L(n) asm volatile("s_waitcnt lgkmcnt(" #n ")" ::: "memory")
#define PG8_BAR __builtin_amdgcn_s_barrier()
#define PG8_SCHED __builtin_amdgcn_sched_barrier(0)
    Unit cur, nxt; int ui = 0;
    if (!S.next(0, cur)) return;
    f32x4 acc[2][2][4][2];
#pragma unroll
    for (int a = 0; a < 2; ++a)
#pragma unroll
        for (int b = 0; b < 2; ++b)
#pragma unroll
            for (int m = 0; m < 4; ++m)
#pragma unroll
                for (int n = 0; n < 2; ++n) acc[a][b][m][n] = (f32x4){0.f, 0.f, 0.f, 0.f};
    bf16x8 At[4][2], B0[2][2], B1[2][2];
    const char* cA = (const char*)g.A + (size_t)cur.pm * tstep; const char* cB = (const char*)g.Bt + (size_t)cur.pn * tstep;
    S.a_ready(cur);
    if constexpr (SP2) {
        PG8_STAGE(PG8_SB(0, 0), cB, voffB); PG8_STAGE(PG8_SB(0, 1), cB + hstep, voffB); PG8_STAGE(PG8_SA(0, 0), cA, voffA); PG8_STAGE(PG8_SA(0, 1), cA + hstep, voffA);
        if (wr == 1) PG8_BAR;
        PG8_WAIT_V(2); PG8_BAR;
        PG8_STAGE(PG8_SB(1, 0), cB + kstep, voffB); PG8_STAGE(PG8_SA(1, 0), cA + kstep, voffA); PG8_STAGE(PG8_SB(1, 1), cB + hstep + kstep, voffB);
        PG8_WAIT_V(6); PG8_BAR;
    } else {
        PG8_STAGE(PG8_SB(0, 0), cB, voffB); PG8_STAGE(PG8_SA(0, 0), cA, voffA); PG8_STAGE(PG8_SB(0, 1), cB + hstep, voffB); PG8_STAGE(PG8_SA(0, 1), cA + hstep, voffA);
        if (wr == 1) PG8_BAR;
        PG8_WAIT_V(4); PG8_BAR;
        PG8_STAGE(PG8_SB(1, 0), cB + kstep, voffB); PG8_STAGE(PG8_SA(1, 0), cA + kstep, voffA); PG8_STAGE(PG8_SB(1, 1), cB + hstep + kstep, voffB);
        PG8_WAIT_V(6); PG8_BAR;
    }
    for (;;) {
        const bool has_next = S.next(ui + 1, nxt);
        const char* nA = has_next ? (const char*)g.A + (size_t)nxt.pm * tstep : cA; const char* nB = has_next ? (const char*)g.Bt + (size_t)nxt.pn * tstep : cB;
        for (int t = 0; t < nt; t += 2) {
            const bool last = (t == nt - 2);
            const char* a1 = cA + (size_t)(t + 1) * kstep;
            const char* a2 = last ? nA : cA + (size_t)(t + 2) * kstep; const char* b2 = last ? nB : cB + (size_t)(t + 2) * kstep;
            const char* a3 = a2 + kstep; const char* b3 = b2 + kstep;
            if (last && has_next) S.a_ready(nxt);
            if constexpr (SP2) {
            PG8_LDB(B0, 0, 0); PG8_LDB(B1, 0, 1); PG8_SCHED; PG8_LDA(At, 0, 0); PG8_STAGE(PG8_SA(1, 1), a1 + hstep, voffA);
            PG8_WAIT_V(8); PG8_WAIT_L(0); PG8_BAR; PG8_MMA(0, 0, At, B0); PG8_MMA(0, 1, At, B1); PG8_BAR; PG8_SCHED;
            PG8_LDA(At, 0, 1); PG8_STAGE(PG8_SB(0, 0), b2, voffB); PG8_STAGE(PG8_SB(0, 1), b2 + hstep, voffB); PG8_STAGE(PG8_SA(0, 0), a2, voffA);
            PG8_WAIT_V(8); PG8_WAIT_L(0); PG8_BAR; PG8_MMA(1, 0, At, B0); PG8_MMA(1, 1, At, B1); PG8_BAR; PG8_SCHED;
            PG8_LDB(B0, 1, 0); PG8_LDB(B1, 1, 1); PG8_SCHED; PG8_LDA(At, 1, 0); PG8_STAGE(PG8_SA(0, 1), a2 + hstep, voffA);
            PG8_WAIT_V(8); PG8_WAIT_L(0); PG8_BAR; PG8_MMA(0, 0, At, B0); PG8_MMA(0, 1, At, B1); PG8_BAR; PG8_SCHED;
            PG8_LDA(At, 1, 1); PG8_STAGE(PG8_SB(1, 0), b3, voffB); PG8_STAGE(PG8_SB(1, 1), b3 + hstep, voffB); PG8_STAGE(PG8_SA(1, 0), a3, voffA);
            PG8_WAIT_V(8); PG8_WAIT_L(0); PG8_BAR; PG8_MMA(1, 0, At, B0); PG8_MMA(1, 1, At, B1); PG8_BAR; PG8_SCHED;
            } else {
            PG8_LDB(B0, 0, 0); PG8_SCHED; PG8_LDA(At, 0, 0); PG8_STAGE(PG8_SA(1, 1), a1 + hstep, voffA);
            PG8_WAIT_L(8); PG8_BAR; PG8_WAIT_L(0); PG8_MMA(0, 0, At, B0); PG8_BAR; PG8_SCHED;
            PG8_LDB(B1, 0, 1); PG8_STAGE(PG8_SB(0, 0), b2, voffB);
            PG8_BAR; PG8_WAIT_L(0); PG8_MMA(0, 1, At, B1); PG8_BAR;
            PG8_LDA(At, 0, 1); PG8_STAGE(PG8_SA(0, 0), a2, voffA);
            PG8_BAR; PG8_WAIT_L(0); PG8_MMA(1, 0, At, B0); PG8_BAR; PG8_SCHED;
            PG8_STAGE(PG8_SB(0, 1), b2 + hstep, voffB);
            PG8_WAIT_V(6); PG8_BAR; PG8_MMA(1, 1, At, B1); PG8_BAR;
            PG8_LDB(B0, 1, 0); PG8_SCHED; PG8_LDA(At, 1, 0); PG8_STAGE(PG8_SA(0, 1), a2 + hstep, voffA);
            PG8_WAIT_L(8); PG8_BAR; PG8_WAIT_L(0); PG8_MMA(0, 0, At, B0); PG8_BAR; PG8_SCHED;
            PG8_LDB(B1, 1, 1); PG8_STAGE(PG8_SB(1, 0), b3, voffB);
            PG8_BAR; PG8_WAIT_L(0); PG8_MMA(0, 1, At, B1); PG8_BAR;
            PG8_LDA(At, 1, 1); PG8_STAGE(PG8_SA(1, 0), a3, voffA);
            PG8_BAR; PG8_WAIT_L(0); PG8_MMA(1, 0, At, B0); PG8_BAR; PG8_SCHED;
            PG8_STAGE(PG8_SB(1, 1), b3 + hstep, voffB);
            PG8_WAIT_V(6); PG8_BAR; PG8_MMA(1, 1, At, B1); PG8_BAR;
            }
        }
        if constexpr (ALIGN_EPI) { if (wr == 0) PG8_BAR; }
        if constexpr (!Epi::AFTER_DRAIN) { E(acc, cur, wr, wc, fr, fq); S.done(cur); }
        if (!has_next) break;
#pragma unroll
        for (int a = 0; a < 2; ++a)
#pragma unroll
            for (int b = 0; b < 2; ++b)
#pragma unroll
                for (int m = 0; m < 4; ++m)
#pragma unroll
                    for (int n = 0; n < 2; ++n) acc[a][b][m][n] = (f32x4){0.f, 0.f, 0.f, 0.f};
        cur = nxt; cA = nA; cB = nB; ++ui;
        if constexpr (ALIGN_EPI) { if (wr == 1) PG8_BAR; }
    }
    PG8_WAIT_V(0);
    if constexpr (!ALIGN_EPI) { if (wr == 0) PG8_BAR; }
    PG8_BAR;
    if constexpr (Epi::AFTER_DRAIN) { E.fused(acc, cur, wr, wc, fr, fq, lds, wid, lane); S.done(cur); }
#undef PG8_SA
#undef PG8_SB
#undef PG8_STAGE
#undef PG8_LDA
#undef PG8_LDB
#undef PG8_MMA
#undef PG8_WAIT_V
#undef PG8_WAIT_L
#undef PG8_BAR
#undef PG8_SCHED
}
}

constexpr int NWAVES = 8, NTHR = 512;
constexpr int MT = 8704, MP = 8192, DM = 2048, DIN = 4352, DSSM = 1024, DRW = 1024, DSH = 3328, DFF = 5632, NMEM = 256;
constexpr float ALPHA = 1.189207115002721f;
constexpr float LN_EPS = 1e-5f, GN_EPS = 64e-5f;
constexpr size_t O_Y = 0, O_SRE_P = (size_t)MT * DM, O_SIM_P = O_SRE_P + 16384, O_WKV_P = O_SIM_P + 16384, O_SH_P = O_WKV_P + 262144, O_MK = O_SH_P + 4 * DSH,
                 O_MV = O_MK + 2097152, O_SRE_S = O_MV + 2097152, O_SIM_S = O_SRE_S + 524288, O_WKV_S = O_SIM_S + 524288, O_SH_S = O_WKV_S + 8388608, O_END = O_SH_S + 128 * DSH;
static_assert(O_END == 32191488, "output size");
constexpr size_t MiB = 1u << 20;
constexpr size_t WS_CTL = 0, WS_WIN = 1 * MiB, WS_WGLU = 18 * MiB, WS_WOUT = 20 * MiB, WS_WQ = 28 * MiB, WS_WKV = 36 * MiB, WS_WO = 52 * MiB, WS_WGU = 60 * MiB, WS_WDN = 104 * MiB,
                 WS_W2T = 126 * MiB, WS_A2T = WS_W2T + 131072, WS_G2T = WS_W2T + 262144, WS_KB = 127 * MiB, WS_VTB = 131 * MiB, WS_XB = 135 * MiB, WS_MB = 169 * MiB,
                 WS_H = 173 * MiB, WS_R = WS_H, WS_X = WS_H + 72 * MiB, WS_PREP = 318 * MiB, WS_BONUS = 556 * MiB, WS_QB = WS_PREP, WS_OB = WS_PREP + 34 * MiB, WS_HFF = WS_PREP + 68 * MiB,
                 WS_YR = 557 * MiB, WS_YGB = 591 * MiB, WS_MIX = 608 * MiB, WS_END = 642 * MiB;
constexpr size_t PREP_STRIDE = 34 * MiB;
constexpr int LDS_BYTES = 135168;
constexpr int MISC_OFF = 131072;
constexpr int NPHASE = 14;

#define LAS __attribute__((address_space(3)))
typedef unsigned short bf16;
typedef unsigned v4u __attribute__((ext_vector_type(4)));
typedef unsigned v2u __attribute__((ext_vector_type(2)));
typedef float f32x4 __attribute__((ext_vector_type(4)));
typedef float f32x2 __attribute__((ext_vector_type(2)));
typedef float f32x16 __attribute__((ext_vector_type(16)));
typedef short bf16x8 __attribute__((ext_vector_type(8)));
#define LDS_WAIT() asm volatile("s_waitcnt lgkmcnt(0)" ::: "memory")

__device__ __forceinline__ unsigned pk2(float lo, float hi) { return pg8::cvt_pk_bf16(lo, hi); }
__device__ __forceinline__ bf16x8 pack_bf8(const f32x4 a, const f32x4 b) { v4u w; w.x = pk2(a[0], a[1]); w.y = pk2(a[2], a[3]); w.z = pk2(b[0], b[1]); w.w = pk2(b[2], b[3]); return __builtin_bit_cast(bf16x8, w); }
__device__ __forceinline__ float wave_sum(float v) {
#pragma unroll
    for (int o = 1; o < 64; o <<= 1) v += __shfl_xor(v, o);
    return v;
}
__device__ __forceinline__ float wave_max(float v) {
#pragma unroll
    for (int o = 1; o < 64; o <<= 1) v = fmaxf(v, __shfl_xor(v, o));
    return v;
}
template <int CTRL> __device__ __forceinline__ float dpp_f(float x) { return __builtin_bit_cast(float, __builtin_amdgcn_update_dpp(0, __builtin_bit_cast(int, x), CTRL, 0xf, 0xf, false)); }
__device__ __forceinline__ float sum16(float x) { x += dpp_f<0xB1>(x); x += dpp_f<0x4E>(x); x += dpp_f<0x141>(x); x += dpp_f<0x140>(x); return x; }
__device__ __forceinline__ float sigm(float x) { return 1.0f / (1.0f + __expf(-x)); }
__device__ __forceinline__ float tanh_(float x) { return 1.0f - 2.0f / (1.0f + __expf(2.0f * x)); }
__device__ __forceinline__ float gelu_tanh(float x) { const float u = 1.5957691216057308f * (x + 0.044715f * x * x * x); return x / (1.0f + __expf(-u)); }
#define MFMA16(a, b, c) __builtin_amdgcn_mfma_f32_16x16x32_bf16((a), (b), (c), 0, 0, 0)
#define MFMA32(a, b, c) __builtin_amdgcn_mfma_f32_32x32x16_bf16((a), (b), (c), 0, 0, 0)

struct Args { const float* in[45]; float* out; unsigned char* ws; int lo, hi; };

struct Frame {
    LAS unsigned char* lds; volatile LAS unsigned* MISC;
    int tid, lane, wave, G, bid;
    const float* const* in; float* out; unsigned char* ws;
};

__device__ __forceinline__ void tr_item(const float* W, int K, int N, bf16* WT, int drow0, int k0, int n0, LAS float* scr, int lane) {
#pragma unroll 8
    for (int i = 0; i < 32; ++i) { const int kk = 2 * i + (lane >> 5); scr[kk * 33 + (lane & 31)] = W[(size_t)(k0 + kk) * N + n0 + (lane & 31)]; }
    LDS_WAIT(); asm volatile("" ::: "memory");
    const int c = lane & 7;
#pragma unroll
    for (int j = 0; j < 4; ++j) { const int n = (lane >> 3) + 8 * j; const LAS float* s = scr + (8 * c) * 33 + n;
        v4u o; o.x = pk2(s[0 * 33], s[1 * 33]); o.y = pk2(s[2 * 33], s[3 * 33]); o.z = pk2(s[4 * 33], s[5 * 33]); o.w = pk2(s[6 * 33], s[7 * 33]);
        *(v4u*)(WT + (size_t)(drow0 + n) * K + k0 + 8 * c) = o; }
    LDS_WAIT(); asm volatile("" ::: "memory");
}
__device__ __forceinline__ void p0_prologue(Frame& F) {
    LAS float* scr = (LAS float*)(F.lds + F.wave * 16384);
    const int gw = F.bid * NWAVES + F.wave, NGW = F.G * NWAVES, lane = F.lane;
    unsigned char* ws = F.ws;
#define TR_MAT(Wp, Kk, Nn, Dst, ROWMAP) { const int nblk = (Nn) / 32, cnt = ((Kk) / 64) * nblk; if (r < cnt) { const int kb = r / nblk, n0 = (r % nblk) * 32; \
        tr_item((Wp), (Kk), (Nn), (bf16*)(Dst), (ROWMAP), kb * 64, n0, scr, lane); continue; } r -= cnt; }
    constexpr int NITEMS = 32 * 136 + 16 * 32 + 5 * 32 * 64 + 2 * 32 * 176 + 88 * 64 + 32 + 32 + 64;
    for (int it = gw; it < NITEMS; it += NGW) {
        int r = it;
        TR_MAT(F.in[9], DM, DIN, ws + WS_WIN, n0)
        TR_MAT(F.in[18], DSSM, DSSM, ws + WS_WGLU, n0)
        TR_MAT(F.in[31], DM, DM, ws + WS_WOUT, n0)
        TR_MAT(F.in[34], DM, DM, ws + WS_WQ, n0)
        TR_MAT(F.in[35], DM, DM, ws + WS_WKV, n0)
        TR_MAT(F.in[36], DM, DM, ws + WS_WKV, 2048 + n0)
        TR_MAT(F.in[37], DM, DM, ws + WS_WO, n0)
        TR_MAT(F.in[40], DM, DFF, ws + WS_WGU, 256 * (n0 / 128) + (n0 % 128))
        TR_MAT(F.in[41], DM, DFF, ws + WS_WGU, 256 * (n0 / 128) + 128 + (n0 % 128))
        TR_MAT(F.in[42], DFF, DM, ws + WS_WDN, n0)
        TR_MAT(F.in[22], 64, DRW, ws + WS_W2T, n0)
        TR_MAT(F.in[24], 64, DRW, ws + WS_A2T, n0)
        TR_MAT(F.in[25], 128, DRW, ws + WS_G2T, n0)
    }
#undef TR_MAT
    const size_t gt = (size_t)F.bid * NTHR + F.tid, NGT = (size_t)F.G * NTHR;
    { const f32x4* xp = (const f32x4*)F.in[0]; const f32x4* xs = (const f32x4*)F.in[1]; v4u* xb = (v4u*)(ws + WS_XB);
      const size_t np = (size_t)MP * DM / 8, nt = (size_t)MT * DM / 8;
      for (size_t i = gt; i < nt; i += NGT) { const f32x4* s = i < np ? xp + 2 * i : xs + 2 * (i - np); const f32x4 a = s[0], b = s[1]; xb[i] = pg8::pack8(a, b); } }
    { const f32x4* mp = (const f32x4*)F.in[2]; v4u* mb = (v4u*)(ws + WS_MB); const size_t nm = (size_t)1024 * DM / 8;
      for (size_t i = gt; i < nm; i += NGT) { const f32x4 a = mp[2 * i], b = mp[2 * i + 1]; mb[i] = pg8::pack8(a, b); } }
}

__device__ __forceinline__ void p2_prep(Frame& F) {
    const float* H = (const float*)(F.ws + WS_H);
    const float* mu = F.in[20]; const float* w0 = F.in[21]; const float* a0 = F.in[23]; const float* k_k = F.in[26]; const float* k_a = F.in[27]; const float* r_k = F.in[28];
    const bf16* W2T = (const bf16*)(F.ws + WS_W2T); const bf16* A2T = (const bf16*)(F.ws + WS_A2T); const bf16* G2T = (const bf16*)(F.ws + WS_G2T);
    float* PR = (float*)(F.ws + WS_PREP); constexpr size_t PS = PREP_STRIDE / 4;
    float* BON = (float*)(F.ws + WS_BONUS);
    const int lane = F.lane, fr = lane & 15, fq = lane >> 4;
    for (int tile = F.bid; tile < MT / 16; tile += F.G) {
        const int m = tile * 16 + fr;
        const float* prow = H + (size_t)m * DIN + 1024;
        const bool prompt = m < MP; const int t = prompt ? (m & 2047) : ((m - MP) & 3);
        const float* qrow = prow - DIN; float qs = 1.0f;
        if (t == 0) { if (prompt) { qrow = prow; qs = 0.0f; } else qrow = F.in[6] + (size_t)((m - MP) >> 2) * DSH; }
#define PS4(col) ({ const f32x4 p_ = *(const f32x4*)(prow + (col)); const f32x4 q_ = *(const f32x4*)(qrow + (col)) * qs; const f32x4 m_ = *(const f32x4*)(mu + (col)); p_ + (q_ - p_) * m_; })
        bf16x8 bw[2], ba[2], bg[4];
#pragma unroll
        for (int kc = 0; kc < 2; ++kc) { f32x4 x0 = PS4(3072 + 32 * kc + 8 * fq), x1 = PS4(3072 + 32 * kc + 8 * fq + 4);
#pragma unroll
            for (int j = 0; j < 4; ++j) { x0[j] = tanh_(x0[j]); x1[j] = tanh_(x1[j]); }
            bw[kc] = pack_bf8(x0, x1);
            const f32x4 y0 = PS4(3136 + 32 * kc + 8 * fq), y1 = PS4(3136 + 32 * kc + 8 * fq + 4); ba[kc] = pack_bf8(y0, y1); }
#pragma unroll
        for (int kc = 0; kc < 4; ++kc) { f32x4 x0 = PS4(3200 + 32 * kc + 8 * fq), x1 = PS4(3200 + 32 * kc + 8 * fq + 4);
#pragma unroll
            for (int j = 0; j < 4; ++j) { x0[j] = sigm(x0[j]); x1[j] = sigm(x1[j]); }
            bg[kc] = pack_bf8(x0, x1); }
#pragma unroll 1
        for (int hi = 0; hi < 2; ++hi) {
            const int hd = 2 * F.wave + hi;
            f32x4 accW[4], accA[4], accG[4];
#pragma unroll
            for (int ct = 0; ct < 4; ++ct) { const int c = 64 * hd + 16 * ct + fr;
                accW[ct] = (f32x4){0.f, 0.f, 0.f, 0.f}; accA[ct] = accW[ct]; accG[ct] = accW[ct];
#pragma unroll
                for (int kc = 0; kc < 2; ++kc) { accW[ct] = MFMA16(*(const bf16x8*)(W2T + c * 64 + 32 * kc + 8 * fq), bw[kc], accW[ct]);
                                                  accA[ct] = MFMA16(*(const bf16x8*)(A2T + c * 64 + 32 * kc + 8 * fq), ba[kc], accA[ct]); }
#pragma unroll
                for (int kc = 0; kc < 4; ++kc) accG[ct] = MFMA16(*(const bf16x8*)(G2T + c * 128 + 32 * kc + 8 * fq), bg[kc], accG[ct]); }
            f32x4 av[4], kkr[4]; float ss = 0.f, bon = 0.f;
#pragma unroll
            for (int ct = 0; ct < 4; ++ct) { const int col = 64 * hd + 16 * ct + 4 * fq; const size_t o = (size_t)m * 1024 + col;
                const f32x4 r4 = PS4(col), k4 = PS4(1024 + col), v4 = PS4(2048 + col);
                const f32x4 w04 = *(const f32x4*)(w0 + col), a04 = *(const f32x4*)(a0 + col), kk4 = *(const f32x4*)(k_k + col), ka4 = *(const f32x4*)(k_a + col), rk4 = *(const f32x4*)(r_k + col);
                f32x4 dec, a, km;
#pragma unroll
                for (int j = 0; j < 4; ++j) { const float z = -(w04[j] + accW[ct][j]); const float sp = fmaxf(z, 0.f) + log1pf(__expf(-fabsf(z))); const float wl = -sp - 0.5f;
                    dec[j] = __expf(-__expf(wl)); a[j] = sigm(a04[j] + accA[ct][j]); km[j] = k4[j] * (1.0f + (a[j] - 1.0f) * ka4[j]);
                    const float kr = k4[j] * kk4[j]; kkr[ct][j] = kr; ss += kr * kr; bon += r4[j] * km[j] * rk4[j]; }
                av[ct] = a;
                *(f32x4*)(PR + 0 * PS + o) = r4; *(f32x4*)(PR + 1 * PS + o) = dec; *(f32x4*)(PR + 2 * PS + o) = km; *(f32x4*)(PR + 3 * PS + o) = v4; *(f32x4*)(PR + 6 * PS + o) = accG[ct]; }
            ss += __shfl_xor(ss, 16); ss += __shfl_xor(ss, 32); bon += __shfl_xor(bon, 16); bon += __shfl_xor(bon, 32);
            const float inv = rsqrtf(fmaxf(ss, 1e-24f));
#pragma unroll
            for (int ct = 0; ct < 4; ++ct) { const size_t o = (size_t)m * 1024 + 64 * hd + 16 * ct + 4 * fq; const f32x4 kk = kkr[ct] * inv;
                *(f32x4*)(PR + 4 * PS + o) = kk; *(f32x4*)(PR + 5 * PS + o) = kk * av[ct]; }
            if (fq == 0) BON[(size_t)m * 16 + hd] = bon;
        }
#undef PS4
    }
    { const int gt = F.bid * NTHR + F.tid, NGT = F.G * NTHR;
      for (int i = gt; i < 132 * (DSH / 4); i += NGT) { const int s = i / (DSH / 4), c4 = i % (DSH / 4);
          const int m = s < 4 ? s * 2048 + 2047 : MP + 4 * (s - 4) + 3;
          float* o = s < 4 ? F.out + O_SH_P + (size_t)s * DSH : F.out + O_SH_S + (size_t)(s - 4) * DSH;
          *(f32x4*)(o + 4 * c4) = *(const f32x4*)(H + (size_t)m * DIN + 1024 + 4 * c4); } }
}

__device__ __forceinline__ void rwkv_scan(Frame& F, int m0, int T, int h, int half, const float* s_in, float* s_out) {
    const float* PR = (const float*)(F.ws + WS_PREP); constexpr size_t PS = PREP_STRIDE / 4;
    float* YR = (float*)(F.ws + WS_YR);
    const int tid = F.tid, lane = F.lane, rr = lane >> 4, kq = lane & 15, v = 32 * half + 4 * F.wave + rr;
    LAS float* buf = (LAS float*)F.lds;
    f32x4 S = (f32x4){0.f, 0.f, 0.f, 0.f};
    if (s_in) S = *(const f32x4*)(s_in + v * 64 + 4 * kq);
    const int nchunk = (T + 31) >> 5, step_l = tid >> 4, part = tid & 15;
    f32x4 st[6];
#pragma unroll
    for (int q = 0; q < 6; ++q) st[q] = (f32x4){0.f, 0.f, 0.f, 0.f};
#define RW_GLOAD(c) do { const int t_ = (c) * 32 + step_l; if (t_ < T) { const size_t off_ = (size_t)(m0 + t_) * 1024 + h * 64 + 4 * part; \
        st[0] = *(const f32x4*)(PR + 1 * PS + off_); st[1] = *(const f32x4*)(PR + 4 * PS + off_); st[2] = *(const f32x4*)(PR + 5 * PS + off_); \
        st[3] = *(const f32x4*)(PR + 2 * PS + off_); st[4] = *(const f32x4*)(PR + 0 * PS + off_); st[5] = *(const f32x4*)(PR + 3 * PS + off_); } } while (0)
#define RW_LSTORE(b) do { LAS float* d_ = buf + (b) * 12288 + step_l * 384 + 4 * part; _Pragma("unroll") for (int q = 0; q < 6; ++q) *(LAS f32x4*)(d_ + q * 64) = st[q]; } while (0)
    RW_GLOAD(0); RW_LSTORE(0); __syncthreads();
    for (int c = 0; c < nchunk; ++c) {
        const int cur = c & 1;
        if (c + 1 < nchunk) RW_GLOAD(c + 1);
        const int nst = (T - 32 * c) < 32 ? (T - 32 * c) : 32;
        const LAS float* cb = buf + cur * 12288;
#pragma unroll 4
        for (int s = 0; s < nst; ++s) {
            const LAS float* sb = cb + s * 384;
            const f32x4 w4 = *(const LAS f32x4*)(sb + 4 * kq), kk4 = *(const LAS f32x4*)(sb + 64 + 4 * kq), b4 = *(const LAS f32x4*)(sb + 128 + 4 * kq),
                        k4 = *(const LAS f32x4*)(sb + 192 + 4 * kq), r4 = *(const LAS f32x4*)(sb + 256 + 4 * kq);
            const float vv = sb[320 + v];
            float sa = -((S[0] * kk4[0] + S[1] * kk4[1]) + (S[2] * kk4[2] + S[3] * kk4[3]));
            sa = sum16(sa);
            S = S * w4 + (b4 * sa + k4 * vv);
            float y = (S[0] * r4[0] + S[1] * r4[1]) + (S[2] * r4[2] + S[3] * r4[3]);
            y = sum16(y);
            if (kq == 0) YR[(size_t)(m0 + 32 * c + s) * 1024 + h * 64 + v] = y;
        }
        if (c + 1 < nchunk) RW_LSTORE(cur ^ 1);
        __syncthreads();
    }
#undef RW_GLOAD
#undef RW_LSTORE
    *(f32x4*)(s_out + v * 64 + 4 * kq) = S;
}

template <int SEG> __device__ __forceinline__ void ssm_item(Frame& F, int g, int sel) {
    const float* H = (const float*)(F.ws + WS_H);
    bf16* YG = (bf16*)(F.ws + WS_YGB);
    const int lane = F.lane, n = lane & 31, hh = lane >> 5, fr = lane & 15, fq = lane >> 4;
    LAS bf16* ldsS = (LAS bf16*)(F.lds + F.wave * 8704);
    const float dt = __expf(F.in[17][g]);
    float lr[2], li[2]; bf16x8 Bre[2], Bim[2];
#pragma unroll
    for (int pp = 0; pp < 2; ++pp) { const int p = 2 * n + pp; const float are = F.in[10][g * 64 + p], aim = F.in[11][g * 64 + p];
        const float mag = expf(are * dt), ang = aim * dt; float sn, cs; sincosf(ang, &sn, &cs); lr[pp] = mag * cs; li[pp] = mag * sn;
        const float sh = sinf(0.5f * ang); const float xr = expm1f(are * dt) * cs - 2.0f * sh * sh, xi = mag * sn;
        const float den = 1.0f / (are * are + aim * aim); const float qr = (xr * are + xi * aim) * den, qi = (xi * are - xr * aim) * den;
        const float* brp = F.in[12] + (size_t)(g * 64 + p) * 16 + 8 * hh; const float* bip = F.in[13] + (size_t)(g * 64 + p) * 16 + 8 * hh;
        const f32x4 br0 = *(const f32x4*)brp, br1 = *(const f32x4*)(brp + 4), bi0 = *(const f32x4*)bip, bi1 = *(const f32x4*)(bip + 4);
        Bre[pp] = pack_bf8(br0 * qr - bi0 * qi, br1 * qr - bi1 * qi); Bim[pp] = pack_bf8(bi0 * qr + br0 * qi, bi1 * qr + br1 * qi); }
    bf16x8 Cop[4];
#pragma unroll
    for (int kc = 0; kc < 4; ++kc) { const float* cp = (kc < 2 ? F.in[14] : F.in[15]) + (size_t)(g * 16 + fr) * 64 + 32 * (kc & 1) + 8 * fq; const float sg = kc < 2 ? 1.0f : -1.0f;
        Cop[kc] = pack_bf8(*(const f32x4*)cp * sg, *(const f32x4*)(cp + 4) * sg); }
    const f32x4 d4 = *(const f32x4*)(F.in[16] + 16 * g + 4 * fq);
    float sre[2] = {0.f, 0.f}, sim[2] = {0.f, 0.f};
    const int ntile = SEG == 16 ? 128 : 1;
    const int hr = (n >> 2) & 1, ir = 4 * (n >> 3) + (n & 3);
    for (int tile = 0; tile < ntile; ++tile) {
        const int arow = SEG == 16 ? (2 * sel + hr) * 2048 + tile * 16 + ir : MP + 4 * (8 * sel + 4 * hr + (ir >> 2)) + (ir & 3);
        const float* up = H + (size_t)arow * DIN + 16 * g + 8 * hh;
        const bf16x8 A1 = pack_bf8(*(const f32x4*)up, *(const f32x4*)(up + 4));
        const f32x16 z16 = {0.f, 0.f, 0.f, 0.f, 0.f, 0.f, 0.f, 0.f, 0.f, 0.f, 0.f, 0.f, 0.f, 0.f, 0.f, 0.f};
        f32x16 aRe[2], aIm[2];
#pragma unroll
        for (int pp = 0; pp < 2; ++pp) { aRe[pp] = MFMA32(A1, Bre[pp], z16); aIm[pp] = MFMA32(A1, Bim[pp], z16); }
#pragma unroll
        for (int i = 0; i < 16; ++i) {
            if (SEG == 4 && (i & 3) == 0) { const int batch = 8 * sel + 4 * hh + (i >> 2); const size_t so = (size_t)(batch * 64 + g) * 64 + 2 * n;
                const f32x2 a = *(const f32x2*)(F.in[3] + so), b = *(const f32x2*)(F.in[4] + so); sre[0] = a[0]; sre[1] = a[1]; sim[0] = b[0]; sim[1] = b[1]; }
#pragma unroll
            for (int pp = 0; pp < 2; ++pp) { const float nr = lr[pp] * sre[pp] - li[pp] * sim[pp] + aRe[pp][i], ni = lr[pp] * sim[pp] + li[pp] * sre[pp] + aIm[pp][i]; sre[pp] = nr; sim[pp] = ni; }
            *(LAS unsigned*)(ldsS + (16 * hh + i) * 136 + 2 * n) = pk2(sre[0], sre[1]);
            *(LAS unsigned*)(ldsS + (16 * hh + i) * 136 + 64 + 2 * n) = pk2(sim[0], sim[1]);
            if (SEG == 4 && (i & 3) == 3) { const int batch = 8 * sel + 4 * hh + (i >> 2); const size_t so = (size_t)(batch * 64 + g) * 64 + 2 * n;
                *(f32x2*)(F.out + O_SRE_S + so) = (f32x2){sre[0], sre[1]}; *(f32x2*)(F.out + O_SIM_S + so) = (f32x2){sim[0], sim[1]}; }
        }
        LDS_WAIT(); asm volatile("" ::: "memory");
#pragma unroll
        for (int rg = 0; rg < 2; ++rg) {
            f32x4 aY = (f32x4){0.f, 0.f, 0.f, 0.f};
#pragma unroll
            for (int kc = 0; kc < 4; ++kc) aY = MFMA16(Cop[kc], *(const LAS bf16x8*)(ldsS + (16 * rg + fr) * 136 + 32 * kc + 8 * fq), aY);
            const int orow = SEG == 16 ? (2 * sel + rg) * 2048 + tile * 16 + fr : MP + 4 * (8 * sel + 4 * rg + (fr >> 2)) + (fr & 3);
            const f32x4 u4 = *(const f32x4*)(H + (size_t)orow * DIN + 16 * g + 4 * fq);
            const f32x4 y = aY + d4 * u4;
            v2u w; w.x = pk2(gelu_tanh(y[0]), gelu_tanh(y[1])); w.y = pk2(gelu_tanh(y[2]), gelu_tanh(y[3]));
            *(v2u*)(YG + (size_t)orow * 1024 + 16 * g + 4 * fq) = w;
        }
        LDS_WAIT(); asm volatile("" ::: "memory");
    }
    if (SEG == 16) { const size_t so = (size_t)((2 * sel + hh) * 64 + g) * 64 + 2 * n;
        *(f32x2*)(F.out + O_SRE_P + so) = (f32x2){sre[0], sre[1]}; *(f32x2*)(F.out + O_SIM_P + so) = (f32x2){sim[0], sim[1]}; }
}

__device__ __forceinline__ void p3_scans(Frame& F) {
    unsigned* ctr = (unsigned*)(F.ws + WS_CTL);
    constexpr int N_RP = 128, N_SP = 64, N_RS = 2048, N_SS = 128, TOTAL = N_RP + N_SP + N_RS + N_SS;
    for (;;) {
        __syncthreads();
        if (F.tid == 0) F.MISC[0] = atomicAdd(ctr, 1u);
        __syncthreads();
        int it = (int)F.MISC[0];
        if (it >= TOTAL) break;
        if (it < N_RP) { const int b = it >> 5, h = (it >> 1) & 15, half = it & 1;
            rwkv_scan(F, b * 2048, 2048, h, half, nullptr, F.out + O_WKV_P + (size_t)(b * 16 + h) * 4096); continue; }
        it -= N_RP;
        if (it < N_SP) { if (F.wave < 2) ssm_item<16>(F, it, F.wave); continue; }
        it -= N_SP;
        if (it < N_RS) { const int b = it >> 4, h = it & 15; const size_t so = (size_t)(b * 16 + h) * 4096;
            rwkv_scan(F, MP + 4 * b, 4, h, 0, F.in[5] + so, F.out + O_WKV_S + so);
            rwkv_scan(F, MP + 4 * b, 4, h, 1, F.in[5] + so, F.out + O_WKV_S + so); continue; }
        it -= N_RS;
        { const int wi = it * 8 + F.wave; ssm_item<4>(F, wi >> 4, wi & 15); }
    }
}

__device__ __forceinline__ void p4_post(Frame& F) {
    unsigned* ctr = (unsigned*)(F.ws + WS_CTL) + 64;
    const float* PR = (const float*)(F.ws + WS_PREP); constexpr size_t PS = PREP_STRIDE / 4;
    const float* YR = (const float*)(F.ws + WS_YR); const float* BON = (const float*)(F.ws + WS_BONUS);
    const float* lg = F.in[29]; const float* lb = F.in[30];
    bf16* MIX = (bf16*)(F.ws + WS_MIX);
    const int lane = F.lane;
    for (;;) {
        __syncthreads();
        if (F.tid == 0) F.MISC[0] = atomicAdd(ctr, 1u);
        __syncthreads();
        const int it = (int)F.MISC[0];
        if (it >= MT / 16) break;
#pragma unroll 1
        for (int q = 0; q < 2; ++q) { const int m = it * 16 + 2 * F.wave + q;
#pragma unroll
            for (int j = 0; j < 4; ++j) { const int col = 256 * j + 4 * lane, hd = 4 * j + (lane >> 4); const size_t o = (size_t)m * 1024 + col;
                const f32x4 y = *(const f32x4*)(YR + o);
                const float mean = sum16((y[0] + y[1]) + (y[2] + y[3])) * (1.0f / 64.0f);
                const f32x4 d = y - mean;
                const float var = sum16((d[0] * d[0] + d[1] * d[1]) + (d[2] * d[2] + d[3] * d[3])) * (1.0f / 64.0f);
                const float rstd = rsqrtf(var + GN_EPS), bon = BON[(size_t)m * 16 + hd];
                const f32x4 v4 = *(const f32x4*)(PR + 3 * PS + o), g4 = *(const f32x4*)(PR + 6 * PS + o), lg4 = *(const f32x4*)(lg + col), lb4 = *(const f32x4*)(lb + col);
                const f32x4 ov = (d * rstd * lg4 + lb4 + v4 * bon) * g4;
                v2u w; w.x = pk2(ov[0], ov[1]); w.y = pk2(ov[2], ov[3]);
                *(v2u*)(MIX + (size_t)m * 2048 + 1024 + col) = w; } }
    }
}

__device__ __forceinline__ void ln_rows(Frame& F, const float* src, const float* gam, const float* bet, float* dstf, bf16* dstb) {
    const int gw = F.bid * NWAVES + F.wave, NGW = F.G * NWAVES, lane = F.lane;
    f32x4 gg[8], bb[8];
#pragma unroll
    for (int j = 0; j < 8; ++j) { gg[j] = *(const f32x4*)(gam + 4 * (lane + 64 * j)); bb[j] = *(const f32x4*)(bet + 4 * (lane + 64 * j)); }
    for (int row = gw; row < MT; row += NGW) {
        const f32x4* s = (const f32x4*)(src + (size_t)row * DM) + lane; f32x4 v[8]; float sm = 0.f;
#pragma unroll
        for (int j = 0; j < 8; ++j) { v[j] = s[64 * j]; sm += (v[j][0] + v[j][1]) + (v[j][2] + v[j][3]); }
        const float mean = wave_sum(sm) * (1.0f / DM); float s2 = 0.f;
#pragma unroll
        for (int j = 0; j < 8; ++j) { v[j] = v[j] - mean; s2 += (v[j][0] * v[j][0] + v[j][1] * v[j][1]) + (v[j][2] * v[j][2] + v[j][3] * v[j][3]); }
        const float rstd = rsqrtf(wave_sum(s2) * (1.0f / DM) + LN_EPS);
#pragma unroll
        for (int j = 0; j < 8; ++j) { const f32x4 o = v[j] * rstd * gg[j] + bb[j];
            if (dstf) *((f32x4*)(dstf + (size_t)row * DM) + lane + 64 * j) = o;
            if (dstb) { v2u w; w.x = pk2(o[0], o[1]); w.y = pk2(o[2], o[3]); *((v2u*)(dstb + (size_t)row * DM) + lane + 64 * j) = w; } }
    }
}

__device__ __forceinline__ void attn_prompt_unit(Frame& F, int b, int h, int qt) {
    const bf16* Qb = (const bf16*)(F.ws + WS_QB); const bf16* Kb = (const bf16*)(F.ws + WS_KB); const bf16* VT = (const bf16*)(F.ws + WS_VTB);
    bf16* Ob = (bf16*)(F.ws + WS_OB);
    const int lane = F.lane, fr = lane & 15, fq = lane >> 4;
    const int m = b * 2048 + qt * 128 + 16 * F.wave + fr;
    bf16x8 Qf[16];
#pragma unroll
    for (int kc = 0; kc < 16; ++kc) Qf[kc] = *(const bf16x8*)(Qb + (size_t)m * DM + h * 512 + 32 * kc + 8 * fq);
    f32x4 s[8][2];
#pragma unroll
    for (int c = 0; c < 8; ++c)
#pragma unroll
        for (int sb = 0; sb < 2; ++sb) { const int mem = 32 * c + 8 * (fr >> 2) + 4 * sb + (fr & 3);
            const bf16* krow = Kb + (size_t)(b * NMEM + mem) * DM + h * 512 + 8 * fq; f32x4 acc = (f32x4){0.f, 0.f, 0.f, 0.f};
#pragma unroll
            for (int kc = 0; kc < 16; ++kc) acc = MFMA16(*(const bf16x8*)(krow + 32 * kc), Qf[kc], acc);
            s[c][sb] = acc; }
    float mx = -3.0e38f;
#pragma unroll
    for (int c = 0; c < 8; ++c)
#pragma unroll
        for (int sb = 0; sb < 2; ++sb)
#pragma unroll
            for (int j = 0; j < 4; ++j) mx = fmaxf(mx, s[c][sb][j]);
    mx = fmaxf(mx, __shfl_xor(mx, 16)); mx = fmaxf(mx, __shfl_xor(mx, 32));
    const float sc2 = 0.044194173824159216f * 1.4426950408889634f;
    float sum = 0.f;
#pragma unroll
    for (int c = 0; c < 8; ++c)
#pragma unroll
        for (int sb = 0; sb < 2; ++sb)
#pragma unroll
            for (int j = 0; j < 4; ++j) { const float p = exp2f((s[c][sb][j] - mx) * sc2); s[c][sb][j] = p; sum += p; }
    sum += __shfl_xor(sum, 16); sum += __shfl_xor(sum, 32);
    const float inv = 1.0f / sum;
    bf16x8 Pf[8];
#pragma unroll
    for (int c = 0; c < 8; ++c) Pf[c] = pack_bf8(s[c][0] * inv, s[c][1] * inv);
#pragma unroll 4
    for (int dt = 0; dt < 32; ++dt) { const bf16* vrow = VT + (size_t)(h * 512 + 16 * dt + fr) * 1024 + b * NMEM + 8 * fq; f32x4 acc = (f32x4){0.f, 0.f, 0.f, 0.f};
#pragma unroll
        for (int c = 0; c < 8; ++c) acc = MFMA16(*(const bf16x8*)(vrow + 32 * c), Pf[c], acc);
        v2u w; w.x = pk2(acc[0], acc[1]); w.y = pk2(acc[2], acc[3]);
        *(v2u*)(Ob + (size_t)m * DM + h * 512 + 16 * dt + 4 * fq) = w; }
}
__device__ __forceinline__ void attn_sample_unit(Frame& F, int b, int h) {
    const bf16* Qb = (const bf16*)(F.ws + WS_QB); bf16* Ob = (bf16*)(F.ws + WS_OB);
    const float* CK = F.in[7]; const float* CV = F.in[8];
    LAS float* sc = (LAS float*)F.lds; LAS float* Pm = (LAS float*)(F.lds + 4096); LAS float* red = (LAS float*)(F.lds + 8192);
    const int lane = F.lane, fr = lane & 15, fq = lane >> 4, w = F.wave, tid = F.tid;
    bf16x8 Qf[16];
#pragma unroll
    for (int kc = 0; kc < 16; ++kc) { const bf16x8 z = {0, 0, 0, 0, 0, 0, 0, 0};
        Qf[kc] = fr < 4 ? *(const bf16x8*)(Qb + (size_t)(MP + 4 * b + fr) * DM + h * 512 + 32 * kc + 8 * fq) : z; }
#pragma unroll
    for (int tl = 0; tl < 2; ++tl) { const int mem = 32 * w + 16 * tl + fr; const float* krow = CK + (size_t)(b * NMEM + mem) * DM + h * 512 + 8 * fq; f32x4 acc = (f32x4){0.f, 0.f, 0.f, 0.f};
#pragma unroll
        for (int kc = 0; kc < 16; ++kc) acc = MFMA16(pack_bf8(*(const f32x4*)(krow + 32 * kc), *(const f32x4*)(krow + 32 * kc + 4)), Qf[kc], acc);
        if (fr < 4) *(LAS f32x4*)(sc + fr * 256 + 32 * w + 16 * tl + 4 * fq) = acc * 0.044194173824159216f; }
    __syncthreads();
    if (w < 4) { const f32x4 v = *(const LAS f32x4*)(sc + w * 256 + 4 * lane);
        const float mx = wave_max(fmaxf(fmaxf(v[0], v[1]), fmaxf(v[2], v[3])));
        f32x4 e; e[0] = __expf(v[0] - mx); e[1] = __expf(v[1] - mx); e[2] = __expf(v[2] - mx); e[3] = __expf(v[3] - mx);
        const float inv = 1.0f / wave_sum((e[0] + e[1]) + (e[2] + e[3]));
#pragma unroll
        for (int j = 0; j < 4; ++j) Pm[(4 * lane + j) * 4 + w] = e[j] * inv; }
    __syncthreads();
    f32x4 a0[4], a1[4];
#pragma unroll
    for (int q = 0; q < 4; ++q) { a0[q] = (f32x4){0.f, 0.f, 0.f, 0.f}; a1[q] = a0[q]; }
#pragma unroll 8
    for (int i = 0; i < 32; ++i) { const int mem = 32 * w + i; const float* vrow = CV + (size_t)(b * NMEM + mem) * DM + h * 512;
        const f32x4 v0 = *(const f32x4*)(vrow + 4 * lane), v1 = *(const f32x4*)(vrow + 256 + 4 * lane); const f32x4 p4 = *(const LAS f32x4*)(Pm + mem * 4);
#pragma unroll
        for (int q = 0; q < 4; ++q) { a0[q] += v0 * p4[q]; a1[q] += v1 * p4[q]; } }
#pragma unroll
    for (int q = 0; q < 4; ++q) { *(LAS f32x4*)(red + (w * 4 + q) * 512 + 4 * lane) = a0[q]; *(LAS f32x4*)(red + (w * 4 + q) * 512 + 256 + 4 * lane) = a1[q]; }
    __syncthreads();
    { const int q = tid >> 7, d4 = (tid & 127) * 4; f32x4 o = (f32x4){0.f, 0.f, 0.f, 0.f};
#pragma unroll
      for (int ww = 0; ww < 8; ++ww) o += *(const LAS f32x4*)(red + (ww * 4 + q) * 512 + d4);
      v2u pw; pw.x = pk2(o[0], o[1]); pw.y = pk2(o[2], o[3]);
      *(v2u*)(Ob + (size_t)(MP + 4 * b + q) * DM + h * 512 + d4) = pw; }
    __syncthreads();
}
__device__ __forceinline__ void p8_attn(Frame& F) {
#ifndef MK_ATT_SKIP
#define MK_ATT_SKIP 0
#endif
    if (MK_ATT_SKIP != 1) for (int u = F.bid; u < 512; u += F.G) attn_sample_unit(F, u >> 2, u & 3);
    if (MK_ATT_SKIP != 2) for (int u = F.bid; u < 256; u += F.G) attn_prompt_unit(F, u >> 6, (u >> 4) & 3, u & 15);
}

template <bool COOP>
__global__ void __launch_bounds__(NTHR, 2) mk_fwd(Args args) {
    extern __shared__ __attribute__((aligned(16))) unsigned char lds_raw[];
    Frame F;
    F.lds = (LAS unsigned char*)lds_raw; F.MISC = (volatile LAS unsigned*)(F.lds + MISC_OFF);
    F.tid = threadIdx.x; F.lane = F.tid & 63; F.wave = __builtin_amdgcn_readfirstlane(F.tid >> 6); F.G = gridDim.x; F.bid = blockIdx.x;
    F.in = args.in; F.out = args.out; F.ws = args.ws;
    unsigned char* ws = args.ws;
    const int lo = args.lo, hi = args.hi, bid = F.bid, G = F.G;
#define IN(k) (lo <= (k) && (k) < hi)
#define SEAM(k) do { if (COOP) { if (IN(k) && IN((k) + 1)) cg::this_grid().sync(); } } while (0)
    using pg8::Gemm; using pg8::StaticOrder; using pg8::gemm_phase;
    bf16* XB = (bf16*)(ws + WS_XB); float* Hh = (float*)(ws + WS_H); float* R = (float*)(ws + WS_R); float* X = (float*)(ws + WS_X);

    if (IN(0)) { p0_prologue(F); } SEAM(0);
    if (IN(1)) {
        { Gemm g{XB, (const bf16*)(ws + WS_WIN), MT, DIN, DM}; StaticOrder S; S.init(MT, DIN, G, bid); pg8::EpiF32 E{Hh, DIN};
          gemm_phase<pg8::EpiF32, StaticOrder, true, true>(F.lds, g, S, E); }
        { Gemm g{(const bf16*)(ws + WS_MB), (const bf16*)(ws + WS_WKV), 1024, 4096, DM}; StaticOrder S; S.init(1024, 4096, G, (bid + G - 66) % G);
          pg8::EpiMemKV E{F.out + O_MK, F.out + O_MV, (bf16*)(ws + WS_KB)};
          gemm_phase<pg8::EpiMemKV, StaticOrder, true, true>(F.lds, g, S, E); }
        { Gemm g{(const bf16*)(ws + WS_WKV) + (size_t)2048 * DM, (const bf16*)(ws + WS_MB), 2048, 1024, DM}; StaticOrder S; S.init(2048, 1024, G, (bid + G - 130) % G);
          pg8::EpiBf16S E{(bf16*)(ws + WS_VTB), 1024};
          gemm_phase<pg8::EpiBf16S, StaticOrder, true, true>(F.lds, g, S, E); }
    } SEAM(1);
    if (IN(2)) { p2_prep(F); } SEAM(2);
    if (IN(3)) { p3_scans(F); } SEAM(3);
    if (IN(4)) {
        { Gemm g{(const bf16*)(ws + WS_YGB), (const bf16*)(ws + WS_WGLU), MT, DSSM, DSSM}; StaticOrder S; S.init(MT, DSSM, G, bid);
          pg8::EpiGlu E{(const bf16*)(ws + WS_YGB), 1024, F.in[19], (bf16*)(ws + WS_MIX), 2048};
          gemm_phase<pg8::EpiGlu, StaticOrder, true, true>(F.lds, g, S, E); }
        p4_post(F);
    } SEAM(4);
    if (IN(5)) { Gemm g{(const bf16*)(ws + WS_MIX), (const bf16*)(ws + WS_WOUT), MT, DM, DM}; StaticOrder S; S.init(MT, DM, G, bid);
        pg8::EpiRes E{F.in[0], F.in[1], R, DM, ALPHA};
        gemm_phase<pg8::EpiRes, StaticOrder, true, true>(F.lds, g, S, E); } SEAM(5);
    if (IN(6)) { ln_rows(F, R, F.in[32], F.in[33], X, XB); } SEAM(6);
    if (IN(7)) { Gemm g{XB, (const bf16*)(ws + WS_WQ), MT, DM, DM}; StaticOrder S; S.init(MT, DM, G, bid);
        pg8::EpiBf16S E{(bf16*)(ws + WS_QB), DM};
        gemm_phase<pg8::EpiBf16S, StaticOrder, true, true>(F.lds, g, S, E); } SEAM(7);
    if (IN(8)) { p8_attn(F); } SEAM(8);
    if (IN(9)) { Gemm g{(const bf16*)(ws + WS_OB), (const bf16*)(ws + WS_WO), MT, DM, DM}; StaticOrder S; S.init(MT, DM, G, bid);
        pg8::EpiRes E{X, X + (size_t)MP * DM, R, DM, ALPHA};
        gemm_phase<pg8::EpiRes, StaticOrder, true, true>(F.lds, g, S, E); } SEAM(9);
    if (IN(10)) { ln_rows(F, R, F.in[38], F.in[39], X, XB); } SEAM(10);
    if (IN(11)) { Gemm g{XB, (const bf16*)(ws + WS_WGU), MT, 2 * DFF, DM}; StaticOrder S; S.init(MT, 2 * DFF, G, bid);
        pg8::EpiSwiGLU E{(bf16*)(ws + WS_HFF), DFF};
        gemm_phase<pg8::EpiSwiGLU, StaticOrder, true, true>(F.lds, g, S, E); } SEAM(11);
    if (IN(12)) { Gemm g{(const bf16*)(ws + WS_HFF), (const bf16*)(ws + WS_WDN), MT, DM, DFF}; StaticOrder S; S.init(MT, DM, G, bid);
        pg8::EpiRes E{X, X + (size_t)MP * DM, R, DM, ALPHA};
        gemm_phase<pg8::EpiRes, StaticOrder, true, true>(F.lds, g, S, E); } SEAM(12);
    if (IN(13)) { ln_rows(F, R, F.in[43], F.in[44], F.out + O_Y, nullptr); }
#undef IN
#undef SEAM
}

#ifndef MK_COOP
#define MK_COOP 0
#endif
#ifndef MK_PH_HI
#define MK_PH_HI NPHASE
#endif
extern "C" void kernel_launch(void* const* d_in, const int* in_sizes, int n_in, void* d_out, int out_size, void* d_ws, size_t ws_size, hipStream_t stream) {
    static int grid = 0;
    if (grid == 0) {
        if (n_in != 45 || out_size != (int)O_END || ws_size < WS_END) { fprintf(stderr, "kernel_launch: unexpected shapes (n_in %d out %d ws %zu)\n", n_in, out_size, ws_size); grid = -1; return; }
        int dev = 0, cus = 0, per_cu = 0;
        (void)hipGetDevice(&dev); (void)hipDeviceGetAttribute(&cus, hipDeviceAttributeMultiprocessorCount, dev);
        (void)hipFuncSetAttribute((const void*)mk_fwd<true>, hipFuncAttributeMaxDynamicSharedMemorySize, LDS_BYTES);
        (void)hipFuncSetAttribute((const void*)mk_fwd<false>, hipFuncAttributeMaxDynamicSharedMemorySize, LDS_BYTES);
        (void)hipOccupancyMaxActiveBlocksPerMultiprocessor(&per_cu, (const void*)mk_fwd<true>, NTHR, LDS_BYTES);
        (void)hipGetLastError();
        if (per_cu < 1) { fprintf(stderr, "kernel_launch: occupancy query says %d blocks per CU\n", per_cu); per_cu = 1; }
        grid = cus;
    }
    if (grid < 0) return;
    (void)hipMemsetAsync((char*)d_ws + WS_CTL, 0, 4096, stream);
    if (MK_PH_HI < NPHASE) (void)hipMemsetAsync(d_out, 0, (size_t)out_size * 4, stream);
#ifdef MK_DUMP_OFF
#ifndef MK_DUMP_BYTES
#define MK_DUMP_BYTES ((size_t)MT * DM * 4)
#endif
#define MK_DUMP_AFTER (void)hipMemcpyAsync(d_out, (char*)d_ws + (MK_DUMP_OFF), MK_DUMP_BYTES, hipMemcpyDeviceToDevice, stream);
#else
#define MK_DUMP_AFTER
#endif
    Args a{};
    for (int i = 0; i < 45; ++i) a.in[i] = (const float*)d_in[i];
    a.out = (float*)d_out; a.ws = (unsigned char*)d_ws;
#if MK_COOP
    a.lo = 0; a.hi = MK_PH_HI;
    void* kargs[] = {&a};
    hipError_t e = hipLaunchCooperativeKernel((const void*)mk_fwd<true>, dim3(grid), dim3(NTHR), kargs, LDS_BYTES, stream);
    if (e != hipSuccess) fprintf(stderr, "cooperative launch failed: %s (grid %d)\n", hipGetErrorString(e), grid);
#else
    for (int p = 0; p < MK_PH_HI; ++p) { a.lo = p; a.hi = p + 1; hipLaunchKernelGGL(mk_fwd<false>, dim3(grid), dim3(NTHR), LDS_BYTES, stream, a); }
#endif
    MK_DUMP_AFTER
}
```

```cpp
#include <hip/hip_runtime.h>
#include <hip/hip_cooperative_groups.h>
#include <cstdio>
#include <cstdint>
namespace cg = cooperative_groups;
#define MK_COOP 1
namespace pg8 {
#define PG8_LAS __attribute__((address_space(3)))
typedef unsigned short bf16_t;
typedef short bf16x8 __attribute__((ext_vector_type(8)));
typedef float f32x4 __attribute__((ext_vector_type(4)));
typedef unsigned u32x4 __attribute__((ext_vector_type(4)));
constexpr int BM = 256, BK = 64, HALF = 128, HTB = HALF * BK * 2  , STAGE_BYTES = 8 * HTB, NXCD = 8, WGM = 8;

__host__ __device__ __forceinline__ int lds_byte(int r, int c) { const int st = (r >> 4) * 2 + (c >> 5), rr = r & 15, cc = c & 31, ob = rr * 64 + cc * 2; return st * 1024 + (ob ^ (((ob >> 9) & 1) << 5)); }
__host__ __device__ __forceinline__ void stage_rc(int b, int& R, int& C) { const int st = b / 1024, sb = b % 1024, swz = sb ^ (((sb >> 9) & 1) << 5); R = (st >> 1) * 16 + swz / 64; C = (st & 1) * 32 + (swz % 64) / 2; }
__host__ __device__ __forceinline__ int perm32(int rho) { const int n = rho >> 4, i = rho & 15; return 8 * (i >> 2) + 4 * n + (i & 3); }

struct Unit { int pm, pn; };
struct Gemm { const bf16_t* A; const bf16_t* Bt; int M, N, K; };

struct StaticOrder {
    int nM, nN, nwg, G, c;
    __host__ __device__ void init(int M, int N, int G_, int c_) { nM = M / BM; nN = N / BM; nwg = nM * nN; G = G_; c = c_; }
    __host__ __device__ bool next(int i, Unit& u) const {
        const long L = (long)i * G + c; if (L >= nwg) return false;
        int wgid = (int)L; { const int q = nwg / NXCD, r = nwg % NXCD, xcd = wgid % NXCD, off = wgid / NXCD; wgid = (xcd < r ? xcd * (q + 1) : r * (q + 1) + (xcd - r) * q) + off; }
        const int nig = WGM * nN, gid = wgid / nig, fm = gid * WGM, gsz = (nM - fm) < WGM ? (nM - fm) : WGM;
        u.pm = fm + ((wgid % nig) % gsz); u.pn = (wgid % nig) / gsz; return true;
    }
    __device__ __forceinline__ void a_ready(const Unit&) const {}
    __device__ __forceinline__ void done(const Unit&) const {}
};
typedef float f32x2_cv __attribute__((ext_vector_type(2))); typedef __bf16 bf16x2_cv __attribute__((ext_vector_type(2)));
__device__ __forceinline__ unsigned cvt_pk_bf16(float lo, float hi) { const f32x2_cv v = {lo, hi}; const bf16x2_cv b = __builtin_convertvector(v, bf16x2_cv); return __builtin_bit_cast(unsigned, b); }

__device__ __forceinline__ float bf_lo(unsigned w) { return __builtin_bit_cast(float, w << 16); }
__device__ __forceinline__ float bf_hi(unsigned w) { return __builtin_bit_cast(float, w & 0xffff0000u); }
__device__ __forceinline__ u32x4 pack8(const f32x4 a, const f32x4 b) { u32x4 w; w.x = cvt_pk_bf16(a[0], a[1]); w.y = cvt_pk_bf16(a[2], a[3]); w.z = cvt_pk_bf16(b[0], b[1]); w.w = cvt_pk_bf16(b[2], b[3]); return w; }
__device__ __forceinline__ float sigmoidf_(float x) { return 1.0f / (1.0f + __expf(-x)); }

struct EpiF32 {
    static constexpr bool PERM = true, AFTER_DRAIN = false;
    float* O; int ldc;
    __device__ __forceinline__ void operator()(const f32x4 (&acc)[2][2][4][2], const Unit& u, int wr, int wc, int fr, int fq) const {
        const int row0 = u.pm * BM + wr * 64 + fr, col0 = u.pn * BM + wc * 32 + 8 * fq;
#pragma unroll
        for (int ai = 0; ai < 2; ++ai)
#pragma unroll
            for (int m = 0; m < 4; ++m) { float* rowp = O + (size_t)(row0 + ai * HALF + m * 16) * ldc + col0;
#pragma unroll
                for (int bj = 0; bj < 2; ++bj) { *(f32x4*)(rowp + bj * HALF) = acc[ai][bj][m][0]; *(f32x4*)(rowp + bj * HALF + 4) = acc[ai][bj][m][1]; } }
    }
};
struct EpiMemKV {
    static constexpr bool PERM = true, AFTER_DRAIN = false;
    float* outK; float* outV; bf16_t* Kb;
    __device__ __forceinline__ void operator()(const f32x4 (&acc)[2][2][4][2], const Unit& u, int wr, int wc, int fr, int fq) const {
        const int row0 = u.pm * BM + wr * 64 + fr; const int colt = u.pn * BM; const bool isV = colt >= 2048;
        float* o = isV ? outV : outK; const int col0 = (isV ? colt - 2048 : colt) + wc * 32 + 8 * fq;
#pragma unroll
        for (int ai = 0; ai < 2; ++ai)
#pragma unroll
            for (int m = 0; m < 4; ++m)
#pragma unroll
                for (int bj = 0; bj < 2; ++bj) { const size_t off = (size_t)(row0 + ai * HALF + m * 16) * 2048 + col0 + bj * HALF;
                    *(f32x4*)(o + off) = acc[ai][bj][m][0]; *(f32x4*)(o + off + 4) = acc[ai][bj][m][1];
                    if (!isV) *(u32x4*)(Kb + off) = pack8(acc[ai][bj][m][0], acc[ai][bj][m][1]); }
    }
};
struct EpiBf16S {
    static constexpr bool PERM = true, AFTER_DRAIN = false;
    bf16_t* O; int ldc;
    __device__ __forceinline__ void operator()(const f32x4 (&acc)[2][2][4][2], const Unit& u, int wr, int wc, int fr, int fq) const {
        const int row0 = u.pm * BM + wr * 64 + fr, col0 = u.pn * BM + wc * 32 + 8 * fq;
#pragma unroll
        for (int ai = 0; ai < 2; ++ai)
#pragma unroll
            for (int m = 0; m < 4; ++m) { bf16_t* rowp = O + (size_t)(row0 + ai * HALF + m * 16) * ldc + col0;
#pragma unroll
                for (int bj = 0; bj < 2; ++bj) *(u32x4*)(rowp + bj * HALF) = pack8(acc[ai][bj][m][0], acc[ai][bj][m][1]); }
    }
};
struct EpiGlu {
    static constexpr bool PERM = true, AFTER_DRAIN = false;
    const bf16_t* Y; int ldy; const float* bias; bf16_t* O; int ldo;
    __device__ __forceinline__ void operator()(const f32x4 (&acc)[2][2][4][2], const Unit& u, int wr, int wc, int fr, int fq) const {
        const int row0 = u.pm * BM + wr * 64 + fr, col0 = u.pn * BM + wc * 32 + 8 * fq;
#pragma unroll
        for (int bj = 0; bj < 2; ++bj) { const f32x4 b0 = *(const f32x4*)(bias + col0 + bj * HALF), b1 = *(const f32x4*)(bias + col0 + bj * HALF + 4);
#pragma unroll
            for (int ai = 0; ai < 2; ++ai)
#pragma unroll
                for (int m = 0; m < 4; ++m) { const int row = row0 + ai * HALF + m * 16;
                    const u32x4 yv = *(const u32x4*)(Y + (size_t)row * ldy + col0 + bj * HALF);
                    const f32x4 a0 = acc[ai][bj][m][0] + b0, a1 = acc[ai][bj][m][1] + b1; f32x4 z0, z1;
                    z0[0] = bf_lo(yv.x) * sigmoidf_(a0[0]); z0[1] = bf_hi(yv.x) * sigmoidf_(a0[1]); z0[2] = bf_lo(yv.y) * sigmoidf_(a0[2]); z0[3] = bf_hi(yv.y) * sigmoidf_(a0[3]);
                    z1[0] = bf_lo(yv.z) * sigmoidf_(a1[0]); z1[1] = bf_hi(yv.z) * sigmoidf_(a1[1]); z1[2] = bf_lo(yv.w) * sigmoidf_(a1[2]); z1[3] = bf_hi(yv.w) * sigmoidf_(a1[3]);
                    *(u32x4*)(O + (size_t)row * ldo + col0 + bj * HALF) = pack8(z0, z1); } }
    }
};
struct EpiRes {
    static constexpr bool PERM = true, AFTER_DRAIN = false;
    const float* base0; const float* base1; float* O; int ld; float alpha;
    __device__ __forceinline__ void operator()(const f32x4 (&acc)[2][2][4][2], const Unit& u, int wr, int wc, int fr, int fq) const {
        const int row0 = u.pm * BM + wr * 64 + fr, col0 = u.pn * BM + wc * 32 + 8 * fq;
        const bool lo = (u.pm * BM) < 8192; const float* bp = lo ? base0 : base1; const int rsub = lo ? 0 : 8192;
#pragma unroll
        for (int ai = 0; ai < 2; ++ai)
#pragma unroll
            for (int m = 0; m < 4; ++m) { const int row = row0 + ai * HALF + m * 16; const float* brow = bp + (size_t)(row - rsub) * ld + col0; float* orow = O + (size_t)row * ld + col0;
#pragma unroll
                for (int bj = 0; bj < 2; ++bj) { const f32x4 x0 = *(const f32x4*)(brow + bj * HALF), x1 = *(const f32x4*)(brow + bj * HALF + 4);
                    *(f32x4*)(orow + bj * HALF) = x0 * alpha + acc[ai][bj][m][0]; *(f32x4*)(orow + bj * HALF + 4) = x1 * alpha + acc[ai][bj][m][1]; } }
    }
};
struct EpiSwiGLU {
    static constexpr bool PERM = true, AFTER_DRAIN = false;
    bf16_t* O; int ldo;
    __device__ __forceinline__ void operator()(const f32x4 (&acc)[2][2][4][2], const Unit& u, int wr, int wc, int fr, int fq) const {
        const int row0 = u.pm * BM + wr * 64 + fr, col0 = u.pn * HALF + wc * 32 + 8 * fq;
#pragma unroll
        for (int ai = 0; ai < 2; ++ai)
#pragma unroll
            for (int m = 0; m < 4; ++m) { f32x4 h0, h1;
#pragma unroll
                for (int j = 0; j < 4; ++j) { const float g0 = acc[ai][0][m][0][j], g1 = acc[ai][0][m][1][j];
                    h0[j] = g0 * sigmoidf_(g0) * acc[ai][1][m][0][j]; h1[j] = g1 * sigmoidf_(g1) * acc[ai][1][m][1][j]; }
                *(u32x4*)(O + (size_t)(row0 + ai * HALF + m * 16) * ldo + col0) = pack8(h0, h1); }
    }
};

template <class Epi, class Sched, bool ALIGN_EPI = false, bool SP2 = false>
__device__ __forceinline__ void gemm_phase(PG8_LAS unsigned char* lds, const Gemm g, const Sched& S, const Epi& E) {
    const int tid = threadIdx.x, wid = __builtin_amdgcn_readfirstlane(tid >> 6), lane = tid & 63, wr = wid >> 2, wc = wid & 3, fr = lane & 15, fq = lane >> 4;
    const int K = g.K, nt = K / BK;
    unsigned voffA[2], voffB[2];
#pragma unroll
    for (int i = 0; i < 2; ++i) { int R, C; stage_rc(tid * 16 + i * 8192, R, C); const int Rb = Epi::PERM ? ((R & ~31) + perm32(R & 31)) : R;
        voffA[i] = (unsigned)(R * K + C) * 2u; voffB[i] = (unsigned)(Rb * K + C) * 2u; }
    const size_t kstep = (size_t)(BK * 2);
    const size_t hstep = (size_t)HALF * K * 2;
    const size_t tstep = 2 * hstep;
    const unsigned ldsw = (unsigned)wid * 1024u;
    const int aoff = lds_byte(wr * 64 + fr, fq * 8), boff = lds_byte(wc * 32 + fr, fq * 8);
#define PG8_SA(b, h) (((b) * 2 + (h)) * HTB)
#define PG8_SB(b, h) ((4 + (b) * 2 + (h)) * HTB)
#define PG8_STAGE(bufoff, gbase, voff) do { _Pragma("unroll") for (int _i = 0; _i < 2; ++_i) \
        __builtin_amdgcn_global_load_lds((const unsigned*)((const char*)(gbase) + (voff)[_i]), (PG8_LAS unsigned*)(lds + (bufoff) + ldsw + _i * 8192), 16, 0, 0); } while (0)
#define PG8_LDA(dst, b, h) do { _Pragma("unroll") for (int m = 0; m < 4; ++m) _Pragma("unroll") for (int k = 0; k < 2; ++k) dst[m][k] = *(const PG8_LAS bf16x8*)(lds + PG8_SA(b, h) + aoff + m * 2048 + k * 1024); } while (0)
#define PG8_LDB(dst, b, h) do { _Pragma("unroll") for (int n = 0; n < 2; ++n) _Pragma("unroll") for (int k = 0; k < 2; ++k) dst[n][k] = *(const PG8_LAS bf16x8*)(lds + PG8_SB(b, h) + boff + n * 2048 + k * 1024); } while (0)
#define PG8_MMA(ai, bj, At, Bt) do { __builtin_amdgcn_s_setprio(1); _Pragma("unroll") for (int m = 0; m < 4; ++m) _Pragma("unroll") for (int n = 0; n < 2; ++n) _Pragma("unroll") for (int k = 0; k < 2; ++k) \
        acc[ai][bj][m][n] = __builtin_amdgcn_mfma_f32_16x16x32_bf16(Bt[n][k], At[m][k], acc[ai][bj][m][n], 0, 0, 0); __builtin_amdgcn_s_setprio(0); } while (0)
#define PG8_WAIT_V(n) asm volatile("s_waitcnt vmcnt(" #n ")" ::: "memory")
#define PG8_WAIT_L(n) asm volatile("s_waitcnt lgkmcnt(" #n ")" ::: "memory")
#define PG8_BAR __builtin_amdgcn_s_barrier()
#define PG8_SCHED __builtin_amdgcn_sched_barrier(0)
    Unit cur, nxt; int ui = 0;
    if (!S.next(0, cur)) return;
    f32x4 acc[2][2][4][2];
#pragma unroll
    for (int a = 0; a < 2; ++a)
#pragma unroll
        for (int b = 0; b < 2; ++b)
#pragma unroll
            for (int m = 0; m < 4; ++m)
#pragma unroll
                for (int n = 0; n < 2; ++n) acc[a][b][m][n] = (f32x4){0.f, 0.f, 0.f, 0.f};
    bf16x8 At[4][2], B0[2][2], B1[2][2];
    const char* cA = (const char*)g.A + (size_t)cur.pm * tstep; const char* cB = (const char*)g.Bt + (size_t)cur.pn * tstep;
    S.a_ready(cur);
    if constexpr (SP2) {
        PG8_STAGE(PG8_SB(0, 0), cB, voffB); PG8_STAGE(PG8_SB(0, 1), cB + hstep, voffB); PG8_STAGE(PG8_SA(0, 0), cA, voffA); PG8_STAGE(PG8_SA(0, 1), cA + hstep, voffA);
        if (wr == 1) PG8_BAR;
        PG8_WAIT_V(2); PG8_BAR;
        PG8_STAGE(PG8_SB(1, 0), cB + kstep, voffB); PG8_STAGE(PG8_SA(1, 0), cA + kstep, voffA); PG8_STAGE(PG8_SB(1, 1), cB + hstep + kstep, voffB);
        PG8_WAIT_V(6); PG8_BAR;
    } else {
        PG8_STAGE(PG8_SB(0, 0), cB, voffB); PG8_STAGE(PG8_SA(0, 0), cA, voffA); PG8_STAGE(PG8_SB(0, 1), cB + hstep, voffB); PG8_STAGE(PG8_SA(0, 1), cA + hstep, voffA);
        if (wr == 1) PG8_BAR;
        PG8_WAIT_V(4); PG8_BAR;
        PG8_STAGE(PG8_SB(1, 0), cB + kstep, voffB); PG8_STAGE(PG8_SA(1, 0), cA + kstep, voffA); PG8_STAGE(PG8_SB(1, 1), cB + hstep + kstep, voffB);
        PG8_WAIT_V(6); PG8_BAR;
    }
    for (;;) {
        const bool has_next = S.next(ui + 1, nxt);
        const char* nA = has_next ? (const char*)g.A + (size_t)nxt.pm * tstep : cA; const char* nB = has_next ? (const char*)g.Bt + (size_t)nxt.pn * tstep : cB;
        for (int t = 0; t < nt; t += 2) {
            const bool last = (t == nt - 2);
            const char* a1 = cA + (size_t)(t + 1) * kstep;
            const char* a2 = last ? nA : cA + (size_t)(t + 2) * kstep; const char* b2 = last ? nB : cB + (size_t)(t + 2) * kstep;
            const char* a3 = a2 + kstep; const char* b3 = b2 + kstep;
            if (last && has_next) S.a_ready(nxt);
            if constexpr (SP2) {
            PG8_LDB(B0, 0, 0); PG8_LDB(B1, 0, 1); PG8_SCHED; PG8_LDA(At, 0, 0); PG8_STAGE(PG8_SA(1, 1), a1 + hstep, voffA);
            PG8_WAIT_V(8); PG8_WAIT_L(0); PG8_BAR; PG8_MMA(0, 0, At, B0); PG8_MMA(0, 1, At, B1); PG8_BAR; PG8_SCHED;
            PG8_LDA(At, 0, 1); PG8_STAGE(PG8_SB(0, 0), b2, voffB); PG8_STAGE(PG8_SB(0, 1), b2 + hstep, voffB); PG8_STAGE(PG8_SA(0, 0), a2, voffA);
            PG8_WAIT_V(8); PG8_WAIT_L(0); PG8_BAR; PG8_MMA(1, 0, At, B0); PG8_MMA(1, 1, At, B1); PG8_BAR; PG8_SCHED;
            PG8_LDB(B0, 1, 0); PG8_LDB(B1, 1, 1); PG8_SCHED; PG8_LDA(At, 1, 0); PG8_STAGE(PG8_SA(0, 1), a2 + hstep, voffA);
            PG8_WAIT_V(8); PG8_WAIT_L(0); PG8_BAR; PG8_MMA(0, 0, At, B0); PG8_MMA(0, 1, At, B1); PG8_BAR; PG8_SCHED;
            PG8_LDA(At, 1, 1); PG8_STAGE(PG8_SB(1, 0), b3, voffB); PG8_STAGE(PG8_SB(1, 1), b3 + hstep, voffB); PG8_STAGE(PG8_SA(1, 0), a3, voffA);
            PG8_WAIT_V(8); PG8_WAIT_L(0); PG8_BAR; PG8_MMA(1, 0, At, B0); PG8_MMA(1, 1, At, B1); PG8_BAR; PG8_SCHED;
            } else {
            PG8_LDB(B0, 0, 0); PG8_SCHED; PG8_LDA(At, 0, 0); PG8_STAGE(PG8_SA(1, 1), a1 + hstep, voffA);
            PG8_WAIT_L(8); PG8_BAR; PG8_WAIT_L(0); PG8_MMA(0, 0, At, B0); PG8_BAR; PG8_SCHED;
            PG8_LDB(B1, 0, 1); PG8_STAGE(PG8_SB(0, 0), b2, voffB);
            PG8_BAR; PG8_WAIT_L(0); PG8_MMA(0, 1, At, B1); PG8_BAR;
            PG8_LDA(At, 0, 1); PG8_STAGE(PG8_SA(0, 0), a2, voffA);
            PG8_BAR; PG8_WAIT_L(0); PG8_MMA(1, 0, At, B0); PG8_BAR; PG8_SCHED;
            PG8_STAGE(PG8_SB(0, 1), b2 + hstep, voffB);
            PG8_WAIT_V(6); PG8_BAR; PG8_MMA(1, 1, At, B1); PG8_BAR;
            PG8_LDB(B0, 1, 0); PG8_SCHED; PG8_LDA(At, 1, 0); PG8_STAGE(PG8_SA(0, 1), a2 + hstep, voffA);
            PG8_WAIT_L(8); PG8_BAR; PG8_WAIT_L(0); PG8_MMA(0, 0, At, B0); PG8_BAR; PG8_SCHED;
            PG8_LDB(B1, 1, 1); PG8_STAGE(PG8_SB(1, 0), b3, voffB);
            PG8_BAR; PG8_WAIT_L(0); PG8_MMA(0, 1, At, B1); PG8_BAR;
            PG8_LDA(At, 1, 1); PG8_STAGE(PG8_SA(1, 0), a3, voffA);
            PG8_BAR; PG8_WAIT_L(0); PG8_MMA(1, 0, At, B0); PG8_BAR; PG8_SCHED;
            PG8_STAGE(PG8_SB(1, 1), b3 + hstep, voffB);
            PG8_WAIT_V(6); PG8_BAR; PG8_MMA(1, 1, At, B1); PG8_BAR;
            }
        }
        if constexpr (ALIGN_EPI) { if (wr == 0) PG8_BAR; }
        if constexpr (!Epi::AFTER_DRAIN) { E(acc, cur, wr, wc, fr, fq); S.done(cur); }
        if (!has_next) break;
#pragma unroll
        for (int a = 0; a < 2; ++a)
#pragma unroll
            for (int b = 0; b < 2; ++b)
#pragma unroll
                for (int m = 0; m < 4; ++m)
#pragma unroll
                    for (int n = 0; n < 2; ++n) acc[a][b][m][n] = (f32x4){0.f, 0.f, 0.f, 0.f};
        cur = nxt; cA = nA; cB = nB; ++ui;
        if constexpr (ALIGN_EPI) { if (wr == 1) PG8_BAR; }
    }
    PG8_WAIT_V(0);
    if constexpr (!ALIGN_EPI) { if (wr == 0) PG8_BAR; }
    PG8_BAR;
    if constexpr (Epi::AFTER_DRAIN) { E.fused(acc, cur, wr, wc, fr, fq, lds, wid, lane); S.done(cur); }
#undef PG8_SA
#undef PG8_SB
#undef PG8_STAGE
#undef PG8_LDA
#undef PG8_LDB
#undef PG8_MMA
#undef PG8_WAIT_V
#undef PG8_WAIT_L
#undef PG8_BAR
#undef PG8_SCHED
}
}

constexpr int NWAVES = 8, NTHR = 512;
constexpr int MT = 8704, MP = 8192, DM = 2048, DIN = 4352, DSSM = 1024, DRW = 1024, DSH = 3328, DFF = 5632, NMEM = 256;
constexpr float ALPHA = 1.189207115002721f;
constexpr float LN_EPS = 1e-5f, GN_EPS = 64e-5f;
constexpr size_t O_Y = 0, O_SRE_P = (size_t)MT * DM, O_SIM_P = O_SRE_P + 16384, O_WKV_P = O_SIM_P + 16384, O_SH_P = O_WKV_P + 262144, O_MK = O_SH_P + 4 * DSH,
                 O_MV = O_MK + 2097152, O_SRE_S = O_MV + 2097152, O_SIM_S = O_SRE_S + 524288, O_WKV_S = O_SIM_S + 524288, O_SH_S = O_WKV_S + 8388608, O_END = O_SH_S + 128 * DSH;
static_assert(O_END == 32191488, "output size");
constexpr size_t MiB = 1u << 20;
constexpr size_t WS_CTL = 0, WS_WIN = 1 * MiB, WS_WGLU = 18 * MiB, WS_WOUT = 20 * MiB, WS_WQ = 28 * MiB, WS_WKV = 36 * MiB, WS_WO = 52 * MiB, WS_WGU = 60 * MiB, WS_WDN = 104 * MiB,
                 WS_W2T = 126 * MiB, WS_A2T = WS_W2T + 131072, WS_G2T = WS_W2T + 262144, WS_KB = 127 * MiB, WS_VTB = 131 * MiB, WS_XB = 135 * MiB, WS_MB = 169 * MiB,
                 WS_H = 173 * MiB, WS_R = WS_H, WS_X = WS_H + 72 * MiB, WS_PREP = 318 * MiB, WS_BONUS = 556 * MiB, WS_QB = WS_PREP, WS_OB = WS_PREP + 34 * MiB, WS_HFF = WS_PREP + 68 * MiB,
                 WS_YR = 557 * MiB, WS_YGB = 591 * MiB, WS_MIX = 608 * MiB, WS_END = 642 * MiB;
constexpr size_t PREP_STRIDE = 34 * MiB;
constexpr int LDS_BYTES = 135168;
constexpr int MISC_OFF = 131072;
constexpr int NPHASE = 14;

#define LAS __attribute__((address_space(3)))
typedef unsigned short bf16;
typedef unsigned v4u __attribute__((ext_vector_type(4)));
typedef unsigned v2u __attribute__((ext_vector_type(2)));
typedef float f32x4 __attribute__((ext_vector_type(4)));
typedef float f32x2 __attribute__((ext_vector_type(2)));
typedef float f32x16 __attribute__((ext_vector_type(16)));
typedef short bf16x8 __attribute__((ext_vector_type(8)));
#define LDS_WAIT() asm volatile("s_waitcnt lgkmcnt(0)" ::: "memory")

__device__ __forceinline__ unsigned pk2(float lo, float hi) { return pg8::cvt_pk_bf16(lo, hi); }
__device__ __forceinline__ bf16x8 pack_bf8(const f32x4 a, const f32x4 b) { v4u w; w.x = pk2(a[0], a[1]); w.y = pk2(a[2], a[3]); w.z = pk2(b[0], b[1]); w.w = pk2(b[2], b[3]); return __builtin_bit_cast(bf16x8, w); }
__device__ __forceinline__ float wave_sum(float v) {
#pragma unroll
    for (int o = 1; o < 64; o <<= 1) v += __shfl_xor(v, o);
    return v;
}
__device__ __forceinline__ float wave_max(float v) {
#pragma unroll
    for (int o = 1; o < 64; o <<= 1) v = fmaxf(v, __shfl_xor(v, o));
    return v;
}
template <int CTRL> __device__ __forceinline__ float dpp_f(float x) { return __builtin_bit_cast(float, __builtin_amdgcn_update_dpp(0, __builtin_bit_cast(int, x), CTRL, 0xf, 0xf, false)); }
__device__ __forceinline__ float sum16(float x) { x += dpp_f<0xB1>(x); x += dpp_f<0x4E>(x); x += dpp_f<0x141>(x); x += dpp_f<0x140>(x); return x; }
__device__ __forceinline__ float sigm(float x) { return 1.0f / (1.0f + __expf(-x)); }
__device__ __forceinline__ float tanh_(float x) { return 1.0f - 2.0f / (1.0f + __expf(2.0f * x)); }
__device__ __forceinline__ float gelu_tanh(float x) { const float u = 1.5957691216057308f * (x + 0.044715f * x * x * x); return x / (1.0f + __expf(-u)); }
#define MFMA16(a, b, c) __builtin_amdgcn_mfma_f32_16x16x32_bf16((a), (b), (c), 0, 0, 0)
#define MFMA32(a, b, c) __builtin_amdgcn_mfma_f32_32x32x16_bf16((a), (b), (c), 0, 0, 0)

struct Args { const float* in[45]; float* out; unsigned char* ws; int lo, hi; };

struct Frame {
    LAS unsigned char* lds; volatile LAS unsigned* MISC;
    int tid, lane, wave, G, bid;
    const float* const* in; float* out; unsigned char* ws;
};

__device__ __forceinline__ void tr_item(const float* W, int K, int N, bf16* WT, int drow0, int k0, int n0, LAS float* scr, int lane) {
#pragma unroll 8
    for (int i = 0; i < 32; ++i) { const int kk = 2 * i + (lane >> 5); scr[kk * 33 + (lane & 31)] = W[(size_t)(k0 + kk) * N + n0 + (lane & 31)]; }
    LDS_WAIT(); asm volatile("" ::: "memory");
    const int c = lane & 7;
#pragma unroll
    for (int j = 0; j < 4; ++j) { const int n = (lane >> 3) + 8 * j; const LAS float* s = scr + (8 * c) * 33 + n;
        v4u o; o.x = pk2(s[0 * 33], s[1 * 33]); o.y = pk2(s[2 * 33], s[3 * 33]); o.z = pk2(s[4 * 33], s[5 * 33]); o.w = pk2(s[6 * 33], s[7 * 33]);
        *(v4u*)(WT + (size_t)(drow0 + n) * K + k0 + 8 * c) = o; }
    LDS_WAIT(); asm volatile("" ::: "memory");
}
__device__ __forceinline__ void p0_prologue(Frame& F) {
    LAS float* scr = (LAS float*)(F.lds + F.wave * 16384);
    const int gw = F.bid * NWAVES + F.wave, NGW = F.G * NWAVES, lane = F.lane;
    unsigned char* ws = F.ws;
#define TR_MAT(Wp, Kk, Nn, Dst, ROWMAP) { const int nblk = (Nn) / 32, cnt = ((Kk) / 64) * nblk; if (r < cnt) { const int kb = r / nblk, n0 = (r % nblk) * 32; \
        tr_item((Wp), (Kk), (Nn), (bf16*)(Dst), (ROWMAP), kb * 64, n0, scr, lane); continue; } r -= cnt; }
    constexpr int NITEMS = 32 * 136 + 16 * 32 + 5 * 32 * 64 + 2 * 32 * 176 + 88 * 64 + 32 + 32 + 64;
    for (int it = gw; it < NITEMS; it += NGW) {
        int r = it;
        TR_MAT(F.in[9], DM, DIN, ws + WS_WIN, n0)
        TR_MAT(F.in[18], DSSM, DSSM, ws + WS_WGLU, n0)
        TR_MAT(F.in[31], DM, DM, ws + WS_WOUT, n0)
        TR_MAT(F.in[34], DM, DM, ws + WS_WQ, n0)
        TR_MAT(F.in[35], DM, DM, ws + WS_WKV, n0)
        TR_MAT(F.in[36], DM, DM, ws + WS_WKV, 2048 + n0)
        TR_MAT(F.in[37], DM, DM, ws + WS_WO, n0)
        TR_MAT(F.in[40], DM, DFF, ws + WS_WGU, 256 * (n0 / 128) + (n0 % 128))
        TR_MAT(F.in[41], DM, DFF, ws + WS_WGU, 256 * (n0 / 128) + 128 + (n0 % 128))
        TR_MAT(F.in[42], DFF, DM, ws + WS_WDN, n0)
        TR_MAT(F.in[22], 64, DRW, ws + WS_W2T, n0)
        TR_MAT(F.in[24], 64, DRW, ws + WS_A2T, n0)
        TR_MAT(F.in[25], 128, DRW, ws + WS_G2T, n0)
    }
#undef TR_MAT
    const size_t gt = (size_t)F.bid * NTHR + F.tid, NGT = (size_t)F.G * NTHR;
    { const f32x4* xp = (const f32x4*)F.in[0]; const f32x4* xs = (const f32x4*)F.in[1]; v4u* xb = (v4u*)(ws + WS_XB);
      const size_t np = (size_t)MP * DM / 8, nt = (size_t)MT * DM / 8;
      for (size_t i = gt; i < nt; i += NGT) { const f32x4* s = i < np ? xp + 2 * i : xs + 2 * (i - np); const f32x4 a = s[0], b = s[1]; xb[i] = pg8::pack8(a, b); } }
    { const f32x4* mp = (const f32x4*)F.in[2]; v4u* mb = (v4u*)(ws + WS_MB); const size_t nm = (size_t)1024 * DM / 8;
      for (size_t i = gt; i < nm; i += NGT) { const f32x4 a = mp[2 * i], b = mp[2 * i + 1]; mb[i] = pg8::pack8(a, b); } }
}

__device__ __forceinline__ void p2_prep(Frame& F) {
    const float* H = (const float*)(F.ws + WS_H);
    const float* mu = F.in[20]; const float* w0 = F.in[21]; const float* a0 = F.in[23]; const float* k_k = F.in[26]; const float* k_a = F.in[27]; const float* r_k = F.in[28];
    const bf16* W2T = (const bf16*)(F.ws + WS_W2T); const bf16* A2T = (const bf16*)(F.ws + WS_A2T); const bf16* G2T = (const bf16*)(F.ws + WS_G2T);
    float* PR = (float*)(F.ws + WS_PREP); constexpr size_t PS = PREP_STRIDE / 4;
    float* BON = (float*)(F.ws + WS_BONUS);
    const int lane = F.lane, fr = lane & 15, fq = lane >> 4;
    for (int tile = F.bid; tile < MT / 16; tile += F.G) {
        const int m = tile * 16 + fr;
        const float* prow = H + (size_t)m * DIN + 1024;
        const bool prompt = m < MP; const int t = prompt ? (m & 2047) : ((m - MP) & 3);
        const float* qrow = prow - DIN; float qs = 1.0f;
        if (t == 0) { if (prompt) { qrow = prow; qs = 0.0f; } else qrow = F.in[6] + (size_t)((m - MP) >> 2) * DSH; }
#define PS4(col) ({ const f32x4 p_ = *(const f32x4*)(prow + (col)); const f32x4 q_ = *(const f32x4*)(qrow + (col)) * qs; const f32x4 m_ = *(const f32x4*)(mu + (col)); p_ + (q_ - p_) * m_; })
        bf16x8 bw[2], ba[2], bg[4];
#pragma unroll
        for (int kc = 0; kc < 2; ++kc) { f32x4 x0 = PS4(3072 + 32 * kc + 8 * fq), x1 = PS4(3072 + 32 * kc + 8 * fq + 4);
#pragma unroll
            for (int j = 0; j < 4; ++j) { x0[j] = tanh_(x0[j]); x1[j] = tanh_(x1[j]); }
            bw[kc] = pack_bf8(x0, x1);
            const f32x4 y0 = PS4(3136 + 32 * kc + 8 * fq), y1 = PS4(3136 + 32 * kc + 8 * fq + 4); ba[kc] = pack_bf8(y0, y1); }
#pragma unroll
        for (int kc = 0; kc < 4; ++kc) { f32x4 x0 = PS4(3200 + 32 * kc + 8 * fq), x1 = PS4(3200 + 32 * kc + 8 * fq + 4);
#pragma unroll
            for (int j = 0; j < 4; ++j) { x0[j] = sigm(x0[j]); x1[j] = sigm(x1[j]); }
            bg[kc] = pack_bf8(x0, x1); }
#pragma unroll 1
        for (int hi = 0; hi < 2; ++hi) {
            const int hd = 2 * F.wave + hi;
            f32x4 accW[4], accA[4], accG[4];
#pragma unroll
            for (int ct = 0; ct < 4; ++ct) { const int c = 64 * hd + 16 * ct + fr;
                accW[ct] = (f32x4){0.f, 0.f, 0.f, 0.f}; accA[ct] = accW[ct]; accG[ct] = accW[ct];
#pragma unroll
                for (int kc = 0; kc < 2; ++kc) { accW[ct] = MFMA16(*(const bf16x8*)(W2T + c * 64 + 32 * kc + 8 * fq), bw[kc], accW[ct]);
                                                  accA[ct] = MFMA16(*(const bf16x8*)(A2T + c * 64 + 32 * kc + 8 * fq), ba[kc], accA[ct]); }
#pragma unroll
                for (int kc = 0; kc < 4; ++kc) accG[ct] = MFMA16(*(const bf16x8*)(G2T + c * 128 + 32 * kc + 8 * fq), bg[kc], accG[ct]); }
            f32x4 av[4], kkr[4]; float ss = 0.f, bon = 0.f;
#pragma unroll
            for (int ct = 0; ct < 4; ++ct) { const int col = 64 * hd + 16 * ct + 4 * fq; const size_t o = (size_t)m * 1024 + col;
                const f32x4 r4 = PS4(col), k4 = PS4(1024 + col), v4 = PS4(2048 + col);
                const f32x4 w04 = *(const f32x4*)(w0 + col), a04 = *(const f32x4*)(a0 + col), kk4 = *(const f32x4*)(k_k + col), ka4 = *(const f32x4*)(k_a + col), rk4 = *(const f32x4*)(r_k + col);
                f32x4 dec, a, km;
#pragma unroll
                for (int j = 0; j < 4; ++j) { const float z = -(w04[j] + accW[ct][j]); const float sp = fmaxf(z, 0.f) + log1pf(__expf(-fabsf(z))); const float wl = -sp - 0.5f;
                    dec[j] = __expf(-__expf(wl)); a[j] = sigm(a04[j] + accA[ct][j]); km[j] = k4[j] * (1.0f + (a[j] - 1.0f) * ka4[j]);
                    const float kr = k4[j] * kk4[j]; kkr[ct][j] = kr; ss += kr * kr; bon += r4[j] * km[j] * rk4[j]; }
                av[ct] = a;
                *(f32x4*)(PR + 0 * PS + o) = r4; *(f32x4*)(PR + 1 * PS + o) = dec; *(f32x4*)(PR + 2 * PS + o) = km; *(f32x4*)(PR + 3 * PS + o) = v4; *(f32x4*)(PR + 6 * PS + o) = accG[ct]; }
            ss += __shfl_xor(ss, 16); ss += __shfl_xor(ss, 32); bon += __shfl_xor(bon, 16); bon += __shfl_xor(bon, 32);
            const float inv = rsqrtf(fmaxf(ss, 1e-24f));
#pragma unroll
            for (int ct = 0; ct < 4; ++ct) { const size_t o = (size_t)m * 1024 + 64 * hd + 16 * ct + 4 * fq; const f32x4 kk = kkr[ct] * inv;
                *(f32x4*)(PR + 4 * PS + o) = kk; *(f32x4*)(PR + 5 * PS + o) = kk * av[ct]; }
            if (fq == 0) BON[(size_t)m * 16 + hd] = bon;
        }
#undef PS4
    }
    { const int gt = F.bid * NTHR + F.tid, NGT = F.G * NTHR;
      for (int i = gt; i < 132 * (DSH / 4); i += NGT) { const int s = i / (DSH / 4), c4 = i % (DSH / 4);
          const int m = s < 4 ? s * 2048 + 2047 : MP + 4 * (s - 4) + 3;
          float* o = s < 4 ? F.out + O_SH_P + (size_t)s * DSH : F.out + O_SH_S + (size_t)(s - 4) * DSH;
          *(f32x4*)(o + 4 * c4) = *(const f32x4*)(H + (size_t)m * DIN + 1024 + 4 * c4); } }
}

__device__ __forceinline__ void rwkv_scan(Frame& F, int m0, int T, int h, int half, const float* s_in, float* s_out) {
    const float* PR = (const float*)(F.ws + WS_PREP); constexpr size_t PS = PREP_STRIDE / 4;
    float* YR = (float*)(F.ws + WS_YR);
    const int tid = F.tid, lane = F.lane, rr = lane >> 4, kq = lane & 15, v = 32 * half + 4 * F.wave + rr;
    LAS float* buf = (LAS float*)F.lds;
    f32x4 S = (f32x4){0.f, 0.f, 0.f, 0.f};
    if (s_in) S = *(const f32x4*)(s_in + v * 64 + 4 * kq);
    const int nchunk = (T + 31) >> 5, step_l = tid >> 4, part = tid & 15;
    f32x4 st[6];
#pragma unroll
    for (int q = 0; q < 6; ++q) st[q] = (f32x4){0.f, 0.f, 0.f, 0.f};
#define RW_GLOAD(c) do { const int t_ = (c) * 32 + step_l; if (t_ < T) { const size_t off_ = (size_t)(m0 + t_) * 1024 + h * 64 + 4 * part; \
        st[0] = *(const f32x4*)(PR + 1 * PS + off_); st[1] = *(const f32x4*)(PR + 4 * PS + off_); st[2] = *(const f32x4*)(PR + 5 * PS + off_); \
        st[3] = *(const f32x4*)(PR + 2 * PS + off_); st[4] = *(const f32x4*)(PR + 0 * PS + off_); st[5] = *(const f32x4*)(PR + 3 * PS + off_); } } while (0)
#define RW_LSTORE(b) do { LAS float* d_ = buf + (b) * 12288 + step_l * 384 + 4 * part; _Pragma("unroll") for (int q = 0; q < 6; ++q) *(LAS f32x4*)(d_ + q * 64) = st[q]; } while (0)
    RW_GLOAD(0); RW_LSTORE(0); __syncthreads();
    for (int c = 0; c < nchunk; ++c) {
        const int cur = c & 1;
        if (c + 1 < nchunk) RW_GLOAD(c + 1);
        const int nst = (T - 32 * c) < 32 ? (T - 32 * c) : 32;
        const LAS float* cb = buf + cur * 12288;
#pragma unroll 4
        for (int s = 0; s < nst; ++s) {
            const LAS float* sb = cb + s * 384;
            const f32x4 w4 = *(const LAS f32x4*)(sb + 4 * kq), kk4 = *(const LAS f32x4*)(sb + 64 + 4 * kq), b4 = *(const LAS f32x4*)(sb + 128 + 4 * kq),
                        k4 = *(const LAS f32x4*)(sb + 192 + 4 * kq), r4 = *(const LAS f32x4*)(sb + 256 + 4 * kq);
            const float vv = sb[320 + v];
            float sa = -((S[0] * kk4[0] + S[1] * kk4[1]) + (S[2] * kk4[2] + S[3] * kk4[3]));
            sa = sum16(sa);
            S = S * w4 + (b4 * sa + k4 * vv);
            float y = (S[0] * r4[0] + S[1] * r4[1]) + (S[2] * r4[2] + S[3] * r4[3]);
            y = sum16(y);
            if (kq == 0) YR[(size_t)(m0 + 32 * c + s) * 1024 + h * 64 + v] = y;
        }
        if (c + 1 < nchunk) RW_LSTORE(cur ^ 1);
        __syncthreads();
    }
#undef RW_GLOAD
#undef RW_LSTORE
    *(f32x4*)(s_out + v * 64 + 4 * kq) = S;
}

template <int SEG> __device__ __forceinline__ void ssm_item(Frame& F, int g, int sel) {
    const float* H = (const float*)(F.ws + WS_H);
    bf16* YG = (bf16*)(F.ws + WS_YGB);
    const int lane = F.lane, n = lane & 31, hh = lane >> 5, fr = lane & 15, fq = lane >> 4;
    LAS bf16* ldsS = (LAS bf16*)(F.lds + F.wave * 8704);
    const float dt = __expf(F.in[17][g]);
    float lr[2], li[2]; bf16x8 Bre[2], Bim[2];
#pragma unroll
    for (int pp = 0; pp < 2; ++pp) { const int p = 2 * n + pp; const float are = F.in[10][g * 64 + p], aim = F.in[11][g * 64 + p];
        const float mag = expf(are * dt), ang = aim * dt; float sn, cs; sincosf(ang, &sn, &cs); lr[pp] = mag * cs; li[pp] = mag * sn;
        const float sh = sinf(0.5f * ang); const float xr = expm1f(are * dt) * cs - 2.0f * sh * sh, xi = mag * sn;
        const float den = 1.0f / (are * are + aim * aim); const float qr = (xr * are + xi * aim) * den, qi = (xi * are - xr * aim) * den;
        const float* brp = F.in[12] + (size_t)(g * 64 + p) * 16 + 8 * hh; const float* bip = F.in[13] + (size_t)(g * 64 + p) * 16 + 8 * hh;
        const f32x4 br0 = *(const f32x4*)brp, br1 = *(const f32x4*)(brp + 4), bi0 = *(const f32x4*)bip, bi1 = *(const f32x4*)(bip + 4);
        Bre[pp] = pack_bf8(br0 * qr - bi0 * qi, br1 * qr - bi1 * qi); Bim[pp] = pack_bf8(bi0 * qr + br0 * qi, bi1 * qr + br1 * qi); }
    bf16x8 Cop[4];
#pragma unroll
    for (int kc = 0; kc < 4; ++kc) { const float* cp = (kc < 2 ? F.in[14] : F.in[15]) + (size_t)(g * 16 + fr) * 64 + 32 * (kc & 1) + 8 * fq; const float sg = kc < 2 ? 1.0f : -1.0f;
        Cop[kc] = pack_bf8(*(const f32x4*)cp * sg, *(const f32x4*)(cp + 4) * sg); }
    const f32x4 d4 = *(const f32x4*)(F.in[16] + 16 * g + 4 * fq);
    float sre[2] = {0.f, 0.f}, sim[2] = {0.f, 0.f};
    const int ntile = SEG == 16 ? 128 : 1;
    const int hr = (n >> 2) & 1, ir = 4 * (n >> 3) + (n & 3);
    for (int tile = 0; tile < ntile; ++tile) {
        const int arow = SEG == 16 ? (2 * sel + hr) * 2048 + tile * 16 + ir : MP + 4 * (8 * sel + 4 * hr + (ir >> 2)) + (ir & 3);
        const float* up = H + (size_t)arow * DIN + 16 * g + 8 * hh;
        const bf16x8 A1 = pack_bf8(*(const f32x4*)up, *(const f32x4*)(up + 4));
        const f32x16 z16 = {0.f, 0.f, 0.f, 0.f, 0.f, 0.f, 0.f, 0.f, 0.f, 0.f, 0.f, 0.f, 0.f, 0.f, 0.f, 0.f};
        f32x16 aRe[2], aIm[2];
#pragma unroll
        for (int pp = 0; pp < 2; ++pp) { aRe[pp] = MFMA32(A1, Bre[pp], z16); aIm[pp] = MFMA32(A1, Bim[pp], z16); }
#pragma unroll
        for (int i = 0; i < 16; ++i) {
            if (SEG == 4 && (i & 3) == 0) { const int batch = 8 * sel + 4 * hh + (i >> 2); const size_t so = (size_t)(batch * 64 + g) * 64 + 2 * n;
                const f32x2 a = *(const f32x2*)(F.in[3] + so), b = *(const f32x2*)(F.in[4] + so); sre[0] = a[0]; sre[1] = a[1]; sim[0] = b[0]; sim[1] = b[1]; }
#pragma unroll
            for (int pp = 0; pp < 2; ++pp) { const float nr = lr[pp] * sre[pp] - li[pp] * sim[pp] + aRe[pp][i], ni = lr[pp] * sim[pp] + li[pp] * sre[pp] + aIm[pp][i]; sre[pp] = nr; sim[pp] = ni; }
            *(LAS unsigned*)(ldsS + (16 * hh + i) * 136 + 2 * n) = pk2(sre[0], sre[1]);
            *(LAS unsigned*)(ldsS + (16 * hh + i) * 136 + 64 + 2 * n) = pk2(sim[0], sim[1]);
            if (SEG == 4 && (i & 3) == 3) { const int batch = 8 * sel + 4 * hh + (i >> 2); const size_t so = (size_t)(batch * 64 + g) * 64 + 2 * n;
                *(f32x2*)(F.out + O_SRE_S + so) = (f32x2){sre[0], sre[1]}; *(f32x2*)(F.out + O_SIM_S + so) = (f32x2){sim[0], sim[1]}; }
        }
        LDS_WAIT(); asm volatile("" ::: "memory");
#pragma unroll
        for (int rg = 0; rg < 2; ++rg) {
            f32x4 aY = (f32x4){0.f, 0.f, 0.f, 0.f};
#pragma unroll
            for (int kc = 0; kc < 4; ++kc) aY = MFMA16(Cop[kc], *(const LAS bf16x8*)(ldsS + (16 * rg + fr) * 136 + 32 * kc + 8 * fq), aY);
            const int orow = SEG == 16 ? (2 * sel + rg) * 2048 + tile * 16 + fr : MP + 4 * (8 * sel + 4 * rg + (fr >> 2)) + (fr & 3);
            const f32x4 u4 = *(const f32x4*)(H + (size_t)orow * DIN + 16 * g + 4 * fq);
            const f32x4 y = aY + d4 * u4;
            v2u w; w.x = pk2(gelu_tanh(y[0]), gelu_tanh(y[1])); w.y = pk2(gelu_tanh(y[2]), gelu_tanh(y[3]));
            *(v2u*)(YG + (size_t)orow * 1024 + 16 * g + 4 * fq) = w;
        }
        LDS_WAIT(); asm volatile("" ::: "memory");
    }
    if (SEG == 16) { const size_t so = (size_t)((2 * sel + hh) * 64 + g) * 64 + 2 * n;
        *(f32x2*)(F.out + O_SRE_P + so) = (f32x2){sre[0], sre[1]}; *(f32x2*)(F.out + O_SIM_P + so) = (f32x2){sim[0], sim[1]}; }
}

__device__ __forceinline__ void p3_scans(Frame& F) {
    unsigned* ctr = (unsigned*)(F.ws + WS_CTL);
    constexpr int N_RP = 128, N_SP = 64, N_RS = 2048, N_SS = 128, TOTAL = N_RP + N_SP + N_RS + N_SS;
    for (;;) {
        __syncthreads();
        if (F.tid == 0) F.MISC[0] = atomicAdd(ctr, 1u);
        __syncthreads();
        int it = (int)F.MISC[0];
        if (it >= TOTAL) break;
        if (it < N_RP) { const int b = it >> 5, h = (it >> 1) & 15, half = it & 1;
            rwkv_scan(F, b * 2048, 2048, h, half, nullptr, F.out + O_WKV_P + (size_t)(b * 16 + h) * 4096); continue; }
        it -= N_RP;
        if (it < N_SP) { if (F.wave < 2) ssm_item<16>(F, it, F.wave); continue; }
        it -= N_SP;
        if (it < N_RS) { const int b = it >> 4, h = it & 15; const size_t so = (size_t)(b * 16 + h) * 4096;
            rwkv_scan(F, MP + 4 * b, 4, h, 0, F.in[5] + so, F.out + O_WKV_S + so);
            rwkv_scan(F, MP + 4 * b, 4, h, 1, F.in[5] + so, F.out + O_WKV_S + so); continue; }
        it -= N_RS;
        { const int wi = it * 8 + F.wave; ssm_item<4>(F, wi >> 4, wi & 15); }
    }
}

__device__ __forceinline__ void p4_post(Frame& F) {
    unsigned* ctr = (unsigned*)(F.ws + WS_CTL) + 64;
    const float* PR = (const float*)(F.ws + WS_PREP); constexpr size_t PS = PREP_STRIDE / 4;
    const float* YR = (const float*)(F.ws + WS_YR); const float* BON = (const float*)(F.ws + WS_BONUS);
    const float* lg = F.in[29]; const float* lb = F.in[30];
    bf16* MIX = (bf16*)(F.ws + WS_MIX);
    const int lane = F.lane;
    for (;;) {
        __syncthreads();
        if (F.tid == 0) F.MISC[0] = atomicAdd(ctr, 1u);
        __syncthreads();
        const int it = (int)F.MISC[0];
        if (it >= MT / 16) break;
#pragma unroll 1
        for (int q = 0; q < 2; ++q) { const int m = it * 16 + 2 * F.wave + q;
#pragma unroll
            for (int j = 0; j < 4; ++j) { const int col = 256 * j + 4 * lane, hd = 4 * j + (lane >> 4); const size_t o = (size_t)m * 1024 + col;
                const f32x4 y = *(const f32x4*)(YR + o);
                const float mean = sum16((y[0] + y[1]) + (y[2] + y[3])) * (1.0f / 64.0f);
                const f32x4 d = y - mean;
                const float var = sum16((d[0] * d[0] + d[1] * d[1]) + (d[2] * d[2] + d[3] * d[3])) * (1.0f / 64.0f);
                const float rstd = rsqrtf(var + GN_EPS), bon = BON[(size_t)m * 16 + hd];
                const f32x4 v4 = *(const f32x4*)(PR + 3 * PS + o), g4 = *(const f32x4*)(PR + 6 * PS + o), lg4 = *(const f32x4*)(lg + col), lb4 = *(const f32x4*)(lb + col);
                const f32x4 ov = (d * rstd * lg4 + lb4 + v4 * bon) * g4;
                v2u w; w.x = pk2(ov[0], ov[1]); w.y = pk2(ov[2], ov[3]);
                *(v2u*)(MIX + (size_t)m * 2048 + 1024 + col) = w; } }
    }
}

__device__ __forceinline__ void ln_rows(Frame& F, const float* src, const float* gam, const float* bet, float* dstf, bf16* dstb) {
    const int gw = F.bid * NWAVES + F.wave, NGW = F.G * NWAVES, lane = F.lane;
    f32x4 gg[8], bb[8];
#pragma unroll
    for (int j = 0; j < 8; ++j) { gg[j] = *(const f32x4*)(gam + 4 * (lane + 64 * j)); bb[j] = *(const f32x4*)(bet + 4 * (lane + 64 * j)); }
    for (int row = gw; row < MT; row += NGW) {
        const f32x4* s = (const f32x4*)(src + (size_t)row * DM) + lane; f32x4 v[8]; float sm = 0.f;
#pragma unroll
        for (int j = 0; j < 8; ++j) { v[j] = s[64 * j]; sm += (v[j][0] + v[j][1]) + (v[j][2] + v[j][3]); }
        const float mean = wave_sum(sm) * (1.0f / DM); float s2 = 0.f;
#pragma unroll
        for (int j = 0; j < 8; ++j) { v[j] = v[j] - mean; s2 += (v[j][0] * v[j][0] + v[j][1] * v[j][1]) + (v[j][2] * v[j][2] + v[j][3] * v[j][3]); }
        const float rstd = rsqrtf(wave_sum(s2) * (1.0f / DM) + LN_EPS);
#pragma unroll
        for (int j = 0; j < 8; ++j) { const f32x4 o = v[j] * rstd * gg[j] + bb[j];
            if (dstf) *((f32x4*)(dstf + (size_t)row * DM) + lane + 64 * j) = o;
            if (dstb) { v2u w; w.x = pk2(o[0], o[1]); w.y = pk2(o[2], o[3]); *((v2u*)(dstb + (size_t)row * DM) + lane + 64 * j) = w; } }
    }
}

__device__ __forceinline__ void attn_prompt_unit(Frame& F, int b, int h, int qt) {
    const bf16* Qb = (const bf16*)(F.ws + WS_QB); const bf16* Kb = (const bf16*)(F.ws + WS_KB); const bf16* VT = (const bf16*)(F.ws + WS_VTB);
    bf16* Ob = (bf16*)(F.ws + WS_OB);
    const int lane = F.lane, fr = lane & 15, fq = lane >> 4;
    const int m = b * 2048 + qt * 128 + 16 * F.wave + fr;
    bf16x8 Qf[16];
#pragma unroll
    for (int kc = 0; kc < 16; ++kc) Qf[kc] = *(const bf16x8*)(Qb + (size_t)m * DM + h * 512 + 32 * kc + 8 * fq);
    f32x4 s[8][2];
#pragma unroll
    for (int c = 0; c < 8; ++c)
#pragma unroll
        for (int sb = 0; sb < 2; ++sb) { const int mem = 32 * c + 8 * (fr >> 2) + 4 * sb + (fr & 3);
            const bf16* krow = Kb + (size_t)(b * NMEM + mem) * DM + h * 512 + 8 * fq; f32x4 acc = (f32x4){0.f, 0.f, 0.f, 0.f};
#pragma unroll
            for (int kc = 0; kc < 16; ++kc) acc = MFMA16(*(const bf16x8*)(krow + 32 * kc), Qf[kc], acc);
            s[c][sb] = acc; }
    float mx = -3.0e38f;
#pragma unroll
    for (int c = 0; c < 8; ++c)
#pragma unroll
        for (int sb = 0; sb < 2; ++sb)
#pragma unroll
            for (int j = 0; j < 4; ++j) mx = fmaxf(mx, s[c][sb][j]);
    mx = fmaxf(mx, __shfl_xor(mx, 16)); mx = fmaxf(mx, __shfl_xor(mx, 32));
    const float sc2 = 0.044194173824159216f * 1.4426950408889634f;
    float sum = 0.f;
#pragma unroll
    for (int c = 0; c < 8; ++c)
#pragma unroll
        for (int sb = 0; sb < 2; ++sb)
#pragma unroll
            for (int j = 0; j < 4; ++j) { const float p = exp2f((s[c][sb][j] - mx) * sc2); s[c][sb][j] = p; sum += p; }
    sum += __shfl_xor(sum, 16); sum += __shfl_xor(sum, 32);
    const float inv = 1.0f / sum;
    bf16x8 Pf[8];
#pragma unroll
    for (int c = 0; c < 8; ++c) Pf[c] = pack_bf8(s[c][0] * inv, s[c][1] * inv);
#pragma unroll 4
    for (int dt = 0; dt < 32; ++dt) { const bf16* vrow = VT + (size_t)(h * 512 + 16 * dt + fr) * 1024 + b * NMEM + 8 * fq; f32x4 acc = (f32x4){0.f, 0.f, 0.f, 0.f};
#pragma unroll
        for (int c = 0; c < 8; ++c) acc = MFMA16(*(const bf16x8*)(vrow + 32 * c), Pf[c], acc);
        v2u w; w.x = pk2(acc[0], acc[1]); w.y = pk2(acc[2], acc[3]);
        *(v2u*)(Ob + (size_t)m * DM + h * 512 + 16 * dt + 4 * fq) = w; }
}
__device__ __forceinline__ void attn_sample_unit(Frame& F, int b, int h) {
    const bf16* Qb = (const bf16*)(F.ws + WS_QB); bf16* Ob = (bf16*)(F.ws + WS_OB);
    const float* CK = F.in[7]; const float* CV = F.in[8];
    LAS float* sc = (LAS float*)F.lds; LAS float* Pm = (LAS float*)(F.lds + 4096); LAS float* red = (LAS float*)(F.lds + 8192);
    const int lane = F.lane, fr = lane & 15, fq = lane >> 4, w = F.wave, tid = F.tid;
    bf16x8 Qf[16];
#pragma unroll
    for (int kc = 0; kc < 16; ++kc) { const bf16x8 z = {0, 0, 0, 0, 0, 0, 0, 0};
        Qf[kc] = fr < 4 ? *(const bf16x8*)(Qb + (size_t)(MP + 4 * b + fr) * DM + h * 512 + 32 * kc + 8 * fq) : z; }
#pragma unroll
    for (int tl = 0; tl < 2; ++tl) { const int mem = 32 * w + 16 * tl + fr; const float* krow = CK + (size_t)(b * NMEM + mem) * DM + h * 512 + 8 * fq; f32x4 acc = (f32x4){0.f, 0.f, 0.f, 0.f};
#pragma unroll
        for (int kc = 0; kc < 16; ++kc) acc = MFMA16(pack_bf8(*(const f32x4*)(krow + 32 * kc), *(const f32x4*)(krow + 32 * kc + 4)), Qf[kc], acc);
        if (fr < 4) *(LAS f32x4*)(sc + fr * 256 + 32 * w + 16 * tl + 4 * fq) = acc * 0.044194173824159216f; }
    __syncthreads();
    if (w < 4) { const f32x4 v = *(const LAS f32x4*)(sc + w * 256 + 4 * lane);
        const float mx = wave_max(fmaxf(fmaxf(v[0], v[1]), fmaxf(v[2], v[3])));
        f32x4 e; e[0] = __expf(v[0] - mx); e[1] = __expf(v[1] - mx); e[2] = __expf(v[2] - mx); e[3] = __expf(v[3] - mx);
        const float inv = 1.0f / wave_sum((e[0] + e[1]) + (e[2] + e[3]));
#pragma unroll
        for (int j = 0; j < 4; ++j) Pm[(4 * lane + j) * 4 + w] = e[j] * inv; }
    __syncthreads();
    f32x4 a0[4], a1[4];
#pragma unroll
    for (int q = 0; q < 4; ++q) { a0[q] = (f32x4){0.f, 0.f, 0.f, 0.f}; a1[q] = a0[q]; }
#pragma unroll 8
    for (int i = 0; i < 32; ++i) { const int mem = 32 * w + i; const float* vrow = CV + (size_t)(b * NMEM + mem) * DM + h * 512;
        const f32x4 v0 = *(const f32x4*)(vrow + 4 * lane), v1 = *(const f32x4*)(vrow + 256 + 4 * lane); const f32x4 p4 = *(const LAS f32x4*)(Pm + mem * 4);
#pragma unroll
        for (int q = 0; q < 4; ++q) { a0[q] += v0 * p4[q]; a1[q] += v1 * p4[q]; } }
#pragma unroll
    for (int q = 0; q < 4; ++q) { *(LAS f32x4*)(red + (w * 4 + q) * 512 + 4 * lane) = a0[q]; *(LAS f32x4*)(red + (w * 4 + q) * 512 + 256 + 4 * lane) = a1[q]; }
    __syncthreads();
    { const int q = tid >> 7, d4 = (tid & 127) * 4; f32x4 o = (f32x4){0.f, 0.f, 0.f, 0.f};
#pragma unroll
      for (int ww = 0; ww < 8; ++ww) o += *(const LAS f32x4*)(red + (ww * 4 + q) * 512 + d4);
      v2u pw; pw.x = pk2(o[0], o[1]); pw.y = pk2(o[2], o[3]);
      *(v2u*)(Ob + (size_t)(MP + 4 * b + q) * DM + h * 512 + d4) = pw; }
    __syncthreads();
}
__device__ __forceinline__ void p8_attn(Frame& F) {
#ifndef MK_ATT_SKIP
#define MK_ATT_SKIP 0
#endif
    if (MK_ATT_SKIP != 1) for (int u = F.bid; u < 512; u += F.G) attn_sample_unit(F, u >> 2, u & 3);
    if (MK_ATT_SKIP != 2) for (int u = F.bid; u < 256; u += F.G) attn_prompt_unit(F, u >> 6, (u >> 4) & 3, u & 15);
}

#define XB_TMO      128
#define XB_XCNT(j)  (256  + 64 * (j))
#define XB_XSUB(j)  (1280 + 64 * (j))
#define XB_XGEN(j)  (2304 + 64 * (j))
#define XB_TOP      3328
#define XB_TOPGEN   3392
#define XCD_BAR_WORDS 3456
#define XB_SPIN_CAP (1u << 18)

__device__ __forceinline__ unsigned xb_ld(unsigned* p)              { return __hip_atomic_load(p, __ATOMIC_RELAXED, __HIP_MEMORY_SCOPE_AGENT); }
__device__ __forceinline__ unsigned xb_add(unsigned* p, unsigned v) { return __hip_atomic_fetch_add(p, v, __ATOMIC_RELAXED, __HIP_MEMORY_SCOPE_AGENT); }
__device__ __forceinline__ unsigned xb_xcc_id() { return (unsigned)__builtin_amdgcn_s_getreg((3 << 11) | 20) & 0xFu; }
#define XB_SPIN(cond, bar) do { unsigned _sp = 0; while (cond) { __builtin_amdgcn_s_sleep(1); \
    if ((++_sp & 255u) == 0u) { if (xb_ld(&(bar)[XB_TMO])) break; if (_sp > XB_SPIN_CAP) { atomicAdd(&(bar)[XB_TMO], 1u); break; } } } } while (0)

struct XcdBarrier {
    unsigned* bar; unsigned x;
    volatile LAS unsigned* st;
};

__device__ __forceinline__ XcdBarrier xcd_barrier_post(unsigned* bar, volatile LAS unsigned* st) {
    XcdBarrier b; b.bar = bar; b.x = xb_xcc_id(); b.st = st;
    if (threadIdx.x == 0) (void)xb_add(&bar[XB_XCNT(b.x)], 1u);
    return b;
}
__device__ __forceinline__ void xcd_barrier_complete(unsigned* bar, unsigned x, unsigned& nloc, unsigned& nx) {
    const unsigned G = gridDim.x * gridDim.y * gridDim.z;
    unsigned sum, cnt, mine, sp = 0u;
    for (;;) {
        sum = 0u; cnt = 0u; mine = 0u;
#pragma unroll
        for (unsigned j = 0; j < 16; ++j) { const unsigned c = xb_ld(&bar[XB_XCNT(j)]); sum += c; cnt += (c > 0u) ? 1u : 0u; mine = (j == x) ? c : mine; }
        if (sum == G) break;
        __builtin_amdgcn_s_sleep(1);
        if ((++sp & 255u) == 0u) { if (xb_ld(&bar[XB_TMO])) break; if (sp > XB_SPIN_CAP) { atomicAdd(&bar[XB_TMO], 1u); break; } }
    }
    nloc = mine > 0u ? mine : 1u; nx = cnt > 0u ? cnt : 1u;
}

__device__ __forceinline__ void xcd_barrier(const XcdBarrier& b) {
    asm volatile("s_waitcnt vmcnt(0)" ::: "memory");
    __syncthreads();
    if (threadIdx.x == 0) {
        unsigned* bar = b.bar;
        __builtin_amdgcn_s_waitcnt(0);
        unsigned nloc = b.st[0], nx = b.st[1];
        if (nloc == 0u) { xcd_barrier_complete(bar, b.x, nloc, nx); b.st[0] = nloc; b.st[1] = nx; }
        const unsigned old = xb_add(&bar[XB_XSUB(b.x)], 1u);
        const unsigned gen = old / nloc;
        if (old + 1u == (gen + 1u) * nloc) {
            __builtin_amdgcn_fence(__ATOMIC_RELEASE, "agent");
            asm volatile("s_waitcnt vmcnt(0)" ::: "memory");
            const unsigned og = xb_add(&bar[XB_TOP], 1u);
            const unsigned tg = og / nx;
            if (og + 1u == (tg + 1u) * nx) xb_add(&bar[XB_TOPGEN], 1u);
            else XB_SPIN(xb_ld(&bar[XB_TOPGEN]) == tg, bar);
            __builtin_amdgcn_fence(__ATOMIC_ACQUIRE, "agent");
            xb_add(&bar[XB_XGEN(b.x)], 1u);
            asm volatile("s_waitcnt vmcnt(0)" ::: "memory");
        } else {
            XB_SPIN(xb_ld(&bar[XB_XGEN(b.x)]) == gen, bar);
            __builtin_amdgcn_fence(__ATOMIC_ACQUIRE, "agent");
            asm volatile("s_waitcnt vmcnt(0)" ::: "memory");
        }
    }
    __syncthreads();
}

template <bool COOP>
__global__ void __launch_bounds__(NTHR, 2) mk_fwd(Args args) {
    extern __shared__ __attribute__((aligned(16))) unsigned char lds_raw[];
    Frame F;
    F.lds = (LAS unsigned char*)lds_raw; F.MISC = (volatile LAS unsigned*)(F.lds + MISC_OFF);
    F.tid = threadIdx.x; F.lane = F.tid & 63; F.wave = __builtin_amdgcn_readfirstlane(F.tid >> 6); F.G = gridDim.x; F.bid = blockIdx.x;
    F.in = args.in; F.out = args.out; F.ws = args.ws;
    unsigned char* ws = args.ws;
    const int lo = args.lo, hi = args.hi, bid = F.bid, G = F.G;
#define IN(k) (lo <= (k) && (k) < hi)
    XcdBarrier bar; bar.bar = (unsigned*)(ws + WS_CTL) + 4096; bar.x = 0; bar.st = nullptr;
    if (COOP) { if (F.tid < 2) F.MISC[8 + F.tid] = 0u; __syncthreads(); bar = xcd_barrier_post((unsigned*)(ws + WS_CTL) + 4096, F.MISC + 8); }
#define SEAM(k) do { if (COOP) { if (IN(k) && IN((k) + 1)) { if ((k) == 0) cg::this_grid().sync(); else xcd_barrier(bar); } } } while (0)
    using pg8::Gemm; using pg8::StaticOrder; using pg8::gemm_phase;
    bf16* XB = (bf16*)(ws + WS_XB); float* Hh = (float*)(ws + WS_H); float* R = (float*)(ws + WS_R); float* X = (float*)(ws + WS_X);

    if (IN(0)) { p0_prologue(F); } SEAM(0);
    if (IN(1)) {
        { Gemm g{XB, (const bf16*)(ws + WS_WIN), MT, DIN, DM}; StaticOrder S; S.init(MT, DIN, G, bid); pg8::EpiF32 E{Hh, DIN};
          gemm_phase<pg8::EpiF32, StaticOrder, true, true>(F.lds, g, S, E); }
        { Gemm g{(const bf16*)(ws + WS_MB), (const bf16*)(ws + WS_WKV), 1024, 4096, DM}; StaticOrder S; S.init(1024, 4096, G, (bid + G - 66) % G);
          pg8::EpiMemKV E{F.out + O_MK, F.out + O_MV, (bf16*)(ws + WS_KB)};
          gemm_phase<pg8::EpiMemKV, StaticOrder, true, true>(F.lds, g, S, E); }
        { Gemm g{(const bf16*)(ws + WS_WKV) + (size_t)2048 * DM, (const bf16*)(ws + WS_MB), 2048, 1024, DM}; StaticOrder S; S.init(2048, 1024, G, (bid + G - 130) % G);
          pg8::EpiBf16S E{(bf16*)(ws + WS_VTB), 1024};
          gemm_phase<pg8::EpiBf16S, StaticOrder, true, true>(F.lds, g, S, E); }
    } SEAM(1);
    if (IN(2)) { p2_prep(F); } SEAM(2);
    if (IN(3)) { p3_scans(F); } SEAM(3);
    if (IN(4)) {
        { Gemm g{(const bf16*)(ws + WS_YGB), (const bf16*)(ws + WS_WGLU), MT, DSSM, DSSM}; StaticOrder S; S.init(MT, DSSM, G, bid);
          pg8::EpiGlu E{(const bf16*)(ws + WS_YGB), 1024, F.in[19], (bf16*)(ws + WS_MIX), 2048};
          gemm_phase<pg8::EpiGlu, StaticOrder, true, true>(F.lds, g, S, E); }
        p4_post(F);
    } SEAM(4);
    if (IN(5)) { Gemm g{(const bf16*)(ws + WS_MIX), (const bf16*)(ws + WS_WOUT), MT, DM, DM}; StaticOrder S; S.init(MT, DM, G, bid);
        pg8::EpiRes E{F.in[0], F.in[1], R, DM, ALPHA};
        gemm_phase<pg8::EpiRes, StaticOrder, true, true>(F.lds, g, S, E); } SEAM(5);
    if (IN(6)) { ln_rows(F, R, F.in[32], F.in[33], X, XB); } SEAM(6);
    if (IN(7)) { Gemm g{XB, (const bf16*)(ws + WS_WQ), MT, DM, DM}; StaticOrder S; S.init(MT, DM, G, bid);
        pg8::EpiBf16S E{(bf16*)(ws + WS_QB), DM};
        gemm_phase<pg8::EpiBf16S, StaticOrder, true, true>(F.lds, g, S, E); } SEAM(7);
    if (IN(8)) { p8_attn(F); } SEAM(8);
    if (IN(9)) { Gemm g{(const bf16*)(ws + WS_OB), (const bf16*)(ws + WS_WO), MT, DM, DM}; StaticOrder S; S.init(MT, DM, G, bid);
        pg8::EpiRes E{X, X + (size_t)MP * DM, R, DM, ALPHA};
        gemm_phase<pg8::EpiRes, StaticOrder, true, true>(F.lds, g, S, E); } SEAM(9);
    if (IN(10)) { ln_rows(F, R, F.in[38], F.in[39], X, XB); } SEAM(10);
    if (IN(11)) { Gemm g{XB, (const bf16*)(ws + WS_WGU), MT, 2 * DFF, DM}; StaticOrder S; S.init(MT, 2 * DFF, G, bid);
        pg8::EpiSwiGLU E{(bf16*)(ws + WS_HFF), DFF};
        gemm_phase<pg8::EpiSwiGLU, StaticOrder, true, true>(F.lds, g, S, E); } SEAM(11);
    if (IN(12)) { Gemm g{(const bf16*)(ws + WS_HFF), (const bf16*)(ws + WS_WDN), MT, DM, DFF}; StaticOrder S; S.init(MT, DM, G, bid);
        pg8::EpiRes E{X, X + (size_t)MP * DM, R, DM, ALPHA};
        gemm_phase<pg8::EpiRes, StaticOrder, true, true>(F.lds, g, S, E); } SEAM(12);
    if (IN(13)) { ln_rows(F, R, F.in[43], F.in[44], F.out + O_Y, nullptr); }
#undef IN
#undef SEAM
}

#ifndef MK_COOP
#define MK_COOP 0
#endif
#ifndef MK_PH_HI
#define MK_PH_HI NPHASE
#endif
extern "C" void kernel_launch(void* const* d_in, const int* in_sizes, int n_in, void* d_out, int out_size, void* d_ws, size_t ws_size, hipStream_t stream) {
    static int grid = 0;
    if (grid == 0) {
        if (n_in != 45 || out_size != (int)O_END || ws_size < WS_END) { fprintf(stderr, "kernel_launch: unexpected shapes (n_in %d out %d ws %zu)\n", n_in, out_size, ws_size); grid = -1; return; }
        int dev = 0, cus = 0, per_cu = 0;
        (void)hipGetDevice(&dev); (void)hipDeviceGetAttribute(&cus, hipDeviceAttributeMultiprocessorCount, dev);
        (void)hipFuncSetAttribute((const void*)mk_fwd<true>, hipFuncAttributeMaxDynamicSharedMemorySize, LDS_BYTES);
        (void)hipFuncSetAttribute((const void*)mk_fwd<false>, hipFuncAttributeMaxDynamicSharedMemorySize, LDS_BYTES);
        (void)hipOccupancyMaxActiveBlocksPerMultiprocessor(&per_cu, (const void*)mk_fwd<true>, NTHR, LDS_BYTES);
        (void)hipGetLastError();
        if (per_cu < 1) { fprintf(stderr, "kernel_launch: occupancy query says %d blocks per CU\n", per_cu); per_cu = 1; }
        grid = cus;
    }
    if (grid < 0) return;
    (void)hipMemsetAsync((char*)d_ws + WS_CTL, 0, 65536, stream);
    if (MK_PH_HI < NPHASE) (void)hipMemsetAsync(d_out, 0, (size_t)out_size * 4, stream);
#ifdef MK_DUMP_OFF
#ifndef MK_DUMP_BYTES
#define MK_DUMP_BYTES ((size_t)MT * DM * 4)
#endif
#define MK_DUMP_AFTER (void)hipMemcpyAsync(d_out, (char*)d_ws + (MK_DUMP_OFF), MK_DUMP_BYTES, hipMemcpyDeviceToDevice, stream);
#else
#define MK_DUMP_AFTER
#endif
    Args a{};
    for (int i = 0; i < 45; ++i) a.in[i] = (const float*)d_in[i];
    a.out = (float*)d_out; a.ws = (unsigned char*)d_ws;
#if MK_COOP
    a.lo = 0; a.hi = MK_PH_HI;
    void* kargs[] = {&a};
    hipError_t e = hipLaunchCooperativeKernel((const void*)mk_fwd<true>, dim3(grid), dim3(NTHR), kargs, LDS_BYTES, stream);
    if (e != hipSuccess) fprintf(stderr, "cooperative launch failed: %s (grid %d)\n", hipGetErrorString(e), grid);
#else
    for (int p = 0; p < MK_PH_HI; ++p) { a.lo = p; a.hi = p + 1; hipLaunchKernelGGL(mk_fwd<false>, dim3(grid), dim3(NTHR), LDS_BYTES, stream, a); }
#endif
    MK_DUMP_AFTER
}
```

```cpp
#include <hip/hip_runtime.h>
#include <hip/hip_cooperative_groups.h>
#include <cstdio>
#include <cstdint>
namespace cg = cooperative_groups;
#define MK_COOP 1
namespace pg8 {
#define PG8_LAS __attribute__((address_space(3)))
typedef unsigned short bf16_t;
typedef short bf16x8 __attribute__((ext_vector_type(8)));
typedef float f32x4 __attribute__((ext_vector_type(4)));
typedef unsigned u32x4 __attribute__((ext_vector_type(4)));
constexpr int BM = 256, BK = 64, HALF = 128, HTB = HALF * BK * 2  , STAGE_BYTES = 8 * HTB, NXCD = 8, WGM = 8;

__host__ __device__ __forceinline__ int lds_byte(int r, int c) { const int st = (r >> 4) * 2 + (c >> 5), rr = r & 15, cc = c & 31, ob = rr * 64 + cc * 2; return st * 1024 + (ob ^ (((ob >> 9) & 1) << 5)); }
__host__ __device__ __forceinline__ void stage_rc(int b, int& R, int& C) { const int st = b / 1024, sb = b % 1024, swz = sb ^ (((sb >> 9) & 1) << 5); R = (st >> 1) * 16 + swz / 64; C = (st & 1) * 32 + (swz % 64) / 2; }
__host__ __device__ __forceinline__ int perm32(int rho) { const int n = rho >> 4, i = rho & 15; return 8 * (i >> 2) + 4 * n + (i & 3); }

struct Unit { int pm, pn, koff, nt, ks; };
struct Gemm { const bf16_t* A; const bf16_t* Bt; int M, N, K; };

struct StaticOrder {
    int nM, nN, nwg, G, c, ntk;
    __host__ __device__ void init(int M, int N, int G_, int c_, int K_) { nM = M / BM; nN = N / BM; nwg = nM * nN; G = G_; c = c_; ntk = K_ / BK; }
    __host__ __device__ bool next(int i, Unit& u) const {
        const long L = (long)i * G + c; if (L >= nwg) return false;
        int wgid = (int)L; { const int q = nwg / NXCD, r = nwg % NXCD, xcd = wgid % NXCD, off = wgid / NXCD; wgid = (xcd < r ? xcd * (q + 1) : r * (q + 1) + (xcd - r) * q) + off; }
        const int nig = WGM * nN, gid = wgid / nig, fm = gid * WGM, gsz = (nM - fm) < WGM ? (nM - fm) : WGM;
        u.pm = fm + ((wgid % nig) % gsz); u.pn = (wgid % nig) / gsz; u.koff = 0; u.nt = ntk; u.ks = -1; return true;
    }
    __device__ __forceinline__ void a_ready(const Unit&) const {}
    __device__ __forceinline__ void done(const Unit&) const {}
};
struct MixOrder {
    StaticOrder so; int c, nsplit, ksz, nN, pm0;
    __host__ __device__ void init(int M0, int N, int G_, int c_, int K_, int nsplit_, int ksz_) { so.init(M0, N, G_, c_, K_); c = c_; nsplit = nsplit_; ksz = ksz_; nN = N / BM; pm0 = M0 / BM; }
    __host__ __device__ bool next(int i, Unit& u) const {
        if (i == 0) return so.next(0, u);
        if (i == 1) { const int per = 2 * nN; if (c >= nsplit * per) return false; const int tile = c % per, ks = c / per;
            u.pm = pm0 + tile / nN; u.pn = tile % nN; u.koff = ks * ksz; u.nt = ksz / BK; u.ks = ks; return true; }
        return false;
    }
    __device__ __forceinline__ void a_ready(const Unit&) const {}
    __device__ __forceinline__ void done(const Unit&) const {}
};
typedef float f32x2_cv __attribute__((ext_vector_type(2))); typedef __bf16 bf16x2_cv __attribute__((ext_vector_type(2)));
__device__ __forceinline__ unsigned cvt_pk_bf16(float lo, float hi) { const f32x2_cv v = {lo, hi}; const bf16x2_cv b = __builtin_convertvector(v, bf16x2_cv); return __builtin_bit_cast(unsigned, b); }

__device__ __forceinline__ float bf_lo(unsigned w) { return __builtin_bit_cast(float, w << 16); }
__device__ __forceinline__ float bf_hi(unsigned w) { return __builtin_bit_cast(float, w & 0xffff0000u); }
__device__ __forceinline__ u32x4 pack8(const f32x4 a, const f32x4 b) { u32x4 w; w.x = cvt_pk_bf16(a[0], a[1]); w.y = cvt_pk_bf16(a[2], a[3]); w.z = cvt_pk_bf16(b[0], b[1]); w.w = cvt_pk_bf16(b[2], b[3]); return w; }
__device__ __forceinline__ float sigmoidf_(float x) { return 1.0f / (1.0f + __expf(-x)); }

struct EpiF32 {
    static constexpr bool PERM = true, AFTER_DRAIN = false;
    float* O; int ldc;
    __device__ __forceinline__ void operator()(const f32x4 (&acc)[2][2][4][2], const Unit& u, int wr, int wc, int fr, int fq) const {
        const int row0 = u.pm * BM + wr * 64 + fr, col0 = u.pn * BM + wc * 32 + 8 * fq;
#pragma unroll
        for (int ai = 0; ai < 2; ++ai)
#pragma unroll
            for (int m = 0; m < 4; ++m) { float* rowp = O + (size_t)(row0 + ai * HALF + m * 16) * ldc + col0;
#pragma unroll
                for (int bj = 0; bj < 2; ++bj) { *(f32x4*)(rowp + bj * HALF) = acc[ai][bj][m][0]; *(f32x4*)(rowp + bj * HALF + 4) = acc[ai][bj][m][1]; } }
    }
};
struct EpiMemKV {
    static constexpr bool PERM = true, AFTER_DRAIN = false;
    float* outK; float* outV; bf16_t* Kb;
    __device__ __forceinline__ void operator()(const f32x4 (&acc)[2][2][4][2], const Unit& u, int wr, int wc, int fr, int fq) const {
        const int row0 = u.pm * BM + wr * 64 + fr; const int colt = u.pn * BM; const bool isV = colt >= 2048;
        float* o = isV ? outV : outK; const int col0 = (isV ? colt - 2048 : colt) + wc * 32 + 8 * fq;
#pragma unroll
        for (int ai = 0; ai < 2; ++ai)
#pragma unroll
            for (int m = 0; m < 4; ++m)
#pragma unroll
                for (int bj = 0; bj < 2; ++bj) { const size_t off = (size_t)(row0 + ai * HALF + m * 16) * 2048 + col0 + bj * HALF;
                    *(f32x4*)(o + off) = acc[ai][bj][m][0]; *(f32x4*)(o + off + 4) = acc[ai][bj][m][1];
                    if (!isV) *(u32x4*)(Kb + off) = pack8(acc[ai][bj][m][0], acc[ai][bj][m][1]); }
    }
};
struct EpiBf16S {
    static constexpr bool PERM = true, AFTER_DRAIN = false;
    bf16_t* O; int ldc; float* part;
    __device__ __forceinline__ void operator()(const f32x4 (&acc)[2][2][4][2], const Unit& u, int wr, int wc, int fr, int fq) const {
        const int row0 = u.pm * BM + wr * 64 + fr, col0 = u.pn * BM + wc * 32 + 8 * fq;
        if (u.ks >= 0) {
#pragma unroll
            for (int ai = 0; ai < 2; ++ai)
#pragma unroll
                for (int m = 0; m < 4; ++m) { float* rowp = part + ((size_t)u.ks * 512 + (row0 + ai * HALF + m * 16 - 8192)) * ldc + col0;
#pragma unroll
                    for (int bj = 0; bj < 2; ++bj) { *(f32x4*)(rowp + bj * HALF) = acc[ai][bj][m][0]; *(f32x4*)(rowp + bj * HALF + 4) = acc[ai][bj][m][1]; } }
            return; }
#pragma unroll
        for (int ai = 0; ai < 2; ++ai)
#pragma unroll
            for (int m = 0; m < 4; ++m) { bf16_t* rowp = O + (size_t)(row0 + ai * HALF + m * 16) * ldc + col0;
#pragma unroll
                for (int bj = 0; bj < 2; ++bj) *(u32x4*)(rowp + bj * HALF) = pack8(acc[ai][bj][m][0], acc[ai][bj][m][1]); }
    }
};
struct EpiGlu {
    static constexpr bool PERM = true, AFTER_DRAIN = false;
    const bf16_t* Y; int ldy; const float* bias; bf16_t* O; int ldo;
    __device__ __forceinline__ void operator()(const f32x4 (&acc)[2][2][4][2], const Unit& u, int wr, int wc, int fr, int fq) const {
        const int row0 = u.pm * BM + wr * 64 + fr, col0 = u.pn * BM + wc * 32 + 8 * fq;
#pragma unroll
        for (int bj = 0; bj < 2; ++bj) { const f32x4 b0 = *(const f32x4*)(bias + col0 + bj * HALF), b1 = *(const f32x4*)(bias + col0 + bj * HALF + 4);
#pragma unroll
            for (int ai = 0; ai < 2; ++ai)
#pragma unroll
                for (int m = 0; m < 4; ++m) { const int row = row0 + ai * HALF + m * 16;
                    const u32x4 yv = *(const u32x4*)(Y + (size_t)row * ldy + col0 + bj * HALF);
                    const f32x4 a0 = acc[ai][bj][m][0] + b0, a1 = acc[ai][bj][m][1] + b1; f32x4 z0, z1;
                    z0[0] = bf_lo(yv.x) * sigmoidf_(a0[0]); z0[1] = bf_hi(yv.x) * sigmoidf_(a0[1]); z0[2] = bf_lo(yv.y) * sigmoidf_(a0[2]); z0[3] = bf_hi(yv.y) * sigmoidf_(a0[3]);
                    z1[0] = bf_lo(yv.z) * sigmoidf_(a1[0]); z1[1] = bf_hi(yv.z) * sigmoidf_(a1[1]); z1[2] = bf_lo(yv.w) * sigmoidf_(a1[2]); z1[3] = bf_hi(yv.w) * sigmoidf_(a1[3]);
                    *(u32x4*)(O + (size_t)row * ldo + col0 + bj * HALF) = pack8(z0, z1); } }
    }
};
struct EpiRes {
    static constexpr bool PERM = true, AFTER_DRAIN = false;
    const float* base0; const float* base1; float* O; int ld; float alpha; float* part;
    __device__ __forceinline__ void operator()(const f32x4 (&acc)[2][2][4][2], const Unit& u, int wr, int wc, int fr, int fq) const {
        const int row0 = u.pm * BM + wr * 64 + fr, col0 = u.pn * BM + wc * 32 + 8 * fq;
        if (u.ks >= 0) {
#pragma unroll
            for (int ai = 0; ai < 2; ++ai)
#pragma unroll
                for (int m = 0; m < 4; ++m) { float* rowp = part + ((size_t)u.ks * 512 + (row0 + ai * HALF + m * 16 - 8192)) * ld + col0;
#pragma unroll
                    for (int bj = 0; bj < 2; ++bj) { *(f32x4*)(rowp + bj * HALF) = acc[ai][bj][m][0]; *(f32x4*)(rowp + bj * HALF + 4) = acc[ai][bj][m][1]; } }
            return; }
        const bool lo = (u.pm * BM) < 8192; const float* bp = lo ? base0 : base1; const int rsub = lo ? 0 : 8192;
#pragma unroll
        for (int ai = 0; ai < 2; ++ai)
#pragma unroll
            for (int m = 0; m < 4; ++m) { const int row = row0 + ai * HALF + m * 16; const float* brow = bp + (size_t)(row - rsub) * ld + col0; float* orow = O + (size_t)row * ld + col0;
#pragma unroll
                for (int bj = 0; bj < 2; ++bj) { const f32x4 x0 = *(const f32x4*)(brow + bj * HALF), x1 = *(const f32x4*)(brow + bj * HALF + 4);
                    *(f32x4*)(orow + bj * HALF) = x0 * alpha + acc[ai][bj][m][0]; *(f32x4*)(orow + bj * HALF + 4) = x1 * alpha + acc[ai][bj][m][1]; } }
    }
};
struct EpiSwiGLU {
    static constexpr bool PERM = true, AFTER_DRAIN = false;
    bf16_t* O; int ldo;
    __device__ __forceinline__ void operator()(const f32x4 (&acc)[2][2][4][2], const Unit& u, int wr, int wc, int fr, int fq) const {
        const int row0 = u.pm * BM + wr * 64 + fr, col0 = u.pn * HALF + wc * 32 + 8 * fq;
#pragma unroll
        for (int ai = 0; ai < 2; ++ai)
#pragma unroll
            for (int m = 0; m < 4; ++m) { f32x4 h0, h1;
#pragma unroll
                for (int j = 0; j < 4; ++j) { const float g0 = acc[ai][0][m][0][j], g1 = acc[ai][0][m][1][j];
                    h0[j] = g0 * sigmoidf_(g0) * acc[ai][1][m][0][j]; h1[j] = g1 * sigmoidf_(g1) * acc[ai][1][m][1][j]; }
                *(u32x4*)(O + (size_t)(row0 + ai * HALF + m * 16) * ldo + col0) = pack8(h0, h1); }
    }
};

template <class Epi, class Sched, bool ALIGN_EPI = false, bool SP2 = false>
__device__ __forceinline__ void gemm_phase(PG8_LAS unsigned char* lds, const Gemm g, const Sched& S, const Epi& E) {
    const int tid = threadIdx.x, wid = __builtin_amdgcn_readfirstlane(tid >> 6), lane = tid & 63, wr = wid >> 2, wc = wid & 3, fr = lane & 15, fq = lane >> 4;
    const int K = g.K;
    unsigned voffA[2], voffB[2];
#pragma unroll
    for (int i = 0; i < 2; ++i) { int R, C; stage_rc(tid * 16 + i * 8192, R, C); const int Rb = Epi::PERM ? ((R & ~31) + perm32(R & 31)) : R;
        voffA[i] = (unsigned)(R * K + C) * 2u; voffB[i] = (unsigned)(Rb * K + C) * 2u; }
    const size_t kstep = (size_t)(BK * 2);
    const size_t hstep = (size_t)HALF * K * 2;
    const size_t tstep = 2 * hstep;
    const unsigned ldsw = (unsigned)wid * 1024u;
    const int aoff = lds_byte(wr * 64 + fr, fq * 8), boff = lds_byte(wc * 32 + fr, fq * 8);
#define PG8_SA(b, h) (((b) * 2 + (h)) * HTB)
#define PG8_SB(b, h) ((4 + (b) * 2 + (h)) * HTB)
#define PG8_STAGE(bufoff, gbase, voff) do { _Pragma("unroll") for (int _i = 0; _i < 2; ++_i) \
        __builtin_amdgcn_global_load_lds((const unsigned*)((const char*)(gbase) + (voff)[_i]), (PG8_LAS unsigned*)(lds + (bufoff) + ldsw + _i * 8192), 16, 0, 0); } while (0)
#define PG8_LDA(dst, b, h) do { _Pragma("unroll") for (int m = 0; m < 4; ++m) _Pragma("unroll") for (int k = 0; k < 2; ++k) dst[m][k] = *(const PG8_LAS bf16x8*)(lds + PG8_SA(b, h) + aoff + m * 2048 + k * 1024); } while (0)
#define PG8_LDB(dst, b, h) do { _Pragma("unroll") for (int n = 0; n < 2; ++n) _Pragma("unroll") for (int k = 0; k < 2; ++k) dst[n][k] = *(const PG8_LAS bf16x8*)(lds + PG8_SB(b, h) + boff + n * 2048 + k * 1024); } while (0)
#define PG8_MMA(ai, bj, At, Bt) do { __builtin_amdgcn_s_setprio(1); _Pragma("unroll") for (int m = 0; m < 4; ++m) _Pragma("unroll") for (int n = 0; n < 2; ++n) _Pragma("unroll") for (int k = 0; k < 2; ++k) \
        acc[ai][bj][m][n] = __builtin_amdgcn_mfma_f32_16x16x32_bf16(Bt[n][k], At[m][k], acc[ai][bj][m][n], 0, 0, 0); __builtin_amdgcn_s_setprio(0); } while (0)
#define PG8_WAIT_V(n) asm volatile("s_waitcnt vmcnt(" #n ")" ::: "memory")
#define PG8_WAIT_L(n) asm volatile("s_waitcnt lgkmcnt(" #n ")" ::: "memory")
#define PG8_BAR __builtin_amdgcn_s_barrier()
#define PG8_SCHED __builtin_amdgcn_sched_barrier(0)
    Unit cur, nxt; int ui = 0;
    if (!S.next(0, cur)) return;
    f32x4 acc[2][2][4][2];
#pragma unroll
    for (int a = 0; a < 2; ++a)
#pragma unroll
        for (int b = 0; b < 2; ++b)
#pragma unroll
            for (int m = 0; m < 4; ++m)
#pragma unroll
                for (int n = 0; n < 2; ++n) acc[a][b][m][n] = (f32x4){0.f, 0.f, 0.f, 0.f};
    bf16x8 At[4][2], B0[2][2], B1[2][2];
    const char* cA = (const char*)g.A + (size_t)cur.pm * tstep + (size_t)cur.koff * 2; const char* cB = (const char*)g.Bt + (size_t)cur.pn * tstep + (size_t)cur.koff * 2;
    S.a_ready(cur);
    if constexpr (SP2) {
        PG8_STAGE(PG8_SB(0, 0), cB, voffB); PG8_STAGE(PG8_SB(0, 1), cB + hstep, voffB); PG8_STAGE(PG8_SA(0, 0), cA, voffA); PG8_STAGE(PG8_SA(0, 1), cA + hstep, voffA);
        if (wr == 1) PG8_BAR;
        PG8_WAIT_V(2); PG8_BAR;
        PG8_STAGE(PG8_SB(1, 0), cB + kstep, voffB); PG8_STAGE(PG8_SA(1, 0), cA + kstep, voffA); PG8_STAGE(PG8_SB(1, 1), cB + hstep + kstep, voffB);
        PG8_WAIT_V(6); PG8_BAR;
    } else {
        PG8_STAGE(PG8_SB(0, 0), cB, voffB); PG8_STAGE(PG8_SA(0, 0), cA, voffA); PG8_STAGE(PG8_SB(0, 1), cB + hstep, voffB); PG8_STAGE(PG8_SA(0, 1), cA + hstep, voffA);
        if (wr == 1) PG8_BAR;
        PG8_WAIT_V(4); PG8_BAR;
        PG8_STAGE(PG8_SB(1, 0), cB + kstep, voffB); PG8_STAGE(PG8_SA(1, 0), cA + kstep, voffA); PG8_STAGE(PG8_SB(1, 1), cB + hstep + kstep, voffB);
        PG8_WAIT_V(6); PG8_BAR;
    }
    for (;;) {
        const bool has_next = S.next(ui + 1, nxt);
        const char* nA = has_next ? (const char*)g.A + (size_t)nxt.pm * tstep + (size_t)nxt.koff * 2 : cA; const char* nB = has_next ? (const char*)g.Bt + (size_t)nxt.pn * tstep + (size_t)nxt.koff * 2 : cB;
        const int nt = cur.nt;
        for (int t = 0; t < nt; t += 2) {
            const bool last = (t == nt - 2);
            const char* a1 = cA + (size_t)(t + 1) * kstep;
            const char* a2 = last ? nA : cA + (size_t)(t + 2) * kstep; const char* b2 = last ? nB : cB + (size_t)(t + 2) * kstep;
            const char* a3 = a2 + kstep; const char* b3 = b2 + kstep;
            if (last && has_next) S.a_ready(nxt);
            if constexpr (SP2) {
            PG8_LDB(B0, 0, 0); PG8_LDB(B1, 0, 1); PG8_SCHED; PG8_LDA(At, 0, 0); PG8_STAGE(PG8_SA(1, 1), a1 + hstep, voffA);
            PG8_WAIT_V(8); PG8_WAIT_L(0); PG8_BAR; PG8_MMA(0, 0, At, B0); PG8_MMA(0, 1, At, B1); PG8_BAR; PG8_SCHED;
            PG8_LDA(At, 0, 1); PG8_STAGE(PG8_SB(0, 0), b2, voffB); PG8_STAGE(PG8_SB(0, 1), b2 + hstep, voffB); PG8_STAGE(PG8_SA(0, 0), a2, voffA);
            PG8_WAIT_V(8); PG8_WAIT_L(0); PG8_BAR; PG8_MMA(1, 0, At, B0); PG8_MMA(1, 1, At, B1); PG8_BAR; PG8_SCHED;
            PG8_LDB(B0, 1, 0); PG8_LDB(B1, 1, 1); PG8_SCHED; PG8_LDA(At, 1, 0); PG8_STAGE(PG8_SA(0, 1), a2 + hstep, voffA);
            PG8_WAIT_V(8); PG8_WAIT_L(0); PG8_BAR; PG8_MMA(0, 0, At, B0); PG8_MMA(0, 1, At, B1); PG8_BAR; PG8_SCHED;
            PG8_LDA(At, 1, 1); PG8_STAGE(PG8_SB(1, 0), b3, voffB); PG8_STAGE(PG8_SB(1, 1), b3 + hstep, voffB); PG8_STAGE(PG8_SA(1, 0), a3, voffA);
            PG8_WAIT_V(8); PG8_WAIT_L(0); PG8_BAR; PG8_MMA(1, 0, At, B0); PG8_MMA(1, 1, At, B1); PG8_BAR; PG8_SCHED;
            } else {
            PG8_LDB(B0, 0, 0); PG8_SCHED; PG8_LDA(At, 0, 0); PG8_STAGE(PG8_SA(1, 1), a1 + hstep, voffA);
            PG8_WAIT_L(8); PG8_BAR; PG8_WAIT_L(0); PG8_MMA(0, 0, At, B0); PG8_BAR; PG8_SCHED;
            PG8_LDB(B1, 0, 1); PG8_STAGE(PG8_SB(0, 0), b2, voffB);
            PG8_BAR; PG8_WAIT_L(0); PG8_MMA(0, 1, At, B1); PG8_BAR;
            PG8_LDA(At, 0, 1); PG8_STAGE(PG8_SA(0, 0), a2, voffA);
            PG8_BAR; PG8_WAIT_L(0); PG8_MMA(1, 0, At, B0); PG8_BAR; PG8_SCHED;
            PG8_STAGE(PG8_SB(0, 1), b2 + hstep, voffB);
            PG8_WAIT_V(6); PG8_BAR; PG8_MMA(1, 1, At, B1); PG8_BAR;
            PG8_LDB(B0, 1, 0); PG8_SCHED; PG8_LDA(At, 1, 0); PG8_STAGE(PG8_SA(0, 1), a2 + hstep, voffA);
            PG8_WAIT_L(8); PG8_BAR; PG8_WAIT_L(0); PG8_MMA(0, 0, At, B0); PG8_BAR; PG8_SCHED;
            PG8_LDB(B1, 1, 1); PG8_STAGE(PG8_SB(1, 0), b3, voffB);
            PG8_BAR; PG8_WAIT_L(0); PG8_MMA(0, 1, At, B1); PG8_BAR;
            PG8_LDA(At, 1, 1); PG8_STAGE(PG8_SA(1, 0), a3, voffA);
            PG8_BAR; PG8_WAIT_L(0); PG8_MMA(1, 0, At, B0); PG8_BAR; PG8_SCHED;
            PG8_STAGE(PG8_SB(1, 1), b3 + hstep, voffB);
            PG8_WAIT_V(6); PG8_BAR; PG8_MMA(1, 1, At, B1); PG8_BAR;
            }
        }
        if constexpr (ALIGN_EPI) { if (wr == 0) PG8_BAR; }
        if constexpr (!Epi::AFTER_DRAIN) { E(acc, cur, wr, wc, fr, fq); S.done(cur); }
        if (!has_next) break;
#pragma unroll
        for (int a = 0; a < 2; ++a)
#pragma unroll
            for (int b = 0; b < 2; ++b)
#pragma unroll
                for (int m = 0; m < 4; ++m)
#pragma unroll
                    for (int n = 0; n < 2; ++n) acc[a][b][m][n] = (f32x4){0.f, 0.f, 0.f, 0.f};
        cur = nxt; cA = nA; cB = nB; ++ui;
        if constexpr (ALIGN_EPI) { if (wr == 1) PG8_BAR; }
    }
    PG8_WAIT_V(0);
    if constexpr (!ALIGN_EPI) { if (wr == 0) PG8_BAR; }
    PG8_BAR;
    if constexpr (Epi::AFTER_DRAIN) { E.fused(acc, cur, wr, wc, fr, fq, lds, wid, lane); S.done(cur); }
#undef PG8_SA
#undef PG8_SB
#undef PG8_STAGE
#undef PG8_LDA
#undef PG8_LDB
#undef PG8_MMA
#undef PG8_WAIT_V
#undef PG8_WAIT_L
#undef PG8_BAR
#undef PG8_SCHED
}
}

#ifndef MK_REP
#define MK_REP -1
#endif
constexpr int NWAVES = 8, NTHR = 512;
constexpr int MT = 8704, MP = 8192, DM = 2048, DIN = 4352, DSSM = 1024, DRW = 1024, DSH = 3328, DFF = 5632, NMEM = 256;
constexpr float ALPHA = 1.189207115002721f;
constexpr float LN_EPS = 1e-5f, GN_EPS = 64e-5f;
constexpr size_t O_Y = 0, O_SRE_P = (size_t)MT * DM, O_SIM_P = O_SRE_P + 16384, O_WKV_P = O_SIM_P + 16384, O_SH_P = O_WKV_P + 262144, O_MK = O_SH_P + 4 * DSH,
                 O_MV = O_MK + 2097152, O_SRE_S = O_MV + 2097152, O_SIM_S = O_SRE_S + 524288, O_WKV_S = O_SIM_S + 524288, O_SH_S = O_WKV_S + 8388608, O_END = O_SH_S + 128 * DSH;
static_assert(O_END == 32191488, "output size");
constexpr size_t MiB = 1u << 20;
constexpr size_t WS_CTL = 0, WS_WIN = 1 * MiB, WS_WGLU = 18 * MiB, WS_WOUT = 20 * MiB, WS_WQ = 28 * MiB, WS_WKV = 36 * MiB, WS_WO = 52 * MiB, WS_WGU = 60 * MiB, WS_WDN = 104 * MiB,
                 WS_W2T = 126 * MiB, WS_A2T = WS_W2T + 131072, WS_G2T = WS_W2T + 262144, WS_KB = 127 * MiB, WS_VTB = 131 * MiB, WS_XB = 135 * MiB, WS_MB = 169 * MiB,
                 WS_H = 173 * MiB, WS_R = WS_H, WS_X = WS_H + 72 * MiB, WS_PREP = 318 * MiB, WS_BONUS = 556 * MiB, WS_QB = WS_PREP, WS_OB = WS_PREP + 34 * MiB, WS_HFF = WS_PREP + 68 * MiB,
                 WS_YR = 557 * MiB, WS_YGB = 591 * MiB, WS_MIX = 608 * MiB, WS_PART = 642 * MiB, WS_END = 706 * MiB;
constexpr size_t PREP_STRIDE = 34 * MiB;
constexpr int LDS_BYTES = 135168;
constexpr int MISC_OFF = 131072;
constexpr int NPHASE = 14;

#define LAS __attribute__((address_space(3)))
typedef unsigned short bf16;
typedef unsigned v4u __attribute__((ext_vector_type(4)));
typedef unsigned v2u __attribute__((ext_vector_type(2)));
typedef float f32x4 __attribute__((ext_vector_type(4)));
typedef float f32x2 __attribute__((ext_vector_type(2)));
typedef float f32x16 __attribute__((ext_vector_type(16)));
typedef short bf16x8 __attribute__((ext_vector_type(8)));
#define LDS_WAIT() asm volatile("s_waitcnt lgkmcnt(0)" ::: "memory")

__device__ __forceinline__ unsigned pk2(float lo, float hi) { return pg8::cvt_pk_bf16(lo, hi); }
__device__ __forceinline__ bf16x8 pack_bf8(const f32x4 a, const f32x4 b) { v4u w; w.x = pk2(a[0], a[1]); w.y = pk2(a[2], a[3]); w.z = pk2(b[0], b[1]); w.w = pk2(b[2], b[3]); return __builtin_bit_cast(bf16x8, w); }
__device__ __forceinline__ float wave_sum(float v) {
#pragma unroll
    for (int o = 1; o < 64; o <<= 1) v += __shfl_xor(v, o);
    return v;
}
__device__ __forceinline__ float wave_max(float v) {
#pragma unroll
    for (int o = 1; o < 64; o <<= 1) v = fmaxf(v, __shfl_xor(v, o));
    return v;
}
template <int CTRL> __device__ __forceinline__ float dpp_f(float x) { return __builtin_bit_cast(float, __builtin_amdgcn_update_dpp(0, __builtin_bit_cast(int, x), CTRL, 0xf, 0xf, false)); }
__device__ __forceinline__ float sum16(float x) { x += dpp_f<0xB1>(x); x += dpp_f<0x4E>(x); x += dpp_f<0x141>(x); x += dpp_f<0x140>(x); return x; }
__device__ __forceinline__ float sigm(float x) { return 1.0f / (1.0f + __expf(-x)); }
__device__ __forceinline__ float tanh_(float x) { return 1.0f - 2.0f / (1.0f + __expf(2.0f * x)); }
__device__ __forceinline__ float gelu_tanh(float x) { const float u = 1.5957691216057308f * (x + 0.044715f * x * x * x); return x / (1.0f + __expf(-u)); }
#define MFMA16(a, b, c) __builtin_amdgcn_mfma_f32_16x16x32_bf16((a), (b), (c), 0, 0, 0)
#define MFMA32(a, b, c) __builtin_amdgcn_mfma_f32_32x32x16_bf16((a), (b), (c), 0, 0, 0)

struct Args { const float* in[45]; float* out; unsigned char* ws; int lo, hi; };

struct Frame {
    LAS unsigned char* lds; volatile LAS unsigned* MISC;
    int tid, lane, wave, G, bid;
    const float* const* in; float* out; unsigned char* ws;
};

__device__ __forceinline__ void tr_item(const float* W, int K, int N, bf16* WT, int drow0, int k0, int n0, LAS float* scr, int lane) {
#pragma unroll 8
    for (int i = 0; i < 32; ++i) { const int kk = 2 * i + (lane >> 5); scr[kk * 33 + (lane & 31)] = W[(size_t)(k0 + kk) * N + n0 + (lane & 31)]; }
    LDS_WAIT(); asm volatile("" ::: "memory");
    const int c = lane & 7;
#pragma unroll
    for (int j = 0; j < 4; ++j) { const int n = (lane >> 3) + 8 * j; const LAS float* s = scr + (8 * c) * 33 + n;
        v4u o; o.x = pk2(s[0 * 33], s[1 * 33]); o.y = pk2(s[2 * 33], s[3 * 33]); o.z = pk2(s[4 * 33], s[5 * 33]); o.w = pk2(s[6 * 33], s[7 * 33]);
        *(v4u*)(WT + (size_t)(drow0 + n) * K + k0 + 8 * c) = o; }
    LDS_WAIT(); asm volatile("" ::: "memory");
}
__device__ __forceinline__ void p0_prologue(Frame& F) {
    LAS float* scr = (LAS float*)(F.lds + F.wave * 16384);
    const int gw = F.bid * NWAVES + F.wave, NGW = F.G * NWAVES, lane = F.lane;
    unsigned char* ws = F.ws;
#define TR_MAT(Wp, Kk, Nn, Dst, ROWMAP) { const int nblk = (Nn) / 32, cnt = ((Kk) / 64) * nblk; if (r < cnt) { const int kb = r / nblk, n0 = (r % nblk) * 32; \
        tr_item((Wp), (Kk), (Nn), (bf16*)(Dst), (ROWMAP), kb * 64, n0, scr, lane); continue; } r -= cnt; }
    constexpr int NITEMS = 32 * 136 + 16 * 32 + 5 * 32 * 64 + 2 * 32 * 176 + 88 * 64 + 32 + 32 + 64;
    for (int it = gw; it < NITEMS; it += NGW) {
        int r = it;
        TR_MAT(F.in[9], DM, DIN, ws + WS_WIN, n0)
        TR_MAT(F.in[18], DSSM, DSSM, ws + WS_WGLU, n0)
        TR_MAT(F.in[31], DM, DM, ws + WS_WOUT, n0)
        TR_MAT(F.in[34], DM, DM, ws + WS_WQ, n0)
        TR_MAT(F.in[35], DM, DM, ws + WS_WKV, n0)
        TR_MAT(F.in[36], DM, DM, ws + WS_WKV, 2048 + n0)
        TR_MAT(F.in[37], DM, DM, ws + WS_WO, n0)
        TR_MAT(F.in[40], DM, DFF, ws + WS_WGU, 256 * (n0 / 128) + (n0 % 128))
        TR_MAT(F.in[41], DM, DFF, ws + WS_WGU, 256 * (n0 / 128) + 128 + (n0 % 128))
        TR_MAT(F.in[42], DFF, DM, ws + WS_WDN, n0)
        TR_MAT(F.in[22], 64, DRW, ws + WS_W2T, n0)
        TR_MAT(F.in[24], 64, DRW, ws + WS_A2T, n0)
        TR_MAT(F.in[25], 128, DRW, ws + WS_G2T, n0)
    }
#undef TR_MAT
    const size_t gt = (size_t)F.bid * NTHR + F.tid, NGT = (size_t)F.G * NTHR;
    { const f32x4* xp = (const f32x4*)F.in[0]; const f32x4* xs = (const f32x4*)F.in[1]; v4u* xb = (v4u*)(ws + WS_XB);
      const size_t np = (size_t)MP * DM / 8, nt = (size_t)MT * DM / 8;
      for (size_t i = gt; i < nt; i += NGT) { const f32x4* s = i < np ? xp + 2 * i : xs + 2 * (i - np); const f32x4 a = s[0], b = s[1]; xb[i] = pg8::pack8(a, b); } }
    { const f32x4* mp = (const f32x4*)F.in[2]; v4u* mb = (v4u*)(ws + WS_MB); const size_t nm = (size_t)1024 * DM / 8;
      for (size_t i = gt; i < nm; i += NGT) { const f32x4 a = mp[2 * i], b = mp[2 * i + 1]; mb[i] = pg8::pack8(a, b); } }
}

__device__ __forceinline__ void p2_prep(Frame& F) {
    const float* H = (const float*)(F.ws + WS_H);
    const float* mu = F.in[20]; const float* w0 = F.in[21]; const float* a0 = F.in[23]; const float* k_k = F.in[26]; const float* k_a = F.in[27]; const float* r_k = F.in[28];
    const bf16* W2T = (const bf16*)(F.ws + WS_W2T); const bf16* A2T = (const bf16*)(F.ws + WS_A2T); const bf16* G2T = (const bf16*)(F.ws + WS_G2T);
    float* PR = (float*)(F.ws + WS_PREP); constexpr size_t PS = PREP_STRIDE / 4;
    float* BON = (float*)(F.ws + WS_BONUS);
    const int lane = F.lane, fr = lane & 15, fq = lane >> 4;
    for (int tile = F.bid; tile < MT / 16; tile += F.G) {
        const int m = tile * 16 + fr;
        const float* prow = H + (size_t)m * DIN + 1024;
        const bool prompt = m < MP; const int t = prompt ? (m & 2047) : ((m - MP) & 3);
        const float* qrow = prow - DIN; float qs = 1.0f;
        if (t == 0) { if (prompt) { qrow = prow; qs = 0.0f; } else qrow = F.in[6] + (size_t)((m - MP) >> 2) * DSH; }
#define PS4(col) ({ const f32x4 p_ = *(const f32x4*)(prow + (col)); const f32x4 q_ = *(const f32x4*)(qrow + (col)) * qs; const f32x4 m_ = *(const f32x4*)(mu + (col)); p_ + (q_ - p_) * m_; })
        bf16x8 bw[2], ba[2], bg[4];
#pragma unroll
        for (int kc = 0; kc < 2; ++kc) { f32x4 x0 = PS4(3072 + 32 * kc + 8 * fq), x1 = PS4(3072 + 32 * kc + 8 * fq + 4);
#pragma unroll
            for (int j = 0; j < 4; ++j) { x0[j] = tanh_(x0[j]); x1[j] = tanh_(x1[j]); }
            bw[kc] = pack_bf8(x0, x1);
            const f32x4 y0 = PS4(3136 + 32 * kc + 8 * fq), y1 = PS4(3136 + 32 * kc + 8 * fq + 4); ba[kc] = pack_bf8(y0, y1); }
#pragma unroll
        for (int kc = 0; kc < 4; ++kc) { f32x4 x0 = PS4(3200 + 32 * kc + 8 * fq), x1 = PS4(3200 + 32 * kc + 8 * fq + 4);
#pragma unroll
            for (int j = 0; j < 4; ++j) { x0[j] = sigm(x0[j]); x1[j] = sigm(x1[j]); }
            bg[kc] = pack_bf8(x0, x1); }
#pragma unroll 1
        for (int hi = 0; hi < 2; ++hi) {
            const int hd = 2 * F.wave + hi;
            f32x4 accW[4], accA[4], accG[4];
#pragma unroll
            for (int ct = 0; ct < 4; ++ct) { const int c = 64 * hd + 16 * ct + fr;
                accW[ct] = (f32x4){0.f, 0.f, 0.f, 0.f}; accA[ct] = accW[ct]; accG[ct] = accW[ct];
#pragma unroll
                for (int kc = 0; kc < 2; ++kc) { accW[ct] = MFMA16(*(const bf16x8*)(W2T + c * 64 + 32 * kc + 8 * fq), bw[kc], accW[ct]);
                                                  accA[ct] = MFMA16(*(const bf16x8*)(A2T + c * 64 + 32 * kc + 8 * fq), ba[kc], accA[ct]); }
#pragma unroll
                for (int kc = 0; kc < 4; ++kc) accG[ct] = MFMA16(*(const bf16x8*)(G2T + c * 128 + 32 * kc + 8 * fq), bg[kc], accG[ct]); }
            f32x4 av[4], kkr[4]; float ss = 0.f, bon = 0.f;
#pragma unroll
            for (int ct = 0; ct < 4; ++ct) { const int col = 64 * hd + 16 * ct + 4 * fq; const size_t o = (size_t)m * 1024 + col;
                const f32x4 r4 = PS4(col), k4 = PS4(1024 + col), v4 = PS4(2048 + col);
                const f32x4 w04 = *(const f32x4*)(w0 + col), a04 = *(const f32x4*)(a0 + col), kk4 = *(const f32x4*)(k_k + col), ka4 = *(const f32x4*)(k_a + col), rk4 = *(const f32x4*)(r_k + col);
                f32x4 dec, a, km;
#pragma unroll
                for (int j = 0; j < 4; ++j) { const float z = -(w04[j] + accW[ct][j]); const float sp = fmaxf(z, 0.f) + log1pf(__expf(-fabsf(z))); const float wl = -sp - 0.5f;
                    dec[j] = __expf(-__expf(wl)); a[j] = sigm(a04[j] + accA[ct][j]); km[j] = k4[j] * (1.0f + (a[j] - 1.0f) * ka4[j]);
                    const float kr = k4[j] * kk4[j]; kkr[ct][j] = kr; ss += kr * kr; bon += r4[j] * km[j] * rk4[j]; }
                av[ct] = a;
                *(f32x4*)(PR + 0 * PS + o) = r4; *(f32x4*)(PR + 1 * PS + o) = dec; *(f32x4*)(PR + 2 * PS + o) = km; *(f32x4*)(PR + 3 * PS + o) = v4; *(f32x4*)(PR + 6 * PS + o) = accG[ct]; }
            ss += __shfl_xor(ss, 16); ss += __shfl_xor(ss, 32); bon += __shfl_xor(bon, 16); bon += __shfl_xor(bon, 32);
            const float inv = rsqrtf(fmaxf(ss, 1e-24f));
#pragma unroll
            for (int ct = 0; ct < 4; ++ct) { const size_t o = (size_t)m * 1024 + 64 * hd + 16 * ct + 4 * fq; const f32x4 kk = kkr[ct] * inv;
                *(f32x4*)(PR + 4 * PS + o) = kk; *(f32x4*)(PR + 5 * PS + o) = kk * av[ct]; }
            if (fq == 0) BON[(size_t)m * 16 + hd] = bon;
        }
#undef PS4
    }
    { const int gt = F.bid * NTHR + F.tid, NGT = F.G * NTHR;
      for (int i = gt; i < 132 * (DSH / 4); i += NGT) { const int s = i / (DSH / 4), c4 = i % (DSH / 4);
          const int m = s < 4 ? s * 2048 + 2047 : MP + 4 * (s - 4) + 3;
          float* o = s < 4 ? F.out + O_SH_P + (size_t)s * DSH : F.out + O_SH_S + (size_t)(s - 4) * DSH;
          *(f32x4*)(o + 4 * c4) = *(const f32x4*)(H + (size_t)m * DIN + 1024 + 4 * c4); } }
}

__device__ __forceinline__ void grp_bar(volatile LAS unsigned* cnt, unsigned& gen, int lane) {
    gen += 4u; LDS_WAIT();
    if (lane == 0) (void)__hip_atomic_fetch_add((LAS unsigned*)cnt, 1u, __ATOMIC_RELAXED, __HIP_MEMORY_SCOPE_WORKGROUP);
    while (*cnt < gen) __builtin_amdgcn_s_sleep(1);
    asm volatile("" ::: "memory");
}
__device__ __forceinline__ void rwkv_scan_prompt(Frame& F, int b, int h, int quarter) {
    const float* PR = (const float*)(F.ws + WS_PREP); constexpr size_t PS = PREP_STRIDE / 4;
    float* YR = (float*)(F.ws + WS_YR);
    const int tid = F.tid, lane = F.lane, rr = lane >> 4, kq = lane & 15, v = 16 * quarter + 4 * F.wave + rr, m0 = b * 2048;
    LAS float* buf = (LAS float*)F.lds;
    volatile LAS unsigned* cnt = F.MISC + 16; unsigned gen = 0u;
    f32x4 S = (f32x4){0.f, 0.f, 0.f, 0.f};
    const int step_l = tid >> 4, part = tid & 15;
    f32x4 st[6];
#define RW_GLOAD(c) do { const size_t off_ = (size_t)(m0 + (c) * 16 + step_l) * 1024 + h * 64 + 4 * part; \
        st[0] = *(const f32x4*)(PR + 1 * PS + off_); st[1] = *(const f32x4*)(PR + 4 * PS + off_); st[2] = *(const f32x4*)(PR + 5 * PS + off_); \
        st[3] = *(const f32x4*)(PR + 2 * PS + off_); st[4] = *(const f32x4*)(PR + 0 * PS + off_); st[5] = *(const f32x4*)(PR + 3 * PS + off_); } while (0)
#define RW_LSTORE(bi) do { LAS float* d_ = buf + (bi) * 6144 + step_l * 384 + 4 * part; _Pragma("unroll") for (int q = 0; q < 6; ++q) *(LAS f32x4*)(d_ + q * 64) = st[q]; } while (0)
    RW_GLOAD(0); RW_LSTORE(0); grp_bar(cnt, gen, lane);
    for (int c = 0; c < 128; ++c) {
        const int cur = c & 1;
        if (c + 1 < 128) RW_GLOAD(c + 1);
        const LAS float* cb = buf + cur * 6144;
        float yk = 0.f;
#pragma unroll
        for (int s = 0; s < 16; ++s) {
            const LAS float* sb = cb + s * 384;
            const f32x4 w4 = *(const LAS f32x4*)(sb + 4 * kq), kk4 = *(const LAS f32x4*)(sb + 64 + 4 * kq), b4 = *(const LAS f32x4*)(sb + 128 + 4 * kq),
                        k4 = *(const LAS f32x4*)(sb + 192 + 4 * kq), r4 = *(const LAS f32x4*)(sb + 256 + 4 * kq);
            const float vv = sb[320 + v];
            float sa = -((S[0] * kk4[0] + S[1] * kk4[1]) + (S[2] * kk4[2] + S[3] * kk4[3]));
            sa = sum16(sa);
            S = S * w4 + (b4 * sa + k4 * vv);
            float y = (S[0] * r4[0] + S[1] * r4[1]) + (S[2] * r4[2] + S[3] * r4[3]);
            y = sum16(y);
            yk = (kq == s) ? y : yk;
        }
        YR[(size_t)(m0 + 16 * c + kq) * 1024 + h * 64 + v] = yk;
        if (c + 1 < 128) RW_LSTORE(cur ^ 1);
        grp_bar(cnt, gen, lane);
    }
#undef RW_GLOAD
#undef RW_LSTORE
    *(f32x4*)(F.out + O_WKV_P + (size_t)(b * 16 + h) * 4096 + v * 64 + 4 * kq) = S;
}
__device__ __forceinline__ void rwkv_sample_item(Frame& F, int b, int h) {
    const float* PR = (const float*)(F.ws + WS_PREP); constexpr size_t PS = PREP_STRIDE / 4;
    float* YR = (float*)(F.ws + WS_YR);
    const int lane = F.lane, rr = lane >> 4, kq = lane & 15, m0 = MP + 4 * b;
    const float* s_in = F.in[5] + (size_t)(b * 16 + h) * 4096; float* s_out = F.out + O_WKV_S + (size_t)(b * 16 + h) * 4096;
    f32x4 w4[4], kk4[4], b4[4], k4[4], r4[4];
#pragma unroll
    for (int t = 0; t < 4; ++t) { const size_t off = (size_t)(m0 + t) * 1024 + h * 64 + 4 * kq;
        w4[t] = *(const f32x4*)(PR + 1 * PS + off); kk4[t] = *(const f32x4*)(PR + 4 * PS + off); b4[t] = *(const f32x4*)(PR + 5 * PS + off);
        k4[t] = *(const f32x4*)(PR + 2 * PS + off); r4[t] = *(const f32x4*)(PR + 0 * PS + off); }
#pragma unroll 4
    for (int rg = 0; rg < 16; ++rg) { const int v = 4 * rg + rr;
        f32x4 S = *(const f32x4*)(s_in + v * 64 + 4 * kq);
        float vv[4];
#pragma unroll
        for (int t = 0; t < 4; ++t) vv[t] = PR[3 * PS + (size_t)(m0 + t) * 1024 + h * 64 + v];
        float yk = 0.f;
#pragma unroll
        for (int t = 0; t < 4; ++t) {
            float sa = -((S[0] * kk4[t][0] + S[1] * kk4[t][1]) + (S[2] * kk4[t][2] + S[3] * kk4[t][3]));
            sa = sum16(sa);
            S = S * w4[t] + (b4[t] * sa + k4[t] * vv[t]);
            float y = (S[0] * r4[t][0] + S[1] * r4[t][1]) + (S[2] * r4[t][2] + S[3] * r4[t][3]);
            y = sum16(y);
            yk = (kq == t) ? y : yk;
        }
        if (kq < 4) YR[(size_t)(m0 + kq) * 1024 + h * 64 + v] = yk;
        *(f32x4*)(s_out + v * 64 + 4 * kq) = S; }
}

template <int SEG> __device__ __forceinline__ void ssm_item(Frame& F, int g, int sel) {
    const float* H = (const float*)(F.ws + WS_H);
    bf16* YG = (bf16*)(F.ws + WS_YGB);
    const int lane = F.lane, n = lane & 31, hh = lane >> 5, fr = lane & 15, fq = lane >> 4;
    LAS bf16* ldsS = (LAS bf16*)(F.lds + 49152 + F.wave * 8704);
    const float dt = __expf(F.in[17][g]);
    float lr[2], li[2]; bf16x8 Bre[2], Bim[2];
#pragma unroll
    for (int pp = 0; pp < 2; ++pp) { const int p = 2 * n + pp; const float are = F.in[10][g * 64 + p], aim = F.in[11][g * 64 + p];
        const float mag = expf(are * dt), ang = aim * dt; float sn, cs; sincosf(ang, &sn, &cs); lr[pp] = mag * cs; li[pp] = mag * sn;
        const float sh = sinf(0.5f * ang); const float xr = expm1f(are * dt) * cs - 2.0f * sh * sh, xi = mag * sn;
        const float den = 1.0f / (are * are + aim * aim); const float qr = (xr * are + xi * aim) * den, qi = (xi * are - xr * aim) * den;
        const float* brp = F.in[12] + (size_t)(g * 64 + p) * 16 + 8 * hh; const float* bip = F.in[13] + (size_t)(g * 64 + p) * 16 + 8 * hh;
        const f32x4 br0 = *(const f32x4*)brp, br1 = *(const f32x4*)(brp + 4), bi0 = *(const f32x4*)bip, bi1 = *(const f32x4*)(bip + 4);
        Bre[pp] = pack_bf8(br0 * qr - bi0 * qi, br1 * qr - bi1 * qi); Bim[pp] = pack_bf8(bi0 * qr + br0 * qi, bi1 * qr + br1 * qi); }
    bf16x8 Cop[4];
#pragma unroll
    for (int kc = 0; kc < 4; ++kc) { const float* cp = (kc < 2 ? F.in[14] : F.in[15]) + (size_t)(g * 16 + fr) * 64 + 32 * (kc & 1) + 8 * fq; const float sg = kc < 2 ? 1.0f : -1.0f;
        Cop[kc] = pack_bf8(*(const f32x4*)cp * sg, *(const f32x4*)(cp + 4) * sg); }
    const f32x4 d4 = *(const f32x4*)(F.in[16] + 16 * g + 4 * fq);
    float sre[2] = {0.f, 0.f}, sim[2] = {0.f, 0.f};
    const int ntile = SEG == 16 ? 128 : 1;
    const int hr = (n >> 2) & 1, ir = 4 * (n >> 3) + (n & 3);
#define SSM_AROW(t_) (SEG == 16 ? (2 * sel + hr) * 2048 + (t_) * 16 + ir : MP + 4 * (8 * sel + 4 * hr + (ir >> 2)) + (ir & 3))
#define SSM_OROW(t_, rg_) (SEG == 16 ? (2 * sel + (rg_)) * 2048 + (t_) * 16 + fr : MP + 4 * (8 * sel + 4 * (rg_) + (fr >> 2)) + (fr & 3))
#define SSM_LOAD(t_, A0, A1_, U0, U1) do { const float* up_ = H + (size_t)SSM_AROW(t_) * DIN + 16 * g + 8 * hh; A0 = *(const f32x4*)up_; A1_ = *(const f32x4*)(up_ + 4); \
        U0 = *(const f32x4*)(H + (size_t)SSM_OROW(t_, 0) * DIN + 16 * g + 4 * fq); U1 = *(const f32x4*)(H + (size_t)SSM_OROW(t_, 1) * DIN + 16 * g + 4 * fq); } while (0)
    f32x4 pa0[2], pa1[2], pu0[2], pu1[2];
    SSM_LOAD(0, pa0[0], pa1[0], pu0[0], pu1[0]);
    if (ntile > 1) SSM_LOAD(1, pa0[1], pa1[1], pu0[1], pu1[1]); else { pa0[1] = pa0[0]; pa1[1] = pa1[0]; pu0[1] = pu0[0]; pu1[1] = pu1[0]; }
    for (int tile = 0; tile < ntile; ++tile) {
        const f32x4 ca0 = pa0[0], ca1 = pa1[0]; const f32x4 cu[2] = {pu0[0], pu1[0]};
        pa0[0] = pa0[1]; pa1[0] = pa1[1]; pu0[0] = pu0[1]; pu1[0] = pu1[1];
        if (tile + 2 < ntile) SSM_LOAD(tile + 2, pa0[1], pa1[1], pu0[1], pu1[1]);
        const bf16x8 A1 = pack_bf8(ca0, ca1);
        const f32x16 z16 = {0.f, 0.f, 0.f, 0.f, 0.f, 0.f, 0.f, 0.f, 0.f, 0.f, 0.f, 0.f, 0.f, 0.f, 0.f, 0.f};
        f32x16 aRe[2], aIm[2];
#pragma unroll
        for (int pp = 0; pp < 2; ++pp) { aRe[pp] = MFMA32(A1, Bre[pp], z16); aIm[pp] = MFMA32(A1, Bim[pp], z16); }
#pragma unroll
        for (int i = 0; i < 16; ++i) {
            if (SEG == 4 && (i & 3) == 0) { const int batch = 8 * sel + 4 * hh + (i >> 2); const size_t so = (size_t)(batch * 64 + g) * 64 + 2 * n;
                const f32x2 a = *(const f32x2*)(F.in[3] + so), b = *(const f32x2*)(F.in[4] + so); sre[0] = a[0]; sre[1] = a[1]; sim[0] = b[0]; sim[1] = b[1]; }
#pragma unroll
            for (int pp = 0; pp < 2; ++pp) { const float nr = lr[pp] * sre[pp] - li[pp] * sim[pp] + aRe[pp][i], ni = lr[pp] * sim[pp] + li[pp] * sre[pp] + aIm[pp][i]; sre[pp] = nr; sim[pp] = ni; }
            *(LAS unsigned*)(ldsS + (16 * hh + i) * 136 + 2 * n) = pk2(sre[0], sre[1]);
            *(LAS unsigned*)(ldsS + (16 * hh + i) * 136 + 64 + 2 * n) = pk2(sim[0], sim[1]);
            if (SEG == 4 && (i & 3) == 3) { const int batch = 8 * sel + 4 * hh + (i >> 2); const size_t so = (size_t)(batch * 64 + g) * 64 + 2 * n;
                *(f32x2*)(F.out + O_SRE_S + so) = (f32x2){sre[0], sre[1]}; *(f32x2*)(F.out + O_SIM_S + so) = (f32x2){sim[0], sim[1]}; }
        }
        LDS_WAIT(); asm volatile("" ::: "memory");
#pragma unroll
        for (int rg = 0; rg < 2; ++rg) {
            f32x4 aY = (f32x4){0.f, 0.f, 0.f, 0.f};
#pragma unroll
            for (int kc = 0; kc < 4; ++kc) aY = MFMA16(Cop[kc], *(const LAS bf16x8*)(ldsS + (16 * rg + fr) * 136 + 32 * kc + 8 * fq), aY);
            const int orow = SSM_OROW(tile, rg);
            const f32x4 u4 = cu[rg];
            const f32x4 y = aY + d4 * u4;
            v2u w; w.x = pk2(gelu_tanh(y[0]), gelu_tanh(y[1])); w.y = pk2(gelu_tanh(y[2]), gelu_tanh(y[3]));
            *(v2u*)(YG + (size_t)orow * 1024 + 16 * g + 4 * fq) = w;
        }
        LDS_WAIT(); asm volatile("" ::: "memory");
    }
    if (SEG == 16) { const size_t so = (size_t)((2 * sel + hh) * 64 + g) * 64 + 2 * n;
        *(f32x2*)(F.out + O_SRE_P + so) = (f32x2){sre[0], sre[1]}; *(f32x2*)(F.out + O_SIM_P + so) = (f32x2){sim[0], sim[1]}; }
}

__device__ __forceinline__ void p3_scans(Frame& F, int rep) {
    unsigned* ctr = (unsigned*)(F.ws + WS_CTL) + 128 * rep;
    constexpr int N_SP = 128, N_RS = 2048, N_SS = 1024, TOTAL = N_SP + N_RS + N_SS;
    if (F.tid == 0) F.MISC[16] = 0u;
    __syncthreads();
    if (F.wave < 4) { for (int it = F.bid; it < 256; it += F.G) rwkv_scan_prompt(F, it >> 6, (it >> 2) & 15, it & 3); }
    for (;;) {
        unsigned itu = 0u;
        if (F.lane == 0) itu = atomicAdd(ctr, 1u);
        int it = (int)__builtin_amdgcn_readfirstlane(itu);
        if (it >= TOTAL) break;
        if (it < N_SP) { ssm_item<16>(F, it >> 1, it & 1); continue; }
        it -= N_SP;
        if (it < N_RS) { rwkv_sample_item(F, it >> 4, it & 15); continue; }
        it -= N_RS;
        ssm_item<4>(F, it >> 4, it & 15);
    }
}

__device__ __forceinline__ void p4_post(Frame& F, int rep) {
    unsigned* ctr = (unsigned*)(F.ws + WS_CTL) + 64 + 128 * rep;
    const float* PR = (const float*)(F.ws + WS_PREP); constexpr size_t PS = PREP_STRIDE / 4;
    const float* YR = (const float*)(F.ws + WS_YR); const float* BON = (const float*)(F.ws + WS_BONUS);
    const float* lg = F.in[29]; const float* lb = F.in[30];
    bf16* MIX = (bf16*)(F.ws + WS_MIX);
    const int lane = F.lane;
    for (;;) {
        __syncthreads();
        if (F.tid == 0) F.MISC[0] = atomicAdd(ctr, 1u);
        __syncthreads();
        const int it = (int)F.MISC[0];
        if (it >= MT / 16) break;
#pragma unroll 1
        for (int q = 0; q < 2; ++q) { const int m = it * 16 + 2 * F.wave + q;
#pragma unroll
            for (int j = 0; j < 4; ++j) { const int col = 256 * j + 4 * lane, hd = 4 * j + (lane >> 4); const size_t o = (size_t)m * 1024 + col;
                const f32x4 y = *(const f32x4*)(YR + o);
                const float mean = sum16((y[0] + y[1]) + (y[2] + y[3])) * (1.0f / 64.0f);
                const f32x4 d = y - mean;
                const float var = sum16((d[0] * d[0] + d[1] * d[1]) + (d[2] * d[2] + d[3] * d[3])) * (1.0f / 64.0f);
                const float rstd = rsqrtf(var + GN_EPS), bon = BON[(size_t)m * 16 + hd];
                const f32x4 v4 = *(const f32x4*)(PR + 3 * PS + o), g4 = *(const f32x4*)(PR + 6 * PS + o), lg4 = *(const f32x4*)(lg + col), lb4 = *(const f32x4*)(lb + col);
                const f32x4 ov = (d * rstd * lg4 + lb4 + v4 * bon) * g4;
                v2u w; w.x = pk2(ov[0], ov[1]); w.y = pk2(ov[2], ov[3]);
                *(v2u*)(MIX + (size_t)m * 2048 + 1024 + col) = w; } }
    }
}

__device__ __forceinline__ void ln_rows(Frame& F, const float* src, const float* gam, const float* bet, float* dstf, bf16* dstb, const float* sbase, const float* part, int nsplit) {
    const int gw = F.bid * NWAVES + F.wave, NGW = F.G * NWAVES, lane = F.lane;
    f32x4 gg[8], bb[8];
#pragma unroll
    for (int j = 0; j < 8; ++j) { gg[j] = *(const f32x4*)(gam + 4 * (lane + 64 * j)); bb[j] = *(const f32x4*)(bet + 4 * (lane + 64 * j)); }
    for (int row = gw; row < MT; row += NGW) {
        const f32x4* s = (const f32x4*)(src + (size_t)row * DM) + lane; f32x4 v[8]; float sm = 0.f;
#pragma unroll
        for (int j = 0; j < 8; ++j) v[j] = s[64 * j];
        if (row >= MP) { const f32x4* sb = (const f32x4*)(sbase + (size_t)(row - MP) * DM) + lane;
#pragma unroll
            for (int j = 0; j < 8; ++j) v[j] = sb[64 * j] * ALPHA;
            for (int ks = 0; ks < nsplit; ++ks) { const f32x4* pp = (const f32x4*)(part + ((size_t)ks * 512 + (row - MP)) * DM) + lane;
#pragma unroll
                for (int j = 0; j < 8; ++j) v[j] += pp[64 * j]; } }
#pragma unroll
        for (int j = 0; j < 8; ++j) sm += (v[j][0] + v[j][1]) + (v[j][2] + v[j][3]);
        const float mean = wave_sum(sm) * (1.0f / DM); float s2 = 0.f;
#pragma unroll
        for (int j = 0; j < 8; ++j) { v[j] = v[j] - mean; s2 += (v[j][0] * v[j][0] + v[j][1] * v[j][1]) + (v[j][2] * v[j][2] + v[j][3] * v[j][3]); }
        const float rstd = rsqrtf(wave_sum(s2) * (1.0f / DM) + LN_EPS);
#pragma unroll
        for (int j = 0; j < 8; ++j) { const f32x4 o = v[j] * rstd * gg[j] + bb[j];
            if (dstf) *((f32x4*)(dstf + (size_t)row * DM) + lane + 64 * j) = o;
            if (dstb) { v2u w; w.x = pk2(o[0], o[1]); w.y = pk2(o[2], o[3]); *((v2u*)(dstb + (size_t)row * DM) + lane + 64 * j) = w; } }
    }
}

__device__ __forceinline__ void attn_prompt_unit(Frame& F, int b, int h, int qt) {
    const bf16* Qb = (const bf16*)(F.ws + WS_QB); const bf16* Kb = (const bf16*)(F.ws + WS_KB); const bf16* VT = (const bf16*)(F.ws + WS_VTB);
    bf16* Ob = (bf16*)(F.ws + WS_OB);
    const int lane = F.lane, fr = lane & 15, fq = lane >> 4, tid = F.tid;
    const int m = b * 2048 + qt * 128 + 16 * F.wave + fr;
    constexpr int BUFB = 33792;
    v4u stg[4];
#define AT_GLOAD(ch) do { _Pragma("unroll") for (int i_ = 0; i_ < 4; ++i_) { const int seg_ = i_ * 512 + tid; \
        if ((ch) < 8) { const int r_ = seg_ >> 6, sg_ = seg_ & 63; stg[i_] = *(const v4u*)(Kb + (size_t)(b * NMEM + 32 * (ch) + r_) * DM + h * 512 + sg_ * 8); } \
        else { const int r_ = seg_ >> 5, sg_ = seg_ & 31; stg[i_] = *(const v4u*)(VT + (size_t)(h * 512 + 64 * ((ch) - 8) + r_) * 1024 + b * NMEM + sg_ * 8); } } } while (0)
#define AT_LSTORE(ch) do { LAS unsigned char* d_ = F.lds + ((ch) & 1) * BUFB; _Pragma("unroll") for (int i_ = 0; i_ < 4; ++i_) { const int seg_ = i_ * 512 + tid; \
        if ((ch) < 8) { const int r_ = seg_ >> 6, sg_ = seg_ & 63; *(LAS v4u*)(d_ + r_ * 1040 + sg_ * 16) = stg[i_]; } \
        else { const int r_ = seg_ >> 5, sg_ = seg_ & 31; *(LAS v4u*)(d_ + r_ * 528 + sg_ * 16) = stg[i_]; } } } while (0)
    AT_GLOAD(0);
    bf16x8 Qf[16];
#pragma unroll
    for (int kc = 0; kc < 16; ++kc) Qf[kc] = *(const bf16x8*)(Qb + (size_t)m * DM + h * 512 + 32 * kc + 8 * fq);
    AT_LSTORE(0); __syncthreads();
    f32x4 s[8][2]; bf16x8 Pf[8];
#pragma unroll
    for (int ch = 0; ch < 16; ++ch) {
        if (ch + 1 < 16) AT_GLOAD(ch + 1);
        const LAS unsigned char* cb = F.lds + (ch & 1) * BUFB;
        if (ch < 8) {
#pragma unroll
            for (int sb = 0; sb < 2; ++sb) { const LAS unsigned char* krow = cb + (8 * (fr >> 2) + 4 * sb + (fr & 3)) * 1040 + 16 * fq; f32x4 acc = (f32x4){0.f, 0.f, 0.f, 0.f};
#pragma unroll
                for (int kc = 0; kc < 16; ++kc) acc = MFMA16(*(const LAS bf16x8*)(krow + 64 * kc), Qf[kc], acc);
                s[ch & 7][sb] = acc; }
            if (ch == 7) {
                float mx = -3.0e38f;
#pragma unroll
                for (int c = 0; c < 8; ++c)
#pragma unroll
                    for (int sb = 0; sb < 2; ++sb)
#pragma unroll
                        for (int j = 0; j < 4; ++j) mx = fmaxf(mx, s[c][sb][j]);
                mx = fmaxf(mx, __shfl_xor(mx, 16)); mx = fmaxf(mx, __shfl_xor(mx, 32));
                const float sc2 = 0.044194173824159216f * 1.4426950408889634f;
                float sum = 0.f;
#pragma unroll
                for (int c = 0; c < 8; ++c)
#pragma unroll
                    for (int sb = 0; sb < 2; ++sb)
#pragma unroll
                        for (int j = 0; j < 4; ++j) { const float p = exp2f((s[c][sb][j] - mx) * sc2); s[c][sb][j] = p; sum += p; }
                sum += __shfl_xor(sum, 16); sum += __shfl_xor(sum, 32);
                const float inv = 1.0f / sum;
#pragma unroll
                for (int c = 0; c < 8; ++c) Pf[c] = pack_bf8(s[c][0] * inv, s[c][1] * inv);
            }
        } else {
#pragma unroll
            for (int dl = 0; dl < 4; ++dl) { const LAS unsigned char* vrow = cb + (16 * dl + fr) * 528 + 16 * fq; f32x4 acc = (f32x4){0.f, 0.f, 0.f, 0.f};
#pragma unroll
                for (int c = 0; c < 8; ++c) acc = MFMA16(*(const LAS bf16x8*)(vrow + 64 * c), Pf[c], acc);
                v2u w; w.x = pk2(acc[0], acc[1]); w.y = pk2(acc[2], acc[3]);
                *(v2u*)(Ob + (size_t)m * DM + h * 512 + 64 * (ch - 8) + 16 * dl + 4 * fq) = w; }
        }
        if (ch + 1 < 16) AT_LSTORE(ch + 1);
        __syncthreads();
    }
#undef AT_GLOAD
#undef AT_LSTORE
}
__device__ __forceinline__ void attn_sample_unit(Frame& F, int b, int h) {
    bf16* Ob = (bf16*)(F.ws + WS_OB);
    const float* CK = F.in[7]; const float* CV = F.in[8];
    const int lane = F.lane, fr = lane & 15, fq = lane >> 4, w = F.wave, tid = F.tid;
    LAS float* Pw = (LAS float*)F.lds + w * 128;
    LAS float* ML = (LAS float*)(F.lds + 4096);
    LAS float* red = (LAS float*)(F.lds + 8192);
    LAS bf16* qs = (LAS bf16*)(F.lds + 73728);
    { const float* PART = (const float*)(F.ws + WS_PART); const int q = tid >> 7, d4 = (tid & 127) * 4; f32x4 o = (f32x4){0.f, 0.f, 0.f, 0.f};
#pragma unroll 4
      for (int ks = 0; ks < 16; ++ks) o += *(const f32x4*)(PART + ((size_t)ks * 512 + 4 * b + q) * DM + h * 512 + d4);
      v2u pw; pw.x = pk2(o[0], o[1]); pw.y = pk2(o[2], o[3]); *(LAS v2u*)(qs + q * 512 + d4) = pw; }
    __syncthreads();
    bf16x8 Qf[16];
#pragma unroll
    for (int kc = 0; kc < 16; ++kc) { const bf16x8 z = {0, 0, 0, 0, 0, 0, 0, 0};
        Qf[kc] = fr < 4 ? *(const LAS bf16x8*)(qs + fr * 512 + 32 * kc + 8 * fq) : z; }
    f32x4 sc[2];
#pragma unroll
    for (int tl = 0; tl < 2; ++tl) { const int mem = 32 * w + 16 * tl + fr; const float* krow = CK + (size_t)(b * NMEM + mem) * DM + h * 512 + 8 * fq; f32x4 acc = (f32x4){0.f, 0.f, 0.f, 0.f};
#pragma unroll
        for (int kc = 0; kc < 16; ++kc) acc = MFMA16(pack_bf8(*(const f32x4*)(krow + 32 * kc), *(const f32x4*)(krow + 32 * kc + 4)), Qf[kc], acc);
        sc[tl] = acc * 0.044194173824159216f; }
    float mx = fmaxf(fmaxf(fmaxf(sc[0][0], sc[0][1]), fmaxf(sc[0][2], sc[0][3])), fmaxf(fmaxf(sc[1][0], sc[1][1]), fmaxf(sc[1][2], sc[1][3])));
    mx = fmaxf(mx, __shfl_xor(mx, 16)); mx = fmaxf(mx, __shfl_xor(mx, 32));
    float ls = 0.f;
#pragma unroll
    for (int tl = 0; tl < 2; ++tl)
#pragma unroll
        for (int j = 0; j < 4; ++j) { const float p = __expf(sc[tl][j] - mx); sc[tl][j] = p; ls += p; }
    ls += __shfl_xor(ls, 16); ls += __shfl_xor(ls, 32);
    if (fr < 4) {
#pragma unroll
        for (int tl = 0; tl < 2; ++tl)
#pragma unroll
            for (int j = 0; j < 4; ++j) Pw[(16 * tl + 4 * fq + j) * 4 + fr] = sc[tl][j];
        if (fq == 0) { ML[(w * 4 + fr) * 2] = mx; ML[(w * 4 + fr) * 2 + 1] = ls; } }
    LDS_WAIT(); asm volatile("" ::: "memory");
    f32x4 a0[4], a1[4];
#pragma unroll
    for (int q = 0; q < 4; ++q) { a0[q] = (f32x4){0.f, 0.f, 0.f, 0.f}; a1[q] = a0[q]; }
#pragma unroll 8
    for (int i = 0; i < 32; ++i) { const int mem = 32 * w + i; const float* vrow = CV + (size_t)(b * NMEM + mem) * DM + h * 512;
        const f32x4 v0 = *(const f32x4*)(vrow + 4 * lane), v1 = *(const f32x4*)(vrow + 256 + 4 * lane); const f32x4 p4 = *(const LAS f32x4*)(Pw + i * 4);
#pragma unroll
        for (int q = 0; q < 4; ++q) { a0[q] += v0 * p4[q]; a1[q] += v1 * p4[q]; } }
#pragma unroll
    for (int q = 0; q < 4; ++q) { *(LAS f32x4*)(red + (w * 4 + q) * 512 + 4 * lane) = a0[q]; *(LAS f32x4*)(red + (w * 4 + q) * 512 + 256 + 4 * lane) = a1[q]; }
    __syncthreads();
    { const int q = tid >> 7, d4 = (tid & 127) * 4; float M = -3.0e38f;
#pragma unroll
      for (int ww = 0; ww < 8; ++ww) M = fmaxf(M, ML[(ww * 4 + q) * 2]);
      float L = 0.f; f32x4 o = (f32x4){0.f, 0.f, 0.f, 0.f};
#pragma unroll
      for (int ww = 0; ww < 8; ++ww) { const float e = __expf(ML[(ww * 4 + q) * 2] - M); L += ML[(ww * 4 + q) * 2 + 1] * e; o += *(const LAS f32x4*)(red + (ww * 4 + q) * 512 + d4) * e; }
      const float inv = 1.0f / L; o = o * inv;
      v2u pw; pw.x = pk2(o[0], o[1]); pw.y = pk2(o[2], o[3]);
      *(v2u*)(Ob + (size_t)(MP + 4 * b + q) * DM + h * 512 + d4) = pw; }
    __syncthreads();
}
__device__ __forceinline__ void p8_attn(Frame& F) {
#ifndef MK_ATT_SKIP
#define MK_ATT_SKIP 0
#endif
    for (int rp = 0; rp < (MK_REP == 80 ? 2 : 1); ++rp) for (int u = F.bid; u < 512; u += F.G) attn_sample_unit(F, u >> 2, u & 3);
    for (int rp = 0; rp < (MK_REP == 81 ? 2 : 1); ++rp) for (int u = F.bid; u < 256; u += F.G) attn_prompt_unit(F, u >> 6, (u >> 4) & 3, u & 15);
}

#define XB_TMO      128
#define XB_XCNT(j)  (256  + 64 * (j))
#define XB_XSUB(j)  (1280 + 64 * (j))
#define XB_XGEN(j)  (2304 + 64 * (j))
#define XB_TOP      3328
#define XB_TOPGEN   3392
#define XCD_BAR_WORDS 3456
#define XB_SPIN_CAP (1u << 18)

__device__ __forceinline__ unsigned xb_ld(unsigned* p)              { return __hip_atomic_load(p, __ATOMIC_RELAXED, __HIP_MEMORY_SCOPE_AGENT); }
__device__ __forceinline__ unsigned xb_add(unsigned* p, unsigned v) { return __hip_atomic_fetch_add(p, v, __ATOMIC_RELAXED, __HIP_MEMORY_SCOPE_AGENT); }
__device__ __forceinline__ unsigned xb_xcc_id() { return (unsigned)__builtin_amdgcn_s_getreg((3 << 11) | 20) & 0xFu; }
#define XB_SPIN(cond, bar) do { unsigned _sp = 0; while (cond) { __builtin_amdgcn_s_sleep(1); \
    if ((++_sp & 255u) == 0u) { if (xb_ld(&(bar)[XB_TMO])) break; if (_sp > XB_SPIN_CAP) { atomicAdd(&(bar)[XB_TMO], 1u); break; } } } } while (0)

struct XcdBarrier {
    unsigned* bar; unsigned x;
    volatile LAS unsigned* st;
};

__device__ __forceinline__ XcdBarrier xcd_barrier_post(unsigned* bar, volatile LAS unsigned* st) {
    XcdBarrier b; b.bar = bar; b.x = xb_xcc_id(); b.st = st;
    if (threadIdx.x == 0) (void)xb_add(&bar[XB_XCNT(b.x)], 1u);
    return b;
}
__device__ __forceinline__ void xcd_barrier_complete(unsigned* bar, unsigned x, unsigned& nloc, unsigned& nx) {
    const unsigned G = gridDim.x * gridDim.y * gridDim.z;
    unsigned sum, cnt, mine, sp = 0u;
    for (;;) {
        sum = 0u; cnt = 0u; mine = 0u;
#pragma unroll
        for (unsigned j = 0; j < 16; ++j) { const unsigned c = xb_ld(&bar[XB_XCNT(j)]); sum += c; cnt += (c > 0u) ? 1u : 0u; mine = (j == x) ? c : mine; }
        if (sum == G) break;
        __builtin_amdgcn_s_sleep(1);
        if ((++sp & 255u) == 0u) { if (xb_ld(&bar[XB_TMO])) break; if (sp > XB_SPIN_CAP) { atomicAdd(&bar[XB_TMO], 1u); break; } }
    }
    nloc = mine > 0u ? mine : 1u; nx = cnt > 0u ? cnt : 1u;
}

__device__ __forceinline__ void xcd_barrier(const XcdBarrier& b) {
    asm volatile("s_waitcnt vmcnt(0)" ::: "memory");
    __syncthreads();
    if (threadIdx.x == 0) {
        unsigned* bar = b.bar;
        __builtin_amdgcn_s_waitcnt(0);
        unsigned nloc = b.st[0], nx = b.st[1];
        if (nloc == 0u) { xcd_barrier_complete(bar, b.x, nloc, nx); b.st[0] = nloc; b.st[1] = nx; }
        const unsigned old = xb_add(&bar[XB_XSUB(b.x)], 1u);
        const unsigned gen = old / nloc;
        if (old + 1u == (gen + 1u) * nloc) {
            __builtin_amdgcn_fence(__ATOMIC_RELEASE, "agent");
            asm volatile("s_waitcnt vmcnt(0)" ::: "memory");
            const unsigned og = xb_add(&bar[XB_TOP], 1u);
            const unsigned tg = og / nx;
            if (og + 1u == (tg + 1u) * nx) xb_add(&bar[XB_TOPGEN], 1u);
            else XB_SPIN(xb_ld(&bar[XB_TOPGEN]) == tg, bar);
            __builtin_amdgcn_fence(__ATOMIC_ACQUIRE, "agent");
            xb_add(&bar[XB_XGEN(b.x)], 1u);
            asm volatile("s_waitcnt vmcnt(0)" ::: "memory");
        } else {
            XB_SPIN(xb_ld(&bar[XB_XGEN(b.x)]) == gen, bar);
            __builtin_amdgcn_fence(__ATOMIC_ACQUIRE, "agent");
            asm volatile("s_waitcnt vmcnt(0)" ::: "memory");
        }
    }
    __syncthreads();
}

template <bool COOP>
__global__ void __launch_bounds__(NTHR, 2) mk_fwd(Args args) {
    extern __shared__ __attribute__((aligned(16))) unsigned char lds_raw[];
    Frame F;
    F.lds = (LAS unsigned char*)lds_raw; F.MISC = (volatile LAS unsigned*)(F.lds + MISC_OFF);
    F.tid = threadIdx.x; F.lane = F.tid & 63; F.wave = __builtin_amdgcn_readfirstlane(F.tid >> 6); F.G = gridDim.x; F.bid = blockIdx.x;
    F.in = args.in; F.out = args.out; F.ws = args.ws;
    unsigned char* ws = args.ws;
    const int lo = args.lo, hi = args.hi, bid = F.bid, G = F.G;
#define IN(k) (lo <= (k) && (k) < hi)
    XcdBarrier bar; bar.bar = (unsigned*)(ws + WS_CTL) + 4096; bar.x = 0; bar.st = nullptr;
    if (COOP) { if (F.tid < 2) F.MISC[8 + F.tid] = 0u; __syncthreads(); bar = xcd_barrier_post((unsigned*)(ws + WS_CTL) + 4096, F.MISC + 8); }
#define SEAM(k) do { if (COOP) { if (IN(k) && IN((k) + 1)) { if ((k) == 0) cg::this_grid().sync(); else xcd_barrier(bar); } } } while (0)
    using pg8::Gemm; using pg8::StaticOrder; using pg8::gemm_phase;
    bf16* XB = (bf16*)(ws + WS_XB); float* Hh = (float*)(ws + WS_H); float* R = (float*)(ws + WS_R); float* X = (float*)(ws + WS_X); float* PART = (float*)(ws + WS_PART);

    if (IN(0)) for (int rep = 0; rep < (MK_REP == 0 ? 2 : 1); ++rep) { if (rep) xcd_barrier(bar); p0_prologue(F); } SEAM(0);
    if (IN(1)) for (int rep = 0; rep < (MK_REP == 1 ? 2 : 1); ++rep) { if (rep) xcd_barrier(bar);
        { Gemm g{XB, (const bf16*)(ws + WS_WIN), MT, DIN, DM}; StaticOrder S; S.init(MT, DIN, G, bid, DM); pg8::EpiF32 E{Hh, DIN};
          gemm_phase<pg8::EpiF32, StaticOrder, true, true>(F.lds, g, S, E); }
        { Gemm g{(const bf16*)(ws + WS_MB), (const bf16*)(ws + WS_WKV), 1024, 4096, DM}; StaticOrder S; S.init(1024, 4096, G, (bid + G - 66) % G, DM);
          pg8::EpiMemKV E{F.out + O_MK, F.out + O_MV, (bf16*)(ws + WS_KB)};
          gemm_phase<pg8::EpiMemKV, StaticOrder, true, true>(F.lds, g, S, E); }
        { Gemm g{(const bf16*)(ws + WS_WKV) + (size_t)2048 * DM, (const bf16*)(ws + WS_MB), 2048, 1024, DM}; StaticOrder S; S.init(2048, 1024, G, (bid + G - 130) % G, DM);
          pg8::EpiBf16S E{(bf16*)(ws + WS_VTB), 1024, nullptr};
          gemm_phase<pg8::EpiBf16S, StaticOrder, true, true>(F.lds, g, S, E); }
    } SEAM(1);
    if (IN(2)) for (int rep = 0; rep < (MK_REP == 2 ? 2 : 1); ++rep) { if (rep) xcd_barrier(bar); p2_prep(F); } SEAM(2);
    if (IN(3)) for (int rep = 0; rep < (MK_REP == 3 ? 2 : 1); ++rep) { if (rep) xcd_barrier(bar); p3_scans(F, rep); } SEAM(3);
    if (IN(4)) for (int rep = 0; rep < (MK_REP == 4 ? 2 : 1); ++rep) { if (rep) xcd_barrier(bar);
        { Gemm g{(const bf16*)(ws + WS_YGB), (const bf16*)(ws + WS_WGLU), MT, DSSM, DSSM}; StaticOrder S; S.init(MT, DSSM, G, bid, DSSM);
          pg8::EpiGlu E{(const bf16*)(ws + WS_YGB), 1024, F.in[19], (bf16*)(ws + WS_MIX), 2048};
          gemm_phase<pg8::EpiGlu, StaticOrder, true, true>(F.lds, g, S, E); }
        p4_post(F, rep);
    } SEAM(4);
    if (IN(5)) for (int rep = 0; rep < (MK_REP == 5 ? 2 : 1); ++rep) { if (rep) xcd_barrier(bar); Gemm g{(const bf16*)(ws + WS_MIX), (const bf16*)(ws + WS_WOUT), MT, DM, DM}; pg8::MixOrder S; S.init(MP, DM, G, bid, DM, 16, 128);
        pg8::EpiRes E{F.in[0], F.in[1], R, DM, ALPHA, PART};
        gemm_phase<pg8::EpiRes, pg8::MixOrder, true, true>(F.lds, g, S, E); } SEAM(5);
    if (IN(6)) for (int rep = 0; rep < (MK_REP == 6 ? 2 : 1); ++rep) { if (rep) xcd_barrier(bar); ln_rows(F, R, F.in[32], F.in[33], X, XB, F.in[1], PART, 16); } SEAM(6);
    if (IN(7)) for (int rep = 0; rep < (MK_REP == 7 ? 2 : 1); ++rep) { if (rep) xcd_barrier(bar); Gemm g{XB, (const bf16*)(ws + WS_WQ), MT, DM, DM}; pg8::MixOrder S; S.init(MP, DM, G, bid, DM, 16, 128);
        pg8::EpiBf16S E{(bf16*)(ws + WS_QB), DM, PART};
        gemm_phase<pg8::EpiBf16S, pg8::MixOrder, true, true>(F.lds, g, S, E); } SEAM(7);
    if (IN(8)) for (int rep = 0; rep < (MK_REP == 8 ? 2 : 1); ++rep) { if (rep) xcd_barrier(bar); p8_attn(F); } SEAM(8);
    if (IN(9)) for (int rep = 0; rep < (MK_REP == 9 ? 2 : 1); ++rep) { if (rep) xcd_barrier(bar); Gemm g{(const bf16*)(ws + WS_OB), (const bf16*)(ws + WS_WO), MT, DM, DM}; pg8::MixOrder S; S.init(MP, DM, G, bid, DM, 16, 128);
        pg8::EpiRes E{X, X + (size_t)MP * DM, R, DM, ALPHA, PART};
        gemm_phase<pg8::EpiRes, pg8::MixOrder, true, true>(F.lds, g, S, E); } SEAM(9);
    if (IN(10)) for (int rep = 0; rep < (MK_REP == 10 ? 2 : 1); ++rep) { if (rep) xcd_barrier(bar); ln_rows(F, R, F.in[38], F.in[39], X, XB, X + (size_t)MP * DM, PART, 16); } SEAM(10);
    if (IN(11)) for (int rep = 0; rep < (MK_REP == 11 ? 2 : 1); ++rep) { if (rep) xcd_barrier(bar); Gemm g{XB, (const bf16*)(ws + WS_WGU), MT, 2 * DFF, DM}; StaticOrder S; S.init(MT, 2 * DFF, G, bid, DM);
        pg8::EpiSwiGLU E{(bf16*)(ws + WS_HFF), DFF};
        gemm_phase<pg8::EpiSwiGLU, StaticOrder, true, true>(F.lds, g, S, E); } SEAM(11);
    if (IN(12)) for (int rep = 0; rep < (MK_REP == 12 ? 2 : 1); ++rep) { if (rep) xcd_barrier(bar); Gemm g{(const bf16*)(ws + WS_HFF), (const bf16*)(ws + WS_WDN), MT, DM, DFF}; pg8::MixOrder S; S.init(MP, DM, G, bid, DFF, 11, 512);
        pg8::EpiRes E{X, X + (size_t)MP * DM, R, DM, ALPHA, PART};
        gemm_phase<pg8::EpiRes, pg8::MixOrder, true, true>(F.lds, g, S, E); } SEAM(12);
    if (IN(13)) for (int rep = 0; rep < (MK_REP == 13 ? 2 : 1); ++rep) { if (rep) xcd_barrier(bar); ln_rows(F, R, F.in[43], F.in[44], F.out + O_Y, nullptr, X + (size_t)MP * DM, PART, 11); }
#undef IN
#undef SEAM
}

#ifndef MK_COOP
#define MK_COOP 0
#endif
#ifndef MK_PH_HI
#define MK_PH_HI NPHASE
#endif
extern "C" void kernel_launch(void* const* d_in, const int* in_sizes, int n_in, void* d_out, int out_size, void* d_ws, size_t ws_size, hipStream_t stream) {
    static int grid = 0;
    if (grid == 0) {
        if (n_in != 45 || out_size != (int)O_END || ws_size < WS_END) { fprintf(stderr, "kernel_launch: unexpected shapes (n_in %d out %d ws %zu)\n", n_in, out_size, ws_size); grid = -1; return; }
        int dev = 0, cus = 0, per_cu = 0;
        (void)hipGetDevice(&dev); (void)hipDeviceGetAttribute(&cus, hipDeviceAttributeMultiprocessorCount, dev);
        (void)hipFuncSetAttribute((const void*)mk_fwd<(MK_COOP != 0)>, hipFuncAttributeMaxDynamicSharedMemorySize, LDS_BYTES);
        (void)hipOccupancyMaxActiveBlocksPerMultiprocessor(&per_cu, (const void*)mk_fwd<(MK_COOP != 0)>, NTHR, LDS_BYTES);
        (void)hipGetLastError();
        if (per_cu < 1) { fprintf(stderr, "kernel_launch: occupancy query says %d blocks per CU\n", per_cu); per_cu = 1; }
        grid = cus;
    }
    if (grid < 0) return;
    (void)hipMemsetAsync((char*)d_ws + WS_CTL, 0, 65536, stream);
    if (MK_PH_HI < NPHASE) (void)hipMemsetAsync(d_out, 0, (size_t)out_size * 4, stream);
#ifdef MK_DUMP_OFF
#ifndef MK_DUMP_BYTES
#define MK_DUMP_BYTES ((size_t)MT * DM * 4)
#endif
#define MK_DUMP_AFTER (void)hipMemcpyAsync(d_out, (char*)d_ws + (MK_DUMP_OFF), MK_DUMP_BYTES, hipMemcpyDeviceToDevice, stream);
#else
#define MK_DUMP_AFTER
#endif
    Args a{};
    for (int i = 0; i < 45; ++i) a.in[i] = (const float*)d_in[i];
    a.out = (float*)d_out; a.ws = (unsigned char*)d_ws;
#if MK_COOP
    a.lo = 0; a.hi = MK_PH_HI;
    void* kargs[] = {&a};
    hipError_t e = hipLaunchCooperativeKernel((const void*)mk_fwd<true>, dim3(grid), dim3(NTHR), kargs, LDS_BYTES, stream);
    if (e != hipSuccess) fprintf(stderr, "cooperative launch failed: %s (grid %d)\n", hipGetErrorString(e), grid);
#else
    for (int p = 0; p < MK_PH_HI; ++p) { a.lo = p; a.hi = p + 1; hipLaunchKernelGGL(mk_fwd<false>, dim3(grid), dim3(NTHR), LDS_BYTES, stream, a); }
#endif
    MK_DUMP_AFTER
}
```

```cpp
#include <hip/hip_runtime.h>
#include <hip/hip_cooperative_groups.h>
#include <cstdio>
#include <cstdint>
namespace cg = cooperative_groups;
#define MK_COOP 1
namespace pg8 {
#define PG8_LAS __attribute__((address_space(3)))
typedef unsigned short bf16_t;
typedef short bf16x8 __attribute__((ext_vector_type(8)));
typedef float f32x4 __attribute__((ext_vector_type(4)));
typedef unsigned u32x4 __attribute__((ext_vector_type(4)));
constexpr int BM = 256, BK = 64, HALF = 128, HTB = HALF * BK * 2  , STAGE_BYTES = 8 * HTB, NXCD = 8, WGM = 8;

__host__ __device__ __forceinline__ int lds_byte(int r, int c) { const int st = (r >> 4) * 2 + (c >> 5), rr = r & 15, cc = c & 31, ob = rr * 64 + cc * 2; return st * 1024 + (ob ^ (((ob >> 9) & 1) << 5)); }
__host__ __device__ __forceinline__ void stage_rc(int b, int& R, int& C) { const int st = b / 1024, sb = b % 1024, swz = sb ^ (((sb >> 9) & 1) << 5); R = (st >> 1) * 16 + swz / 64; C = (st & 1) * 32 + (swz % 64) / 2; }
__host__ __device__ __forceinline__ int perm32(int rho) { const int n = rho >> 4, i = rho & 15; return 8 * (i >> 2) + 4 * n + (i & 3); }

struct Unit { int pm, pn, koff, nt, ks; };
struct Gemm { const bf16_t* A; const bf16_t* Bt; int M, N, K; };

struct StaticOrder {
    int nM, nN, nwg, G, c, ntk;
    __host__ __device__ void init(int M, int N, int G_, int c_, int K_) { nM = M / BM; nN = N / BM; nwg = nM * nN; G = G_; c = c_; ntk = K_ / BK; }
    __host__ __device__ bool next(int i, Unit& u) const {
        const long L = (long)i * G + c; if (L >= nwg) return false;
        int wgid = (int)L; { const int q = nwg / NXCD, r = nwg % NXCD, xcd = wgid % NXCD, off = wgid / NXCD; wgid = (xcd < r ? xcd * (q + 1) : r * (q + 1) + (xcd - r) * q) + off; }
        const int nig = WGM * nN, gid = wgid / nig, fm = gid * WGM, gsz = (nM - fm) < WGM ? (nM - fm) : WGM;
        u.pm = fm + ((wgid % nig) % gsz); u.pn = (wgid % nig) / gsz; u.koff = 0; u.nt = ntk; u.ks = -1; return true;
    }
    __device__ __forceinline__ void a_ready(const Unit&) const {}
    __device__ __forceinline__ void done(const Unit&) const {}
};
struct MixOrder {
    StaticOrder so; int c, nsplit, ksz, nN, pm0;
    __host__ __device__ void init(int M0, int N, int G_, int c_, int K_, int nsplit_, int ksz_) { so.init(M0, N, G_, c_, K_); c = c_; nsplit = nsplit_; ksz = ksz_; nN = N / BM; pm0 = M0 / BM; }
    __host__ __device__ bool next(int i, Unit& u) const {
        if (i == 0) return so.next(0, u);
        if (i == 1) { const int per = 2 * nN; if (c >= nsplit * per) return false; const int tile = c % per, ks = c / per;
            u.pm = pm0 + tile / nN; u.pn = tile % nN; u.koff = ks * ksz; u.nt = ksz / BK; u.ks = ks; return true; }
        return false;
    }
    __device__ __forceinline__ void a_ready(const Unit&) const {}
    __device__ __forceinline__ void done(const Unit&) const {}
};
typedef float f32x2_cv __attribute__((ext_vector_type(2))); typedef __bf16 bf16x2_cv __attribute__((ext_vector_type(2)));
__device__ __forceinline__ unsigned cvt_pk_bf16(float lo, float hi) { const f32x2_cv v = {lo, hi}; const bf16x2_cv b = __builtin_convertvector(v, bf16x2_cv); return __builtin_bit_cast(unsigned, b); }

__device__ __forceinline__ float bf_lo(unsigned w) { return __builtin_bit_cast(float, w << 16); }
__device__ __forceinline__ float bf_hi(unsigned w) { return __builtin_bit_cast(float, w & 0xffff0000u); }
__device__ __forceinline__ u32x4 pack8(const f32x4 a, const f32x4 b) { u32x4 w; w.x = cvt_pk_bf16(a[0], a[1]); w.y = cvt_pk_bf16(a[2], a[3]); w.z = cvt_pk_bf16(b[0], b[1]); w.w = cvt_pk_bf16(b[2], b[3]); return w; }
__device__ __forceinline__ float sigmoidf_(float x) { return 1.0f / (1.0f + __expf(-x)); }

struct EpiF32 {
    static constexpr bool PERM = true, AFTER_DRAIN = false;
    float* O; int ldc;
    __device__ __forceinline__ void operator()(const f32x4 (&acc)[2][2][4][2], const Unit& u, int wr, int wc, int fr, int fq) const {
        const int row0 = u.pm * BM + wr * 64 + fr, col0 = u.pn * BM + wc * 32 + 8 * fq;
#pragma unroll
        for (int ai = 0; ai < 2; ++ai)
#pragma unroll
            for (int m = 0; m < 4; ++m) { float* rowp = O + (size_t)(row0 + ai * HALF + m * 16) * ldc + col0;
#pragma unroll
                for (int bj = 0; bj < 2; ++bj) { *(f32x4*)(rowp + bj * HALF) = acc[ai][bj][m][0]; *(f32x4*)(rowp + bj * HALF + 4) = acc[ai][bj][m][1]; } }
    }
};
struct EpiMemKV {
    static constexpr bool PERM = true, AFTER_DRAIN = false;
    float* outK; float* outV; bf16_t* Kb;
    __device__ __forceinline__ void operator()(const f32x4 (&acc)[2][2][4][2], const Unit& u, int wr, int wc, int fr, int fq) const {
        const int row0 = u.pm * BM + wr * 64 + fr; const int colt = u.pn * BM; const bool isV = colt >= 2048;
        float* o = isV ? outV : outK; const int col0 = (isV ? colt - 2048 : colt) + wc * 32 + 8 * fq;
#pragma unroll
        for (int ai = 0; ai < 2; ++ai)
#pragma unroll
            for (int m = 0; m < 4; ++m)
#pragma unroll
                for (int bj = 0; bj < 2; ++bj) { const size_t off = (size_t)(row0 + ai * HALF + m * 16) * 2048 + col0 + bj * HALF;
                    *(f32x4*)(o + off) = acc[ai][bj][m][0]; *(f32x4*)(o + off + 4) = acc[ai][bj][m][1];
                    if (!isV) *(u32x4*)(Kb + off) = pack8(acc[ai][bj][m][0], acc[ai][bj][m][1]); }
    }
};
struct EpiBf16S {
    static constexpr bool PERM = true, AFTER_DRAIN = false;
    bf16_t* O; int ldc; float* part;
    __device__ __forceinline__ void operator()(const f32x4 (&acc)[2][2][4][2], const Unit& u, int wr, int wc, int fr, int fq) const {
        const int row0 = u.pm * BM + wr * 64 + fr, col0 = u.pn * BM + wc * 32 + 8 * fq;
        if (u.ks >= 0) {
#pragma unroll
            for (int ai = 0; ai < 2; ++ai)
#pragma unroll
                for (int m = 0; m < 4; ++m) { float* rowp = part + ((size_t)u.ks * 512 + (row0 + ai * HALF + m * 16 - 8192)) * ldc + col0;
#pragma unroll
                    for (int bj = 0; bj < 2; ++bj) { *(f32x4*)(rowp + bj * HALF) = acc[ai][bj][m][0]; *(f32x4*)(rowp + bj * HALF + 4) = acc[ai][bj][m][1]; } }
            return; }
#pragma unroll
        for (int ai = 0; ai < 2; ++ai)
#pragma unroll
            for (int m = 0; m < 4; ++m) { bf16_t* rowp = O + (size_t)(row0 + ai * HALF + m * 16) * ldc + col0;
#pragma unroll
                for (int bj = 0; bj < 2; ++bj) *(u32x4*)(rowp + bj * HALF) = pack8(acc[ai][bj][m][0], acc[ai][bj][m][1]); }
    }
};
struct EpiGlu {
    static constexpr bool PERM = true, AFTER_DRAIN = false;
    const bf16_t* Y; int ldy; const float* bias; bf16_t* O; int ldo;
    __device__ __forceinline__ void operator()(const f32x4 (&acc)[2][2][4][2], const Unit& u, int wr, int wc, int fr, int fq) const {
        const int row0 = u.pm * BM + wr * 64 + fr, col0 = u.pn * BM + wc * 32 + 8 * fq;
#pragma unroll
        for (int bj = 0; bj < 2; ++bj) { const f32x4 b0 = *(const f32x4*)(bias + col0 + bj * HALF), b1 = *(const f32x4*)(bias + col0 + bj * HALF + 4);
#pragma unroll
            for (int ai = 0; ai < 2; ++ai)
#pragma unroll
                for (int m = 0; m < 4; ++m) { const int row = row0 + ai * HALF + m * 16;
                    const u32x4 yv = *(const u32x4*)(Y + (size_t)row * ldy + col0 + bj * HALF);
                    const f32x4 a0 = acc[ai][bj][m][0] + b0, a1 = acc[ai][bj][m][1] + b1; f32x4 z0, z1;
                    z0[0] = bf_lo(yv.x) * sigmoidf_(a0[0]); z0[1] = bf_hi(yv.x) * sigmoidf_(a0[1]); z0[2] = bf_lo(yv.y) * sigmoidf_(a0[2]); z0[3] = bf_hi(yv.y) * sigmoidf_(a0[3]);
                    z1[0] = bf_lo(yv.z) * sigmoidf_(a1[0]); z1[1] = bf_hi(yv.z) * sigmoidf_(a1[1]); z1[2] = bf_lo(yv.w) * sigmoidf_(a1[2]); z1[3] = bf_hi(yv.w) * sigmoidf_(a1[3]);
                    *(u32x4*)(O + (size_t)row * ldo + col0 + bj * HALF) = pack8(z0, z1); } }
    }
};
struct EpiRes {
    static constexpr bool PERM = true, AFTER_DRAIN = false;
    const float* base0; const float* base1; float* O; int ld; float alpha; float* part;
    __device__ __forceinline__ void operator()(const f32x4 (&acc)[2][2][4][2], const Unit& u, int wr, int wc, int fr, int fq) const {
        const int row0 = u.pm * BM + wr * 64 + fr, col0 = u.pn * BM + wc * 32 + 8 * fq;
        if (u.ks >= 0) {
#pragma unroll
            for (int ai = 0; ai < 2; ++ai)
#pragma unroll
                for (int m = 0; m < 4; ++m) { float* rowp = part + ((size_t)u.ks * 512 + (row0 + ai * HALF + m * 16 - 8192)) * ld + col0;
#pragma unroll
                    for (int bj = 0; bj < 2; ++bj) { *(f32x4*)(rowp + bj * HALF) = acc[ai][bj][m][0]; *(f32x4*)(rowp + bj * HALF + 4) = acc[ai][bj][m][1]; } }
            return; }
        const bool lo = (u.pm * BM) < 8192; const float* bp = lo ? base0 : base1; const int rsub = lo ? 0 : 8192;
#pragma unroll
        for (int ai = 0; ai < 2; ++ai)
#pragma unroll
            for (int m = 0; m < 4; ++m) { const int row = row0 + ai * HALF + m * 16; const float* brow = bp + (size_t)(row - rsub) * ld + col0; float* orow = O + (size_t)row * ld + col0;
#pragma unroll
                for (int bj = 0; bj < 2; ++bj) { const f32x4 x0 = *(const f32x4*)(brow + bj * HALF), x1 = *(const f32x4*)(brow + bj * HALF + 4);
                    *(f32x4*)(orow + bj * HALF) = x0 * alpha + acc[ai][bj][m][0]; *(f32x4*)(orow + bj * HALF + 4) = x1 * alpha + acc[ai][bj][m][1]; } }
    }
};
struct EpiSwiGLU {
    static constexpr bool PERM = true, AFTER_DRAIN = false;
    bf16_t* O; int ldo;
    __device__ __forceinline__ void operator()(const f32x4 (&acc)[2][2][4][2], const Unit& u, int wr, int wc, int fr, int fq) const {
        const int row0 = u.pm * BM + wr * 64 + fr, col0 = u.pn * HALF + wc * 32 + 8 * fq;
#pragma unroll
        for (int ai = 0; ai < 2; ++ai)
#pragma unroll
            for (int m = 0; m < 4; ++m) { f32x4 h0, h1;
#pragma unroll
                for (int j = 0; j < 4; ++j) { const float g0 = acc[ai][0][m][0][j], g1 = acc[ai][0][m][1][j];
                    h0[j] = g0 * sigmoidf_(g0) * acc[ai][1][m][0][j]; h1[j] = g1 * sigmoidf_(g1) * acc[ai][1][m][1][j]; }
                *(u32x4*)(O + (size_t)(row0 + ai * HALF + m * 16) * ldo + col0) = pack8(h0, h1); }
    }
};

template <class Epi, class Sched, bool ALIGN_EPI = false, bool SP2 = false>
__device__ __forceinline__ void gemm_phase(PG8_LAS unsigned char* lds, const Gemm g, const Sched& S, const Epi& E) {
    const int tid = threadIdx.x, wid = __builtin_amdgcn_readfirstlane(tid >> 6), lane = tid & 63, wr = wid >> 2, wc = wid & 3, fr = lane & 15, fq = lane >> 4;
    const int K = g.K;
    unsigned voffA[2], voffB[2];
#pragma unroll
    for (int i = 0; i < 2; ++i) { int R, C; stage_rc(tid * 16 + i * 8192, R, C); const int Rb = Epi::PERM ? ((R & ~31) + perm32(R & 31)) : R;
        voffA[i] = (unsigned)(R * K + C) * 2u; voffB[i] = (unsigned)(Rb * K + C) * 2u; }
    const size_t kstep = (size_t)(BK * 2);
    const size_t hstep = (size_t)HALF * K * 2;
    const size_t tstep = 2 * hstep;
    const unsigned ldsw = (unsigned)wid * 1024u;
    const int aoff = lds_byte(wr * 64 + fr, fq * 8), boff = lds_byte(wc * 32 + fr, fq * 8);
#define PG8_SA(b, h) (((b) * 2 + (h)) * HTB)
#define PG8_SB(b, h) ((4 + (b) * 2 + (h)) * HTB)
#define PG8_STAGE(bufoff, gbase, voff) do { _Pragma("unroll") for (int _i = 0; _i < 2; ++_i) \
        __builtin_amdgcn_global_load_lds((const unsigned*)((const char*)(gbase) + (voff)[_i]), (PG8_LAS unsigned*)(lds + (bufoff) + ldsw + _i * 8192), 16, 0, 0); } while (0)
#define PG8_LDA(dst, b, h) do { _Pragma("unroll") for (int m = 0; m < 4; ++m) _Pragma("unroll") for (int k = 0; k < 2; ++k) dst[m][k] = *(const PG8_LAS bf16x8*)(lds + PG8_SA(b, h) + aoff + m * 2048 + k * 1024); } while (0)
#define PG8_LDB(dst, b, h) do { _Pragma("unroll") for (int n = 0; n < 2; ++n) _Pragma("unroll") for (int k = 0; k < 2; ++k) dst[n][k] = *(const PG8_LAS bf16x8*)(lds + PG8_SB(b, h) + boff + n * 2048 + k * 1024); } while (0)
#define PG8_MMA(ai, bj, At, Bt) do { __builtin_amdgcn_s_setprio(1); _Pragma("unroll") for (int m = 0; m < 4; ++m) _Pragma("unroll") for (int n = 0; n < 2; ++n) _Pragma("unroll") for (int k = 0; k < 2; ++k) \
        acc[ai][bj][m][n] = __builtin_amdgcn_mfma_f32_16x16x32_bf16(Bt[n][k], At[m][k], acc[ai][bj][m][n], 0, 0, 0); __builtin_amdgcn_s_setprio(0); } while (0)
#define PG8_WAIT_V(n) asm volatile("s_waitcnt vmcnt(" #n ")" ::: "memory")
#define PG8_WAIT_L(n) asm volatile("s_waitcnt lgkmcnt(" #n ")" ::: "memory")
#define PG8_BAR __builtin_amdgcn_s_barrier()
#define PG8_SCHED __builtin_amdgcn_sched_barrier(0)
    Unit cur, nxt; int ui = 0;
    if (!S.next(0, cur)) return;
    f32x4 acc[2][2][4][2];
#pragma unroll
    for (int a = 0; a < 2; ++a)
#pragma unroll
        for (int b = 0; b < 2; ++b)
#pragma unroll
            for (int m = 0; m < 4; ++m)
#pragma unroll
                for (int n = 0; n < 2; ++n) acc[a][b][m][n] = (f32x4){0.f, 0.f, 0.f, 0.f};
    bf16x8 At[4][2], B0[2][2], B1[2][2];
    const char* cA = (const char*)g.A + (size_t)cur.pm * tstep + (size_t)cur.koff * 2; const char* cB = (const char*)g.Bt + (size_t)cur.pn * tstep + (size_t)cur.koff * 2;
    S.a_ready(cur);
    if constexpr (SP2) {
        PG8_STAGE(PG8_SB(0, 0), cB, voffB); PG8_STAGE(PG8_SB(0, 1), cB + hstep, voffB); PG8_STAGE(PG8_SA(0, 0), cA, voffA); PG8_STAGE(PG8_SA(0, 1), cA + hstep, voffA);
        if (wr == 1) PG8_BAR;
        PG8_WAIT_V(2); PG8_BAR;
        PG8_STAGE(PG8_SB(1, 0), cB + kstep, voffB); PG8_STAGE(PG8_SA(1, 0), cA + kstep, voffA); PG8_STAGE(PG8_SB(1, 1), cB + hstep + kstep, voffB);
        PG8_WAIT_V(6); PG8_BAR;
    } else {
        PG8_STAGE(PG8_SB(0, 0), cB, voffB); PG8_STAGE(PG8_SA(0, 0), cA, voffA); PG8_STAGE(PG8_SB(0, 1), cB + hstep, voffB); PG8_STAGE(PG8_SA(0, 1), cA + hstep, voffA);
        if (wr == 1) PG8_BAR;
        PG8_WAIT_V(4); PG8_BAR;
        PG8_STAGE(PG8_SB(1, 0), cB + kstep, voffB); PG8_STAGE(PG8_SA(1, 0), cA + kstep, voffA); PG8_STAGE(PG8_SB(1, 1), cB + hstep + kstep, voffB);
        PG8_WAIT_V(6); PG8_BAR;
    }
    for (;;) {
        const bool has_next = S.next(ui + 1, nxt);
        const char* nA = has_next ? (const char*)g.A + (size_t)nxt.pm * tstep + (size_t)nxt.koff * 2 : cA; const char* nB = has_next ? (const char*)g.Bt + (size_t)nxt.pn * tstep + (size_t)nxt.koff * 2 : cB;
        const int nt = cur.nt;
        for (int t = 0; t < nt; t += 2) {
            const bool last = (t == nt - 2);
            const char* a1 = cA + (size_t)(t + 1) * kstep;
            const char* a2 = last ? nA : cA + (size_t)(t + 2) * kstep; const char* b2 = last ? nB : cB + (size_t)(t + 2) * kstep;
            const char* a3 = a2 + kstep; const char* b3 = b2 + kstep;
            if (last && has_next) S.a_ready(nxt);
            if constexpr (SP2) {
            PG8_LDB(B0, 0, 0); PG8_LDB(B1, 0, 1); PG8_SCHED; PG8_LDA(At, 0, 0); PG8_STAGE(PG8_SA(1, 1), a1 + hstep, voffA);
            PG8_WAIT_V(8); PG8_WAIT_L(0); PG8_BAR; PG8_MMA(0, 0, At, B0); PG8_MMA(0, 1, At, B1); PG8_BAR; PG8_SCHED;
            PG8_LDA(At, 0, 1); PG8_STAGE(PG8_SB(0, 0), b2, voffB); PG8_STAGE(PG8_SB(0, 1), b2 + hstep, voffB); PG8_STAGE(PG8_SA(0, 0), a2, voffA);
            PG8_WAIT_V(8); PG8_WAIT_L(0); PG8_BAR; PG8_MMA(1, 0, At, B0); PG8_MMA(1, 1, At, B1); PG8_BAR; PG8_SCHED;
            PG8_LDB(B0, 1, 0); PG8_LDB(B1, 1, 1); PG8_SCHED; PG8_LDA(At, 1, 0); PG8_STAGE(PG8_SA(0, 1), a2 + hstep, voffA);
            PG8_WAIT_V(8); PG8_WAIT_L(0); PG8_BAR; PG8_MMA(0, 0, At, B0); PG8_MMA(0, 1, At, B1); PG8_BAR; PG8_SCHED;
            PG8_LDA(At, 1, 1); PG8_STAGE(PG8_SB(1, 0), b3, voffB); PG8_STAGE(PG8_SB(1, 1), b3 + hstep, voffB); PG8_STAGE(PG8_SA(1, 0), a3, voffA);
            PG8_WAIT_V(8); PG8_WAIT_L(0); PG8_BAR; PG8_MMA(1, 0, At, B0); PG8_MMA(1, 1, At, B1); PG8_BAR; PG8_SCHED;
            } else {
            PG8_LDB(B0, 0, 0); PG8_SCHED; PG8_LDA(At, 0, 0); PG8_STAGE(PG8_SA(1, 1), a1 + hstep, voffA);
            PG8_WAIT_L(8); PG8_BAR; PG8_WAIT_L(0); PG8_MMA(0, 0, At, B0); PG8_BAR; PG8_SCHED;
            PG8_LDB(B1, 0, 1); PG8_STAGE(PG8_SB(0, 0), b2, voffB);
            PG8_BAR; PG8_WAIT_L(0); PG8_MMA(0, 1, At, B1); PG8_BAR;
            PG8_LDA(At, 0, 1); PG8_STAGE(PG8_SA(0, 0), a2, voffA);
            PG8_BAR; PG8_WAIT_L(0); PG8_MMA(1, 0, At, B0); PG8_BAR; PG8_SCHED;
            PG8_STAGE(PG8_SB(0, 1), b2 + hstep, voffB);
            PG8_WAIT_V(6); PG8_BAR; PG8_MMA(1, 1, At, B1); PG8_BAR;
            PG8_LDB(B0, 1, 0); PG8_SCHED; PG8_LDA(At, 1, 0); PG8_STAGE(PG8_SA(0, 1), a2 + hstep, voffA);
            PG8_WAIT_L(8); PG8_BAR; PG8_WAIT_L(0); PG8_MMA(0, 0, At, B0); PG8_BAR; PG8_SCHED;
            PG8_LDB(B1, 1, 1); PG8_STAGE(PG8_SB(1, 0), b3, voffB);
            PG8_BAR; PG8_WAIT_L(0); PG8_MMA(0, 1, At, B1); PG8_BAR;
            PG8_LDA(At, 1, 1); PG8_STAGE(PG8_SA(1, 0), a3, voffA);
            PG8_BAR; PG8_WAIT_L(0); PG8_MMA(1, 0, At, B0); PG8_BAR; PG8_SCHED;
            PG8_STAGE(PG8_SB(1, 1), b3 + hstep, voffB);
            PG8_WAIT_V(6); PG8_BAR; PG8_MMA(1, 1, At, B1); PG8_BAR;
            }
        }
        if constexpr (ALIGN_EPI) { if (wr == 0) PG8_BAR; }
        if constexpr (!Epi::AFTER_DRAIN) { E(acc, cur, wr, wc, fr, fq); S.done(cur); }
        if (!has_next) break;
#pragma unroll
        for (int a = 0; a < 2; ++a)
#pragma unroll
            for (int b = 0; b < 2; ++b)
#pragma unroll
                for (int m = 0; m < 4; ++m)
#pragma unroll
                    for (int n = 0; n < 2; ++n) acc[a][b][m][n] = (f32x4){0.f, 0.f, 0.f, 0.f};
        cur = nxt; cA = nA; cB = nB; ++ui;
        if constexpr (ALIGN_EPI) { if (wr == 1) PG8_BAR; }
    }
    PG8_WAIT_V(0);
    if constexpr (!ALIGN_EPI) { if (wr == 0) PG8_BAR; }
    PG8_BAR;
    if constexpr (Epi::AFTER_DRAIN) { E.fused(acc, cur, wr, wc, fr, fq, lds, wid, lane); S.done(cur); }
#undef PG8_SA
#undef PG8_SB
#undef PG8_STAGE
#undef PG8_LDA
#undef PG8_LDB
#undef PG8_MMA
#undef PG8_WAIT_V
#undef PG8_WAIT_L
#undef PG8_BAR
#undef PG8_SCHED
}
}

#ifndef MK_REP
#define MK_REP -1
#endif
constexpr int NWAVES = 8, NTHR = 512;
constexpr int MT = 8704, MP = 8192, DM = 2048, DIN = 4352, DSSM = 1024, DRW = 1024, DSH = 3328, DFF = 5632, NMEM = 256;
constexpr float ALPHA = 1.189207115002721f;
constexpr float LN_EPS = 1e-5f, GN_EPS = 64e-5f;
constexpr size_t O_Y = 0, O_SRE_P = (size_t)MT * DM, O_SIM_P = O_SRE_P + 16384, O_WKV_P = O_SIM_P + 16384, O_SH_P = O_WKV_P + 262144, O_MK = O_SH_P + 4 * DSH,
                 O_MV = O_MK + 2097152, O_SRE_S = O_MV + 2097152, O_SIM_S = O_SRE_S + 524288, O_WKV_S = O_SIM_S + 524288, O_SH_S = O_WKV_S + 8388608, O_END = O_SH_S + 128 * DSH;
static_assert(O_END == 32191488, "output size");
constexpr size_t MiB = 1u << 20;
constexpr size_t WS_CTL = 0, WS_WIN = 1 * MiB, WS_WGLU = 18 * MiB, WS_WOUT = 20 * MiB, WS_WQ = 28 * MiB, WS_WKV = 36 * MiB, WS_WO = 52 * MiB, WS_WGU = 60 * MiB, WS_WDN = 104 * MiB,
                 WS_W2T = 126 * MiB, WS_A2T = WS_W2T + 131072, WS_G2T = WS_W2T + 262144, WS_KB = 127 * MiB, WS_VTB = 131 * MiB, WS_XB = 135 * MiB, WS_MB = 169 * MiB,
                 WS_H = 173 * MiB, WS_R = WS_H, WS_X = WS_H + 72 * MiB, WS_PREP = 318 * MiB, WS_BONUS = 706 * MiB, WS_QB = WS_PREP, WS_OB = WS_PREP + 34 * MiB, WS_HFF = WS_PREP + 68 * MiB,
                 WS_YR = 557 * MiB, WS_YGB = 591 * MiB, WS_MIX = 608 * MiB, WS_PART = 642 * MiB, WS_BON4 = 706 * MiB, WS_END = 709 * MiB;
constexpr size_t PREP_STRIDE = 34 * MiB;
constexpr int LDS_BYTES = 135168;
constexpr int MISC_OFF = 131072;
constexpr int NPHASE = 14;

#define LAS __attribute__((address_space(3)))
typedef unsigned short bf16;
typedef unsigned v4u __attribute__((ext_vector_type(4)));
typedef unsigned v2u __attribute__((ext_vector_type(2)));
typedef float f32x4 __attribute__((ext_vector_type(4)));
typedef float f32x2 __attribute__((ext_vector_type(2)));
typedef float f32x16 __attribute__((ext_vector_type(16)));
typedef short bf16x8 __attribute__((ext_vector_type(8)));
#define LDS_WAIT() asm volatile("s_waitcnt lgkmcnt(0)" ::: "memory")

__device__ __forceinline__ unsigned pk2(float lo, float hi) { return pg8::cvt_pk_bf16(lo, hi); }
__device__ __forceinline__ bf16x8 pack_bf8(const f32x4 a, const f32x4 b) { v4u w; w.x = pk2(a[0], a[1]); w.y = pk2(a[2], a[3]); w.z = pk2(b[0], b[1]); w.w = pk2(b[2], b[3]); return __builtin_bit_cast(bf16x8, w); }
__device__ __forceinline__ float wave_sum(float v) {
#pragma unroll
    for (int o = 1; o < 64; o <<= 1) v += __shfl_xor(v, o);
    return v;
}
__device__ __forceinline__ float wave_max(float v) {
#pragma unroll
    for (int o = 1; o < 64; o <<= 1) v = fmaxf(v, __shfl_xor(v, o));
    return v;
}
template <int CTRL> __device__ __forceinline__ float dpp_f(float x) { return __builtin_bit_cast(float, __builtin_amdgcn_update_dpp(0, __builtin_bit_cast(int, x), CTRL, 0xf, 0xf, false)); }
__device__ __forceinline__ float sum16(float x) { x += dpp_f<0xB1>(x); x += dpp_f<0x4E>(x); x += dpp_f<0x141>(x); x += dpp_f<0x140>(x); return x; }
__device__ __forceinline__ float sigm(float x) { return 1.0f / (1.0f + __expf(-x)); }
__device__ __forceinline__ float tanh_(float x) { return 1.0f - 2.0f / (1.0f + __expf(2.0f * x)); }
__device__ __forceinline__ float gelu_tanh(float x) { const float u = 1.5957691216057308f * (x + 0.044715f * x * x * x); return x / (1.0f + __expf(-u)); }
#define MFMA16(a, b, c) __builtin_amdgcn_mfma_f32_16x16x32_bf16((a), (b), (c), 0, 0, 0)
#define MFMA32(a, b, c) __builtin_amdgcn_mfma_f32_32x32x16_bf16((a), (b), (c), 0, 0, 0)

struct Args { const float* in[45]; float* out; unsigned char* ws; int lo, hi; };

struct Frame {
    LAS unsigned char* lds; volatile LAS unsigned* MISC;
    int tid, lane, wave, G, bid;
    const float* const* in; float* out; unsigned char* ws;
};

__device__ __forceinline__ void tr_item(const float* W, int K, int N, bf16* WT, int drow0, int k0, int n0, LAS float* scr, int lane) {
#pragma unroll 8
    for (int i = 0; i < 32; ++i) { const int kk = 2 * i + (lane >> 5); scr[kk * 33 + (lane & 31)] = W[(size_t)(k0 + kk) * N + n0 + (lane & 31)]; }
    LDS_WAIT(); asm volatile("" ::: "memory");
    const int c = lane & 7;
#pragma unroll
    for (int j = 0; j < 4; ++j) { const int n = (lane >> 3) + 8 * j; const LAS float* s = scr + (8 * c) * 33 + n;
        v4u o; o.x = pk2(s[0 * 33], s[1 * 33]); o.y = pk2(s[2 * 33], s[3 * 33]); o.z = pk2(s[4 * 33], s[5 * 33]); o.w = pk2(s[6 * 33], s[7 * 33]);
        *(v4u*)(WT + (size_t)(drow0 + n) * K + k0 + 8 * c) = o; }
    LDS_WAIT(); asm volatile("" ::: "memory");
}
__device__ __forceinline__ void p0_prologue(Frame& F) {
    LAS float* scr = (LAS float*)(F.lds + F.wave * 16384);
    const int gw = F.bid * NWAVES + F.wave, NGW = F.G * NWAVES, lane = F.lane;
    unsigned char* ws = F.ws;
#define TR_MAT(Wp, Kk, Nn, Dst, ROWMAP) { const int nblk = (Nn) / 32, cnt = ((Kk) / 64) * nblk; if (r < cnt) { const int kb = r / nblk, n0 = (r % nblk) * 32; \
        tr_item((Wp), (Kk), (Nn), (bf16*)(Dst), (ROWMAP), kb * 64, n0, scr, lane); continue; } r -= cnt; }
    constexpr int NITEMS = 32 * 136 + 2 * 32 * 64 + 32 + 32 + 64;
    for (int it = gw; it < NITEMS; it += NGW) {
        int r = it;
        TR_MAT(F.in[9], DM, DIN, ws + WS_WIN, n0)
        TR_MAT(F.in[35], DM, DM, ws + WS_WKV, n0)
        TR_MAT(F.in[36], DM, DM, ws + WS_WKV, 2048 + n0)
        TR_MAT(F.in[22], 64, DRW, ws + WS_W2T, n0)
        TR_MAT(F.in[24], 64, DRW, ws + WS_A2T, n0)
        TR_MAT(F.in[25], 128, DRW, ws + WS_G2T, n0)
    }
#undef TR_MAT
    const size_t gt = (size_t)F.bid * NTHR + F.tid, NGT = (size_t)F.G * NTHR;
    { const f32x4* xp = (const f32x4*)F.in[0]; const f32x4* xs = (const f32x4*)F.in[1]; v4u* xb = (v4u*)(ws + WS_XB);
      const size_t np = (size_t)MP * DM / 8, nt = (size_t)MT * DM / 8;
      for (size_t i = gt; i < nt; i += NGT) { const f32x4* s = i < np ? xp + 2 * i : xs + 2 * (i - np); const f32x4 a = s[0], b = s[1]; xb[i] = pg8::pack8(a, b); } }
    { const f32x4* mp = (const f32x4*)F.in[2]; v4u* mb = (v4u*)(ws + WS_MB); const size_t nm = (size_t)1024 * DM / 8;
      for (size_t i = gt; i < nm; i += NGT) { const f32x4 a = mp[2 * i], b = mp[2 * i + 1]; mb[i] = pg8::pack8(a, b); } }
}

constexpr int N_TR_LATE = 16 * 32 + 3 * 32 * 64 + 2 * 32 * 176 + 88 * 64;
__device__ __forceinline__ void tr_late_item(Frame& F, int r, LAS float* scr) {
    unsigned char* ws = F.ws; const int lane = F.lane;
#define TR_MAT(Wp, Kk, Nn, Dst, ROWMAP) { const int nblk = (Nn) / 32, cnt = ((Kk) / 64) * nblk; if (r < cnt) { const int kb = r / nblk, n0 = (r % nblk) * 32; \
        tr_item((Wp), (Kk), (Nn), (bf16*)(Dst), (ROWMAP), kb * 64, n0, scr, lane); return; } r -= cnt; }
    TR_MAT(F.in[18], DSSM, DSSM, ws + WS_WGLU, n0)
    TR_MAT(F.in[31], DM, DM, ws + WS_WOUT, n0)
    TR_MAT(F.in[34], DM, DM, ws + WS_WQ, n0)
    TR_MAT(F.in[37], DM, DM, ws + WS_WO, n0)
    TR_MAT(F.in[40], DM, DFF, ws + WS_WGU, 256 * (n0 / 128) + (n0 % 128))
    TR_MAT(F.in[41], DM, DFF, ws + WS_WGU, 256 * (n0 / 128) + 128 + (n0 % 128))
    TR_MAT(F.in[42], DFF, DM, ws + WS_WDN, n0)
#undef TR_MAT
}

__device__ __forceinline__ void p2_prep(Frame& F) {
    const float* H = (const float*)(F.ws + WS_H);
    const float* mu = F.in[20]; const float* w0 = F.in[21]; const float* a0 = F.in[23]; const float* k_k = F.in[26]; const float* k_a = F.in[27]; const float* r_k = F.in[28];
    const bf16* W2T = (const bf16*)(F.ws + WS_W2T); const bf16* A2T = (const bf16*)(F.ws + WS_A2T); const bf16* G2T = (const bf16*)(F.ws + WS_G2T);
    float* PR = (float*)(F.ws + WS_PREP); constexpr size_t PS = PREP_STRIDE / 4;
    float* BON = (float*)(F.ws + WS_BONUS);
    const int lane = F.lane, fr = lane & 15, fq = lane >> 4, tid = F.tid, w = F.wave;
    LAS bf16* ACT = (LAS bf16*)F.lds;
    LAS float* PRE = (LAS float*)(F.lds + 8448);
    for (int tile = F.bid; tile < MT / 16; tile += F.G) {
        { const int tk = tid >> 5, c8 = (tid & 31) * 8, m = tile * 16 + tk;
          const float* prow = H + (size_t)m * DIN + 1024 + 3072 + c8;
          const bool prompt = m < MP; const int t = prompt ? (m & 2047) : ((m - MP) & 3);
          const float* qrow = prow - DIN; float qs = 1.0f;
          if (t == 0) { if (prompt) { qrow = prow; qs = 0.0f; } else qrow = F.in[6] + (size_t)((m - MP) >> 2) * DSH + 3072 + c8; }
          f32x4 x0 = *(const f32x4*)prow, x1 = *(const f32x4*)(prow + 4);
          const f32x4 q0 = *(const f32x4*)qrow * qs, q1 = *(const f32x4*)(qrow + 4) * qs, m0 = *(const f32x4*)(mu + 3072 + c8), m1 = *(const f32x4*)(mu + 3072 + c8 + 4);
          x0 = x0 + (q0 - x0) * m0; x1 = x1 + (q1 - x1) * m1;
          if (c8 < 64) {
#pragma unroll
              for (int j = 0; j < 4; ++j) { x0[j] = tanh_(x0[j]); x1[j] = tanh_(x1[j]); }
          } else if (c8 >= 128) {
#pragma unroll
              for (int j = 0; j < 4; ++j) { x0[j] = sigm(x0[j]); x1[j] = sigm(x1[j]); } }
          *(LAS bf16x8*)(ACT + tk * 264 + c8) = pack_bf8(x0, x1); }
        __syncthreads();
        bf16x8 bw[2], ba[2], bg[4];
#pragma unroll
        for (int kc = 0; kc < 2; ++kc) { bw[kc] = *(const LAS bf16x8*)(ACT + fr * 264 + 32 * kc + 8 * fq); ba[kc] = *(const LAS bf16x8*)(ACT + fr * 264 + 64 + 32 * kc + 8 * fq); }
#pragma unroll
        for (int kc = 0; kc < 4; ++kc) bg[kc] = *(const LAS bf16x8*)(ACT + fr * 264 + 128 + 32 * kc + 8 * fq);
#pragma unroll 1
        for (int half = 0; half < 2; ++half) {
            { const int hd = 8 * half + w;
#pragma unroll
              for (int ct = 0; ct < 4; ++ct) { const int c = 64 * hd + 16 * ct + fr;
                  f32x4 aW = (f32x4){0.f, 0.f, 0.f, 0.f}, aA = aW, aG = aW;
#pragma unroll
                  for (int kc = 0; kc < 2; ++kc) { aW = MFMA16(*(const bf16x8*)(W2T + c * 64 + 32 * kc + 8 * fq), bw[kc], aW);
                                                    aA = MFMA16(*(const bf16x8*)(A2T + c * 64 + 32 * kc + 8 * fq), ba[kc], aA); }
#pragma unroll
                  for (int kc = 0; kc < 4; ++kc) aG = MFMA16(*(const bf16x8*)(G2T + c * 128 + 32 * kc + 8 * fq), bg[kc], aG);
                  const int lc = 64 * w + 16 * ct + 4 * fq;
                  *(LAS f32x4*)(PRE + (0 * 16 + fr) * 516 + lc) = aW; *(LAS f32x4*)(PRE + (1 * 16 + fr) * 516 + lc) = aA; *(LAS f32x4*)(PRE + (2 * 16 + fr) * 516 + lc) = aG; } }
            __syncthreads();
#pragma unroll 1
            for (int j = 0; j < 2; ++j) { const int lc = 4 * lane + 256 * j, col = 512 * half + lc, hd = 8 * half + 4 * j + (lane >> 4);
                const f32x4 mr = *(const f32x4*)(mu + col), mk = *(const f32x4*)(mu + 1024 + col), mv = *(const f32x4*)(mu + 2048 + col);
                const f32x4 w04 = *(const f32x4*)(w0 + col), a04 = *(const f32x4*)(a0 + col), kk4 = *(const f32x4*)(k_k + col), ka4 = *(const f32x4*)(k_a + col), rk4 = *(const f32x4*)(r_k + col);
#pragma unroll
                for (int tq = 0; tq < 2; ++tq) { const int tk = 2 * w + tq, m = tile * 16 + tk;
                    const float* prow = H + (size_t)m * DIN + 1024 + col;
                    const bool prompt = m < MP; const int t = prompt ? (m & 2047) : ((m - MP) & 3);
                    const float* qrow = prow - DIN; float qs = 1.0f;
                    if (t == 0) { if (prompt) { qrow = prow; qs = 0.0f; } else qrow = F.in[6] + (size_t)((m - MP) >> 2) * DSH + col; }
                    f32x4 r4 = *(const f32x4*)prow, k4 = *(const f32x4*)(prow + 1024), v4 = *(const f32x4*)(prow + 2048);
                    const f32x4 rq = *(const f32x4*)qrow * qs, kq = *(const f32x4*)(qrow + 1024) * qs, vq = *(const f32x4*)(qrow + 2048) * qs;
                    r4 = r4 + (rq - r4) * mr; k4 = k4 + (kq - k4) * mk; v4 = v4 + (vq - v4) * mv;
                    const f32x4 pW = *(const LAS f32x4*)(PRE + (0 * 16 + tk) * 516 + lc), pA = *(const LAS f32x4*)(PRE + (1 * 16 + tk) * 516 + lc), pG = *(const LAS f32x4*)(PRE + (2 * 16 + tk) * 516 + lc);
                    f32x4 dec, a, km, kkr; float ss = 0.f;
#pragma unroll
                    for (int e = 0; e < 4; ++e) { const float z = -(w04[e] + pW[e]); const float sp = fmaxf(z, 0.f) + __logf(1.0f + __expf(-fabsf(z))); const float wl = -sp - 0.5f;
                        dec[e] = __expf(-__expf(wl)); a[e] = sigm(a04[e] + pA[e]); km[e] = k4[e] * (1.0f + (a[e] - 1.0f) * ka4[e]);
                        kkr[e] = k4[e] * kk4[e]; ss += kkr[e] * kkr[e]; }
                    ss = sum16(ss);
                    const float inv = rsqrtf(fmaxf(ss, 1e-24f));
                    const f32x4 kk = kkr * inv, bb = kk * a;
                    float bon = (r4[0] * km[0] * rk4[0] + r4[1] * km[1] * rk4[1]) + (r4[2] * km[2] * rk4[2] + r4[3] * km[3] * rk4[3]);
                    float br = (bb[0] * r4[0] + bb[1] * r4[1]) + (bb[2] * r4[2] + bb[3] * r4[3]);
                    float kr = (km[0] * r4[0] + km[1] * r4[1]) + (km[2] * r4[2] + km[3] * r4[3]);
                    bon = sum16(bon); br = sum16(br); kr = sum16(kr);
                    const size_t o = (size_t)m * 1024 + col;
                    *(f32x4*)(PR + 0 * PS + o) = dec * r4; *(f32x4*)(PR + 1 * PS + o) = dec; *(f32x4*)(PR + 2 * PS + o) = km; *(f32x4*)(PR + 3 * PS + o) = v4;
                    *(f32x4*)(PR + 4 * PS + o) = -kk; *(f32x4*)(PR + 5 * PS + o) = bb; *(f32x4*)(PR + 6 * PS + o) = pG;
                    if ((lane & 15) == 0) *(f32x4*)(BON + ((size_t)m * 16 + hd) * 4) = (f32x4){bon, br, kr, 0.f}; } }
            __syncthreads();
        }
    }
    { const int gt = F.bid * NTHR + F.tid, NGT = F.G * NTHR;
      for (int i = gt; i < 132 * (DSH / 4); i += NGT) { const int s = i / (DSH / 4), c4 = i % (DSH / 4);
          const int m = s < 4 ? s * 2048 + 2047 : MP + 4 * (s - 4) + 3;
          float* o = s < 4 ? F.out + O_SH_P + (size_t)s * DSH : F.out + O_SH_S + (size_t)(s - 4) * DSH;
          *(f32x4*)(o + 4 * c4) = *(const f32x4*)(H + (size_t)m * DIN + 1024 + 4 * c4); } }
}

__device__ __forceinline__ void grp_bar(volatile LAS unsigned* cnt, unsigned& gen, int lane) {
    gen += 4u; LDS_WAIT();
    if (lane == 0) (void)__hip_atomic_fetch_add((LAS unsigned*)cnt, 1u, __ATOMIC_RELAXED, __HIP_MEMORY_SCOPE_WORKGROUP);
    while (*cnt < gen) __builtin_amdgcn_s_sleep(1);
    asm volatile("" ::: "memory");
}
__device__ __forceinline__ void rwkv_scan_prompt(Frame& F, int b, int h, int quarter) {
    const float* PR = (const float*)(F.ws + WS_PREP); constexpr size_t PS = PREP_STRIDE / 4;
    const float* BON = (const float*)(F.ws + WS_BONUS);
    float* YR = (float*)(F.ws + WS_YR);
    const int tid = F.tid, lane = F.lane, rr = lane >> 4, kq = lane & 15, v = 16 * quarter + 4 * F.wave + rr, m0 = b * 2048;
    constexpr int SST = 388, BST = 16 * SST;
    LAS float* buf = (LAS float*)F.lds;
    volatile LAS unsigned* cnt = F.MISC + 16; unsigned gen = 0u;
    f32x4 S = (f32x4){0.f, 0.f, 0.f, 0.f};
    const int step_l = tid >> 4, part = tid & 15;
    f32x4 st[6], stb;
#define RW_GLOAD(c) do { const size_t off_ = (size_t)(m0 + (c) * 16 + step_l) * 1024 + h * 64 + 4 * part; \
        st[0] = *(const f32x4*)(PR + 1 * PS + off_); st[1] = *(const f32x4*)(PR + 4 * PS + off_); st[2] = *(const f32x4*)(PR + 5 * PS + off_); \
        st[3] = *(const f32x4*)(PR + 2 * PS + off_); st[4] = *(const f32x4*)(PR + 0 * PS + off_); st[5] = *(const f32x4*)(PR + 3 * PS + off_); \
        if (part == 0) stb = *(const f32x4*)(BON + ((size_t)(m0 + (c) * 16 + step_l) * 16 + h) * 4); } while (0)
#define RW_LSTORE(bi) do { LAS float* d_ = buf + (bi) * BST + step_l * SST + 4 * part; _Pragma("unroll") for (int q = 0; q < 6; ++q) *(LAS f32x4*)(d_ + q * 64) = st[q]; \
        if (part == 0) *(LAS f32x4*)(d_ + 384) = stb; } while (0)
#define RW_LREAD(sb_, W_, NK_, B_, K_, WR_, VV_, SC_) do { W_ = *(const LAS f32x4*)((sb_) + 4 * kq); NK_ = *(const LAS f32x4*)((sb_) + 64 + 4 * kq); B_ = *(const LAS f32x4*)((sb_) + 128 + 4 * kq); \
        K_ = *(const LAS f32x4*)((sb_) + 192 + 4 * kq); WR_ = *(const LAS f32x4*)((sb_) + 256 + 4 * kq); VV_ = (sb_)[320 + v]; SC_ = *(const LAS f32x4*)((sb_) + 384); } while (0)
    stb = (f32x4){0.f, 0.f, 0.f, 0.f};
    RW_GLOAD(0); RW_LSTORE(0); grp_bar(cnt, gen, lane);
    for (int c = 0; c < 128; ++c) {
        const int cur = c & 1;
        if (c + 1 < 128) RW_GLOAD(c + 1);
        const LAS float* cb = buf + cur * BST;
        float yk = 0.f;
        f32x4 nw, nnk, nb, nk, nwr, nsc; float nvv;
        RW_LREAD(cb, nw, nnk, nb, nk, nwr, nvv, nsc);
#pragma unroll
        for (int s = 0; s < 16; ++s) {
            const f32x4 w4 = nw, nk4 = nnk, b4 = nb, k4 = nk, wr4 = nwr, sc = nsc; const float vv = nvv;
            if (s + 1 < 16) RW_LREAD(cb + (s + 1) * SST, nw, nnk, nb, nk, nwr, nvv, nsc);
            float sa = (S[0] * nk4[0] + S[1] * nk4[1]) + (S[2] * nk4[2] + S[3] * nk4[3]);
            float p = (S[0] * wr4[0] + S[1] * wr4[1]) + (S[2] * wr4[2] + S[3] * wr4[3]);
            sa += dpp_f<0xB1>(sa); p += dpp_f<0xB1>(p); sa += dpp_f<0x4E>(sa); p += dpp_f<0x4E>(p);
            sa += dpp_f<0x141>(sa); p += dpp_f<0x141>(p); sa += dpp_f<0x140>(sa); p += dpp_f<0x140>(p);
            S = S * w4 + (b4 * sa + k4 * vv);
            const float y = p + sa * sc[1] + vv * sc[2];
            yk = (kq == s) ? y : yk;
        }
        YR[(size_t)(m0 + 16 * c + kq) * 1024 + h * 64 + v] = yk;
        if (c + 1 < 128) RW_LSTORE(cur ^ 1);
        grp_bar(cnt, gen, lane);
    }
#undef RW_GLOAD
#undef RW_LSTORE
#undef RW_LREAD
    *(f32x4*)(F.out + O_WKV_P + (size_t)(b * 16 + h) * 4096 + v * 64 + 4 * kq) = S;
}
__device__ __forceinline__ void rwkv_sample_item(Frame& F, int b, int h) {
    const float* PR = (const float*)(F.ws + WS_PREP); constexpr size_t PS = PREP_STRIDE / 4;
    const float* BON = (const float*)(F.ws + WS_BONUS);
    float* YR = (float*)(F.ws + WS_YR);
    const int lane = F.lane, rr = lane >> 4, kq = lane & 15, m0 = MP + 4 * b;
    const float* s_in = F.in[5] + (size_t)(b * 16 + h) * 4096; float* s_out = F.out + O_WKV_S + (size_t)(b * 16 + h) * 4096;
    f32x4 w4[4], nk4[4], b4[4], k4[4], wr4[4], sc[4];
#pragma unroll
    for (int t = 0; t < 4; ++t) { const size_t off = (size_t)(m0 + t) * 1024 + h * 64 + 4 * kq;
        w4[t] = *(const f32x4*)(PR + 1 * PS + off); nk4[t] = *(const f32x4*)(PR + 4 * PS + off); b4[t] = *(const f32x4*)(PR + 5 * PS + off);
        k4[t] = *(const f32x4*)(PR + 2 * PS + off); wr4[t] = *(const f32x4*)(PR + 0 * PS + off); sc[t] = *(const f32x4*)(BON + ((size_t)(m0 + t) * 16 + h) * 4); }
#pragma unroll 4
    for (int rg = 0; rg < 16; ++rg) { const int v = 4 * rg + rr;
        f32x4 S = *(const f32x4*)(s_in + v * 64 + 4 * kq);
        float vv[4];
#pragma unroll
        for (int t = 0; t < 4; ++t) vv[t] = PR[3 * PS + (size_t)(m0 + t) * 1024 + h * 64 + v];
        float yk = 0.f;
#pragma unroll
        for (int t = 0; t < 4; ++t) {
            float sa = (S[0] * nk4[t][0] + S[1] * nk4[t][1]) + (S[2] * nk4[t][2] + S[3] * nk4[t][3]);
            float p = (S[0] * wr4[t][0] + S[1] * wr4[t][1]) + (S[2] * wr4[t][2] + S[3] * wr4[t][3]);
            sa = sum16(sa); p = sum16(p);
            S = S * w4[t] + (b4[t] * sa + k4[t] * vv[t]);
            const float y = p + sa * sc[t][1] + vv[t] * sc[t][2];
            yk = (kq == t) ? y : yk;
        }
        if (kq < 4) YR[(size_t)(m0 + kq) * 1024 + h * 64 + v] = yk;
        *(f32x4*)(s_out + v * 64 + 4 * kq) = S; }
}

template <int SEG> __device__ __forceinline__ void ssm_item(Frame& F, int g, int sel) {
    const float* H = (const float*)(F.ws + WS_H);
    bf16* YG = (bf16*)(F.ws + WS_YGB);
    const int lane = F.lane, n = lane & 31, hh = lane >> 5, fr = lane & 15, fq = lane >> 4;
    LAS bf16* ldsS = (LAS bf16*)(F.lds + 50176 + F.wave * 8704);
    const float dt = __expf(F.in[17][g]);
    float lr[2], li[2]; bf16x8 Bre[2], Bim[2];
#pragma unroll
    for (int pp = 0; pp < 2; ++pp) { const int p = 2 * n + pp; const float are = F.in[10][g * 64 + p], aim = F.in[11][g * 64 + p];
        const float mag = expf(are * dt), ang = aim * dt; float sn, cs; sincosf(ang, &sn, &cs); lr[pp] = mag * cs; li[pp] = mag * sn;
        const float sh = sinf(0.5f * ang); const float xr = expm1f(are * dt) * cs - 2.0f * sh * sh, xi = mag * sn;
        const float den = 1.0f / (are * are + aim * aim); const float qr = (xr * are + xi * aim) * den, qi = (xi * are - xr * aim) * den;
        const float* brp = F.in[12] + (size_t)(g * 64 + p) * 16 + 8 * hh; const float* bip = F.in[13] + (size_t)(g * 64 + p) * 16 + 8 * hh;
        const f32x4 br0 = *(const f32x4*)brp, br1 = *(const f32x4*)(brp + 4), bi0 = *(const f32x4*)bip, bi1 = *(const f32x4*)(bip + 4);
        Bre[pp] = pack_bf8(br0 * qr - bi0 * qi, br1 * qr - bi1 * qi); Bim[pp] = pack_bf8(bi0 * qr + br0 * qi, bi1 * qr + br1 * qi); }
    bf16x8 Cop[4];
#pragma unroll
    for (int kc = 0; kc < 4; ++kc) { const float* cp = (kc < 2 ? F.in[14] : F.in[15]) + (size_t)(g * 16 + fr) * 64 + 32 * (kc & 1) + 8 * fq; const float sg = kc < 2 ? 1.0f : -1.0f;
        Cop[kc] = pack_bf8(*(const f32x4*)cp * sg, *(const f32x4*)(cp + 4) * sg); }
    const f32x4 d4 = *(const f32x4*)(F.in[16] + 16 * g + 4 * fq);
    float sre[2] = {0.f, 0.f}, sim[2] = {0.f, 0.f};
    const int ntile = SEG == 16 ? 128 : 1;
    const int hr = (n >> 2) & 1, ir = 4 * (n >> 3) + (n & 3);
#define SSM_AROW(t_) (SEG == 16 ? (2 * sel + hr) * 2048 + (t_) * 16 + ir : MP + 4 * (8 * sel + 4 * hr + (ir >> 2)) + (ir & 3))
#define SSM_OROW(t_, rg_) (SEG == 16 ? (2 * sel + (rg_)) * 2048 + (t_) * 16 + fr : MP + 4 * (8 * sel + 4 * (rg_) + (fr >> 2)) + (fr & 3))
#define SSM_LOAD(t_, A0, A1_, U0, U1) do { const float* up_ = H + (size_t)SSM_AROW(t_) * DIN + 16 * g + 8 * hh; A0 = *(const f32x4*)up_; A1_ = *(const f32x4*)(up_ + 4); \
        U0 = *(const f32x4*)(H + (size_t)SSM_OROW(t_, 0) * DIN + 16 * g + 4 * fq); U1 = *(const f32x4*)(H + (size_t)SSM_OROW(t_, 1) * DIN + 16 * g + 4 * fq); } while (0)
    f32x4 pa0[2], pa1[2], pu0[2], pu1[2];
    SSM_LOAD(0, pa0[0], pa1[0], pu0[0], pu1[0]);
    if (ntile > 1) SSM_LOAD(1, pa0[1], pa1[1], pu0[1], pu1[1]); else { pa0[1] = pa0[0]; pa1[1] = pa1[0]; pu0[1] = pu0[0]; pu1[1] = pu1[0]; }
    for (int tile = 0; tile < ntile; ++tile) {
        const f32x4 ca0 = pa0[0], ca1 = pa1[0]; const f32x4 cu[2] = {pu0[0], pu1[0]};
        pa0[0] = pa0[1]; pa1[0] = pa1[1]; pu0[0] = pu0[1]; pu1[0] = pu1[1];
        if (tile + 2 < ntile) SSM_LOAD(tile + 2, pa0[1], pa1[1], pu0[1], pu1[1]);
        const bf16x8 A1 = pack_bf8(ca0, ca1);
        const f32x16 z16 = {0.f, 0.f, 0.f, 0.f, 0.f, 0.f, 0.f, 0.f, 0.f, 0.f, 0.f, 0.f, 0.f, 0.f, 0.f, 0.f};
        f32x16 aRe[2], aIm[2];
#pragma unroll
        for (int pp = 0; pp < 2; ++pp) { aRe[pp] = MFMA32(A1, Bre[pp], z16); aIm[pp] = MFMA32(A1, Bim[pp], z16); }
#pragma unroll
        for (int i = 0; i < 16; ++i) {
            if (SEG == 4 && (i & 3) == 0) { const int batch = 8 * sel + 4 * hh + (i >> 2); const size_t so = (size_t)(batch * 64 + g) * 64 + 2 * n;
                const f32x2 a = *(const f32x2*)(F.in[3] + so), b = *(const f32x2*)(F.in[4] + so); sre[0] = a[0]; sre[1] = a[1]; sim[0] = b[0]; sim[1] = b[1]; }
#pragma unroll
            for (int pp = 0; pp < 2; ++pp) { const float nr = lr[pp] * sre[pp] - li[pp] * sim[pp] + aRe[pp][i], ni = lr[pp] * sim[pp] + li[pp] * sre[pp] + aIm[pp][i]; sre[pp] = nr; sim[pp] = ni; }
            *(LAS unsigned*)(ldsS + (16 * hh + i) * 136 + 2 * n) = pk2(sre[0], sre[1]);
            *(LAS unsigned*)(ldsS + (16 * hh + i) * 136 + 64 + 2 * n) = pk2(sim[0], sim[1]);
            if (SEG == 4 && (i & 3) == 3) { const int batch = 8 * sel + 4 * hh + (i >> 2); const size_t so = (size_t)(batch * 64 + g) * 64 + 2 * n;
                *(f32x2*)(F.out + O_SRE_S + so) = (f32x2){sre[0], sre[1]}; *(f32x2*)(F.out + O_SIM_S + so) = (f32x2){sim[0], sim[1]}; }
        }
        LDS_WAIT(); asm volatile("" ::: "memory");
#pragma unroll
        for (int rg = 0; rg < 2; ++rg) {
            f32x4 aY = (f32x4){0.f, 0.f, 0.f, 0.f};
#pragma unroll
            for (int kc = 0; kc < 4; ++kc) aY = MFMA16(Cop[kc], *(const LAS bf16x8*)(ldsS + (16 * rg + fr) * 136 + 32 * kc + 8 * fq), aY);
            const int orow = SSM_OROW(tile, rg);
            const f32x4 u4 = cu[rg];
            const f32x4 y = aY + d4 * u4;
            v2u w; w.x = pk2(gelu_tanh(y[0]), gelu_tanh(y[1])); w.y = pk2(gelu_tanh(y[2]), gelu_tanh(y[3]));
            *(v2u*)(YG + (size_t)orow * 1024 + 16 * g + 4 * fq) = w;
        }
        LDS_WAIT(); asm volatile("" ::: "memory");
    }
    if (SEG == 16) { const size_t so = (size_t)((2 * sel + hh) * 64 + g) * 64 + 2 * n;
        *(f32x2*)(F.out + O_SRE_P + so) = (f32x2){sre[0], sre[1]}; *(f32x2*)(F.out + O_SIM_P + so) = (f32x2){sim[0], sim[1]}; }
}

__device__ __forceinline__ void p3_scans(Frame& F, int rep) {
    unsigned* ctr = (unsigned*)(F.ws + WS_CTL) + 128 * rep;
    constexpr int N_SP = 128, N_RS = 2048, N_SS = 1024, TOTAL = N_SP + N_RS + N_SS + N_TR_LATE;
    if (F.tid == 0) F.MISC[16] = 0u;
    __syncthreads();
    if (F.wave < 4) { for (int it = F.bid; it < 256; it += F.G) rwkv_scan_prompt(F, it >> 6, (it >> 2) & 15, it & 3); }
    for (;;) {
        unsigned itu = 0u;
        if (F.lane == 0) itu = atomicAdd(ctr, 1u);
        int it = (int)__builtin_amdgcn_readfirstlane(itu);
        if (it >= TOTAL) break;
        if (it < N_SP) { ssm_item<16>(F, it >> 1, it & 1); continue; }
        it -= N_SP;
        if (it < N_RS) { rwkv_sample_item(F, it >> 4, it & 15); continue; }
        it -= N_RS;
        if (it < N_SS) { ssm_item<4>(F, it >> 4, it & 15); continue; }
        it -= N_SS;
        tr_late_item(F, it, (LAS float*)(F.lds + 50176 + F.wave * 8704));
    }
}

__device__ __forceinline__ void p4_post(Frame& F, int rep) {
    unsigned* ctr = (unsigned*)(F.ws + WS_CTL) + 64 + 128 * rep;
    const float* PR = (const float*)(F.ws + WS_PREP); constexpr size_t PS = PREP_STRIDE / 4;
    const float* YR = (const float*)(F.ws + WS_YR); const float* BON = (const float*)(F.ws + WS_BONUS);
    const float* lg = F.in[29]; const float* lb = F.in[30];
    bf16* MIX = (bf16*)(F.ws + WS_MIX);
    const int lane = F.lane;
    for (;;) {
        __syncthreads();
        if (F.tid == 0) F.MISC[0] = atomicAdd(ctr, 1u);
        __syncthreads();
        const int it = (int)F.MISC[0];
        if (it >= MT / 16) break;
#pragma unroll 1
        for (int q = 0; q < 2; ++q) { const int m = it * 16 + 2 * F.wave + q;
#pragma unroll
            for (int j = 0; j < 4; ++j) { const int col = 256 * j + 4 * lane, hd = 4 * j + (lane >> 4); const size_t o = (size_t)m * 1024 + col;
                const f32x4 y = *(const f32x4*)(YR + o);
                const float mean = sum16((y[0] + y[1]) + (y[2] + y[3])) * (1.0f / 64.0f);
                const f32x4 d = y - mean;
                const float var = sum16((d[0] * d[0] + d[1] * d[1]) + (d[2] * d[2] + d[3] * d[3])) * (1.0f / 64.0f);
                const float rstd = rsqrtf(var + GN_EPS), bon = BON[((size_t)m * 16 + hd) * 4];
                const f32x4 v4 = *(const f32x4*)(PR + 3 * PS + o), g4 = *(const f32x4*)(PR + 6 * PS + o), lg4 = *(const f32x4*)(lg + col), lb4 = *(const f32x4*)(lb + col);
                const f32x4 ov = (d * rstd * lg4 + lb4 + v4 * bon) * g4;
                v2u w; w.x = pk2(ov[0], ov[1]); w.y = pk2(ov[2], ov[3]);
                *(v2u*)(MIX + (size_t)m * 2048 + 1024 + col) = w; } }
    }
}

__device__ __forceinline__ void ln_rows(Frame& F, const float* src, const float* gam, const float* bet, float* dstf, bf16* dstb, const float* sbase, const float* part, int nsplit) {
    const int gw = F.bid * NWAVES + F.wave, NGW = F.G * NWAVES, lane = F.lane;
    const bool has_s = (gw & 3) == 0 && (gw >> 2) < (MT - MP);
    for (int it = has_s ? -1 : 0; it < MP / NGW; it += (it < 0 ? 1 : 2)) {
        const int row0 = it < 0 ? MP + (gw >> 2) : gw + it * NGW, row1 = it < 0 ? row0 : row0 + NGW;
        f32x4 v[2][8];
        if (it < 0) { const f32x4* sb = (const f32x4*)(sbase + (size_t)(row0 - MP) * DM) + lane;
#pragma unroll
            for (int j = 0; j < 8; ++j) { v[0][j] = sb[64 * j] * ALPHA; v[1][j] = v[0][j]; }
#pragma unroll 2
            for (int ks = 0; ks < nsplit; ++ks) { const f32x4* pp = (const f32x4*)(part + ((size_t)ks * 512 + (row0 - MP)) * DM) + lane;
#pragma unroll
                for (int j = 0; j < 8; ++j) v[0][j] += pp[64 * j]; }
        } else { const f32x4* s0 = (const f32x4*)(src + (size_t)row0 * DM) + lane; const f32x4* s1 = (const f32x4*)(src + (size_t)row1 * DM) + lane;
#pragma unroll
            for (int j = 0; j < 8; ++j) { v[0][j] = s0[64 * j]; v[1][j] = s1[64 * j]; } }
        float sm0 = 0.f, sm1 = 0.f;
#pragma unroll
        for (int j = 0; j < 8; ++j) { sm0 += (v[0][j][0] + v[0][j][1]) + (v[0][j][2] + v[0][j][3]); sm1 += (v[1][j][0] + v[1][j][1]) + (v[1][j][2] + v[1][j][3]); }
#pragma unroll
        for (int o = 1; o < 64; o <<= 1) { sm0 += __shfl_xor(sm0, o); sm1 += __shfl_xor(sm1, o); }
        const float mean0 = sm0 * (1.0f / DM), mean1 = sm1 * (1.0f / DM); float q0 = 0.f, q1 = 0.f;
#pragma unroll
        for (int j = 0; j < 8; ++j) { v[0][j] = v[0][j] - mean0; v[1][j] = v[1][j] - mean1;
            q0 += (v[0][j][0] * v[0][j][0] + v[0][j][1] * v[0][j][1]) + (v[0][j][2] * v[0][j][2] + v[0][j][3] * v[0][j][3]);
            q1 += (v[1][j][0] * v[1][j][0] + v[1][j][1] * v[1][j][1]) + (v[1][j][2] * v[1][j][2] + v[1][j][3] * v[1][j][3]); }
#pragma unroll
        for (int o = 1; o < 64; o <<= 1) { q0 += __shfl_xor(q0, o); q1 += __shfl_xor(q1, o); }
        const float rstd0 = rsqrtf(q0 * (1.0f / DM) + LN_EPS), rstd1 = rsqrtf(q1 * (1.0f / DM) + LN_EPS);
#pragma unroll
        for (int j = 0; j < 8; ++j) { const f32x4 gg = *(const f32x4*)(gam + 4 * (lane + 64 * j)), bb = *(const f32x4*)(bet + 4 * (lane + 64 * j));
            const f32x4 o0 = v[0][j] * rstd0 * gg + bb, o1 = v[1][j] * rstd1 * gg + bb;
            if (dstf) { *((f32x4*)(dstf + (size_t)row0 * DM) + lane + 64 * j) = o0; if (it >= 0) *((f32x4*)(dstf + (size_t)row1 * DM) + lane + 64 * j) = o1; }
            if (dstb) { v2u w; w.x = pk2(o0[0], o0[1]); w.y = pk2(o0[2], o0[3]); *((v2u*)(dstb + (size_t)row0 * DM) + lane + 64 * j) = w;
                if (it >= 0) { v2u w1; w1.x = pk2(o1[0], o1[1]); w1.y = pk2(o1[2], o1[3]); *((v2u*)(dstb + (size_t)row1 * DM) + lane + 64 * j) = w1; } } }
    }
}

__device__ __forceinline__ void attn_prompt_unit(Frame& F, int b, int h, int qt) {
    const bf16* Qb = (const bf16*)(F.ws + WS_QB); const bf16* Kb = (const bf16*)(F.ws + WS_KB); const bf16* VT = (const bf16*)(F.ws + WS_VTB);
    bf16* Ob = (bf16*)(F.ws + WS_OB);
    const int lane = F.lane, fr = lane & 15, fq = lane >> 4, tid = F.tid;
    const int m = b * 2048 + qt * 128 + 16 * F.wave + fr;
    constexpr int BUFB = 33792;
    v4u stg[4];
#define AT_GLOAD(ch) do { _Pragma("unroll") for (int i_ = 0; i_ < 4; ++i_) { const int seg_ = i_ * 512 + tid; \
        if ((ch) < 8) { const int r_ = seg_ >> 6, sg_ = seg_ & 63; stg[i_] = *(const v4u*)(Kb + (size_t)(b * NMEM + 32 * (ch) + r_) * DM + h * 512 + sg_ * 8); } \
        else { const int r_ = seg_ >> 5, sg_ = seg_ & 31; stg[i_] = *(const v4u*)(VT + (size_t)(h * 512 + 64 * ((ch) - 8) + r_) * 1024 + b * NMEM + sg_ * 8); } } } while (0)
#define AT_LSTORE(ch) do { LAS unsigned char* d_ = F.lds + ((ch) & 1) * BUFB; _Pragma("unroll") for (int i_ = 0; i_ < 4; ++i_) { const int seg_ = i_ * 512 + tid; \
        if ((ch) < 8) { const int r_ = seg_ >> 6, sg_ = seg_ & 63; *(LAS v4u*)(d_ + r_ * 1040 + sg_ * 16) = stg[i_]; } \
        else { const int r_ = seg_ >> 5, sg_ = seg_ & 31; *(LAS v4u*)(d_ + r_ * 528 + sg_ * 16) = stg[i_]; } } } while (0)
    AT_GLOAD(0);
    bf16x8 Qf[16];
#pragma unroll
    for (int kc = 0; kc < 16; ++kc) Qf[kc] = *(const bf16x8*)(Qb + (size_t)m * DM + h * 512 + 32 * kc + 8 * fq);
    AT_LSTORE(0); __syncthreads();
    f32x4 s[8][2]; bf16x8 Pf[8];
#pragma unroll
    for (int ch = 0; ch < 16; ++ch) {
        if (ch + 1 < 16) AT_GLOAD(ch + 1);
        const LAS unsigned char* cb = F.lds + (ch & 1) * BUFB;
        if (ch < 8) {
#pragma unroll
            for (int sb = 0; sb < 2; ++sb) { const LAS unsigned char* krow = cb + (8 * (fr >> 2) + 4 * sb + (fr & 3)) * 1040 + 16 * fq; f32x4 acc = (f32x4){0.f, 0.f, 0.f, 0.f};
#pragma unroll
                for (int kc = 0; kc < 16; ++kc) acc = MFMA16(*(const LAS bf16x8*)(krow + 64 * kc), Qf[kc], acc);
                s[ch & 7][sb] = acc; }
            if (ch == 7) {
                float mx = -3.0e38f;
#pragma unroll
                for (int c = 0; c < 8; ++c)
#pragma unroll
                    for (int sb = 0; sb < 2; ++sb)
#pragma unroll
                        for (int j = 0; j < 4; ++j) mx = fmaxf(mx, s[c][sb][j]);
                mx = fmaxf(mx, __shfl_xor(mx, 16)); mx = fmaxf(mx, __shfl_xor(mx, 32));
                const float sc2 = 0.044194173824159216f * 1.4426950408889634f;
                float sum = 0.f;
#pragma unroll
                for (int c = 0; c < 8; ++c)
#pragma unroll
                    for (int sb = 0; sb < 2; ++sb)
#pragma unroll
                        for (int j = 0; j < 4; ++j) { const float p = exp2f((s[c][sb][j] - mx) * sc2); s[c][sb][j] = p; sum += p; }
                sum += __shfl_xor(sum, 16); sum += __shfl_xor(sum, 32);
                const float inv = 1.0f / sum;
#pragma unroll
                for (int c = 0; c < 8; ++c) Pf[c] = pack_bf8(s[c][0] * inv, s[c][1] * inv);
            }
        } else {
#pragma unroll
            for (int dl = 0; dl < 4; ++dl) { const LAS unsigned char* vrow = cb + (16 * dl + fr) * 528 + 16 * fq; f32x4 acc = (f32x4){0.f, 0.f, 0.f, 0.f};
#pragma unroll
                for (int c = 0; c < 8; ++c) acc = MFMA16(*(const LAS bf16x8*)(vrow + 64 * c), Pf[c], acc);
                v2u w; w.x = pk2(acc[0], acc[1]); w.y = pk2(acc[2], acc[3]);
                *(v2u*)(Ob + (size_t)m * DM + h * 512 + 64 * (ch - 8) + 16 * dl + 4 * fq) = w; }
        }
        if (ch + 1 < 16) AT_LSTORE(ch + 1);
        __syncthreads();
    }
#undef AT_GLOAD
#undef AT_LSTORE
}
__device__ __forceinline__ void attn_sample_unit(Frame& F, int b, int h) {
    bf16* Ob = (bf16*)(F.ws + WS_OB);
    const float* CK = F.in[7]; const float* CV = F.in[8];
    const int lane = F.lane, fr = lane & 15, fq = lane >> 4, w = F.wave, tid = F.tid;
    LAS float* Pw = (LAS float*)F.lds + w * 128;
    LAS float* ML = (LAS float*)(F.lds + 4096);
    LAS float* red = (LAS float*)(F.lds + 8192);
    LAS bf16* qs = (LAS bf16*)(F.lds + 73728);
    { const float* PART = (const float*)(F.ws + WS_PART); const int q = tid >> 7, d4 = (tid & 127) * 4; f32x4 o = (f32x4){0.f, 0.f, 0.f, 0.f};
#pragma unroll 4
      for (int ks = 0; ks < 16; ++ks) o += *(const f32x4*)(PART + ((size_t)ks * 512 + 4 * b + q) * DM + h * 512 + d4);
      v2u pw; pw.x = pk2(o[0], o[1]); pw.y = pk2(o[2], o[3]); *(LAS v2u*)(qs + q * 512 + d4) = pw; }
    __syncthreads();
    bf16x8 Qf[16];
#pragma unroll
    for (int kc = 0; kc < 16; ++kc) { const bf16x8 z = {0, 0, 0, 0, 0, 0, 0, 0};
        Qf[kc] = fr < 4 ? *(const LAS bf16x8*)(qs + fr * 512 + 32 * kc + 8 * fq) : z; }
    f32x4 sc[2];
#pragma unroll
    for (int tl = 0; tl < 2; ++tl) { const int mem = 32 * w + 16 * tl + fr; const float* krow = CK + (size_t)(b * NMEM + mem) * DM + h * 512 + 8 * fq; f32x4 acc = (f32x4){0.f, 0.f, 0.f, 0.f};
#pragma unroll
        for (int kc = 0; kc < 16; ++kc) acc = MFMA16(pack_bf8(*(const f32x4*)(krow + 32 * kc), *(const f32x4*)(krow + 32 * kc + 4)), Qf[kc], acc);
        sc[tl] = acc * 0.044194173824159216f; }
    float mx = fmaxf(fmaxf(fmaxf(sc[0][0], sc[0][1]), fmaxf(sc[0][2], sc[0][3])), fmaxf(fmaxf(sc[1][0], sc[1][1]), fmaxf(sc[1][2], sc[1][3])));
    mx = fmaxf(mx, __shfl_xor(mx, 16)); mx = fmaxf(mx, __shfl_xor(mx, 32));
    float ls = 0.f;
#pragma unroll
    for (int tl = 0; tl < 2; ++tl)
#pragma unroll
        for (int j = 0; j < 4; ++j) { const float p = __expf(sc[tl][j] - mx); sc[tl][j] = p; ls += p; }
    ls += __shfl_xor(ls, 16); ls += __shfl_xor(ls, 32);
    if (fr < 4) {
#pragma unroll
        for (int tl = 0; tl < 2; ++tl)
#pragma unroll
            for (int j = 0; j < 4; ++j) Pw[(16 * tl + 4 * fq + j) * 4 + fr] = sc[tl][j];
        if (fq == 0) { ML[(w * 4 + fr) * 2] = mx; ML[(w * 4 + fr) * 2 + 1] = ls; } }
    LDS_WAIT(); asm volatile("" ::: "memory");
    f32x4 a0[4], a1[4];
#pragma unroll
    for (int q = 0; q < 4; ++q) { a0[q] = (f32x4){0.f, 0.f, 0.f, 0.f}; a1[q] = a0[q]; }
#pragma unroll 8
    for (int i = 0; i < 32; ++i) { const int mem = 32 * w + i; const float* vrow = CV + (size_t)(b * NMEM + mem) * DM + h * 512;
        const f32x4 v0 = *(const f32x4*)(vrow + 4 * lane), v1 = *(const f32x4*)(vrow + 256 + 4 * lane); const f32x4 p4 = *(const LAS f32x4*)(Pw + i * 4);
#pragma unroll
        for (int q = 0; q < 4; ++q) { a0[q] += v0 * p4[q]; a1[q] += v1 * p4[q]; } }
#pragma unroll
    for (int q = 0; q < 4; ++q) { *(LAS f32x4*)(red + (w * 4 + q) * 512 + 4 * lane) = a0[q]; *(LAS f32x4*)(red + (w * 4 + q) * 512 + 256 + 4 * lane) = a1[q]; }
    __syncthreads();
    { const int q = tid >> 7, d4 = (tid & 127) * 4; float M = -3.0e38f;
#pragma unroll
      for (int ww = 0; ww < 8; ++ww) M = fmaxf(M, ML[(ww * 4 + q) * 2]);
      float L = 0.f; f32x4 o = (f32x4){0.f, 0.f, 0.f, 0.f};
#pragma unroll
      for (int ww = 0; ww < 8; ++ww) { const float e = __expf(ML[(ww * 4 + q) * 2] - M); L += ML[(ww * 4 + q) * 2 + 1] * e; o += *(const LAS f32x4*)(red + (ww * 4 + q) * 512 + d4) * e; }
      const float inv = 1.0f / L; o = o * inv;
      v2u pw; pw.x = pk2(o[0], o[1]); pw.y = pk2(o[2], o[3]);
      *(v2u*)(Ob + (size_t)(MP + 4 * b + q) * DM + h * 512 + d4) = pw; }
    __syncthreads();
}
__device__ __forceinline__ void p8_attn(Frame& F) {
#ifndef MK_ATT_SKIP
#define MK_ATT_SKIP 0
#endif
    for (int rp = 0; rp < (MK_REP == 80 ? 2 : 1); ++rp) for (int u = F.bid; u < 512; u += F.G) attn_sample_unit(F, u >> 2, u & 3);
    for (int rp = 0; rp < (MK_REP == 81 ? 2 : 1); ++rp) for (int u = F.bid; u < 256; u += F.G) attn_prompt_unit(F, u >> 6, (u >> 4) & 3, u & 15);
}

#define XB_TMO      128
#define XB_XCNT(j)  (256  + 64 * (j))
#define XB_XSUB(j)  (1280 + 64 * (j))
#define XB_XGEN(j)  (2304 + 64 * (j))
#define XB_TOP      3328
#define XB_TOPGEN   3392
#define XCD_BAR_WORDS 3456
#define XB_SPIN_CAP (1u << 18)

__device__ __forceinline__ unsigned xb_ld(unsigned* p)              { return __hip_atomic_load(p, __ATOMIC_RELAXED, __HIP_MEMORY_SCOPE_AGENT); }
__device__ __forceinline__ unsigned xb_add(unsigned* p, unsigned v) { return __hip_atomic_fetch_add(p, v, __ATOMIC_RELAXED, __HIP_MEMORY_SCOPE_AGENT); }
__device__ __forceinline__ unsigned xb_xcc_id() { return (unsigned)__builtin_amdgcn_s_getreg((3 << 11) | 20) & 0xFu; }
#define XB_SPIN(cond, bar) do { unsigned _sp = 0; while (cond) { __builtin_amdgcn_s_sleep(1); \
    if ((++_sp & 255u) == 0u) { if (xb_ld(&(bar)[XB_TMO])) break; if (_sp > XB_SPIN_CAP) { atomicAdd(&(bar)[XB_TMO], 1u); break; } } } } while (0)

struct XcdBarrier {
    unsigned* bar; unsigned x;
    volatile LAS unsigned* st;
};

__device__ __forceinline__ XcdBarrier xcd_barrier_post(unsigned* bar, volatile LAS unsigned* st) {
    XcdBarrier b; b.bar = bar; b.x = xb_xcc_id(); b.st = st;
    if (threadIdx.x == 0) (void)xb_add(&bar[XB_XCNT(b.x)], 1u);
    return b;
}
__device__ __forceinline__ void xcd_barrier_complete(unsigned* bar, unsigned x, unsigned& nloc, unsigned& nx) {
    const unsigned G = gridDim.x * gridDim.y * gridDim.z;
    unsigned sum, cnt, mine, sp = 0u;
    for (;;) {
        sum = 0u; cnt = 0u; mine = 0u;
#pragma unroll
        for (unsigned j = 0; j < 16; ++j) { const unsigned c = xb_ld(&bar[XB_XCNT(j)]); sum += c; cnt += (c > 0u) ? 1u : 0u; mine = (j == x) ? c : mine; }
        if (sum == G) break;
        __builtin_amdgcn_s_sleep(1);
        if ((++sp & 255u) == 0u) { if (xb_ld(&bar[XB_TMO])) break; if (sp > XB_SPIN_CAP) { atomicAdd(&bar[XB_TMO], 1u); break; } }
    }
    nloc = mine > 0u ? mine : 1u; nx = cnt > 0u ? cnt : 1u;
}

__device__ __forceinline__ void xcd_barrier(const XcdBarrier& b) {
    asm volatile("s_waitcnt vmcnt(0)" ::: "memory");
    __syncthreads();
    if (threadIdx.x == 0) {
        unsigned* bar = b.bar;
        __builtin_amdgcn_s_waitcnt(0);
        unsigned nloc = b.st[0], nx = b.st[1];
        if (nloc == 0u) { xcd_barrier_complete(bar, b.x, nloc, nx); b.st[0] = nloc; b.st[1] = nx; }
        const unsigned old = xb_add(&bar[XB_XSUB(b.x)], 1u);
        const unsigned gen = old / nloc;
        if (old + 1u == (gen + 1u) * nloc) {
            __builtin_amdgcn_fence(__ATOMIC_RELEASE, "agent");
            asm volatile("s_waitcnt vmcnt(0)" ::: "memory");
            const unsigned og = xb_add(&bar[XB_TOP], 1u);
            const unsigned tg = og / nx;
            if (og + 1u == (tg + 1u) * nx) xb_add(&bar[XB_TOPGEN], 1u);
            else XB_SPIN(xb_ld(&bar[XB_TOPGEN]) == tg, bar);
            __builtin_amdgcn_fence(__ATOMIC_ACQUIRE, "agent");
            xb_add(&bar[XB_XGEN(b.x)], 1u);
            asm volatile("s_waitcnt vmcnt(0)" ::: "memory");
        } else {
            XB_SPIN(xb_ld(&bar[XB_XGEN(b.x)]) == gen, bar);
            __builtin_amdgcn_fence(__ATOMIC_ACQUIRE, "agent");
            asm volatile("s_waitcnt vmcnt(0)" ::: "memory");
        }
    }
    __syncthreads();
}

template <bool COOP>
__global__ void __launch_bounds__(NTHR, 2) mk_fwd(Args args) {
    extern __shared__ __attribute__((aligned(16))) unsigned char lds_raw[];
    Frame F;
    F.lds = (LAS unsigned char*)lds_raw; F.MISC = (volatile LAS unsigned*)(F.lds + MISC_OFF);
    F.tid = threadIdx.x; F.lane = F.tid & 63; F.wave = __builtin_amdgcn_readfirstlane(F.tid >> 6); F.G = gridDim.x; F.bid = blockIdx.x;
    F.in = args.in; F.out = args.out; F.ws = args.ws;
    unsigned char* ws = args.ws;
    const int lo = args.lo, hi = args.hi, bid = F.bid, G = F.G;
#define IN(k) (lo <= (k) && (k) < hi)
    XcdBarrier bar; bar.bar = (unsigned*)(ws + WS_CTL) + 4096; bar.x = 0; bar.st = nullptr;
    if (COOP) { if (F.tid < 2) F.MISC[8 + F.tid] = 0u; __syncthreads(); bar = xcd_barrier_post((unsigned*)(ws + WS_CTL) + 4096, F.MISC + 8); }
#define SEAM(k) do { if (COOP) { if (IN(k) && IN((k) + 1)) { if ((k) == 0) cg::this_grid().sync(); else xcd_barrier(bar); } } } while (0)
    using pg8::Gemm; using pg8::StaticOrder; using pg8::gemm_phase;
    bf16* XB = (bf16*)(ws + WS_XB); float* Hh = (float*)(ws + WS_H); float* R = (float*)(ws + WS_R); float* X = (float*)(ws + WS_X); float* PART = (float*)(ws + WS_PART);

    if (IN(0)) for (int rep = 0; rep < (MK_REP == 0 ? 2 : 1); ++rep) { if (rep) xcd_barrier(bar); p0_prologue(F); } SEAM(0);
    if (IN(1)) for (int rep = 0; rep < (MK_REP == 1 ? 2 : 1); ++rep) { if (rep) xcd_barrier(bar);
        { Gemm g{XB, (const bf16*)(ws + WS_WIN), MT, DIN, DM}; StaticOrder S; S.init(MT, DIN, G, bid, DM); pg8::EpiF32 E{Hh, DIN};
          gemm_phase<pg8::EpiF32, StaticOrder, true, true>(F.lds, g, S, E); }
        { Gemm g{(const bf16*)(ws + WS_MB), (const bf16*)(ws + WS_WKV), 1024, 4096, DM}; StaticOrder S; S.init(1024, 4096, G, (bid + G - 66) % G, DM);
          pg8::EpiMemKV E{F.out + O_MK, F.out + O_MV, (bf16*)(ws + WS_KB)};
          gemm_phase<pg8::EpiMemKV, StaticOrder, true, true>(F.lds, g, S, E); }
        { Gemm g{(const bf16*)(ws + WS_WKV) + (size_t)2048 * DM, (const bf16*)(ws + WS_MB), 2048, 1024, DM}; StaticOrder S; S.init(2048, 1024, G, (bid + G - 130) % G, DM);
          pg8::EpiBf16S E{(bf16*)(ws + WS_VTB), 1024, nullptr};
          gemm_phase<pg8::EpiBf16S, StaticOrder, true, true>(F.lds, g, S, E); }
    } SEAM(1);
    if (IN(2)) for (int rep = 0; rep < (MK_REP == 2 ? 2 : 1); ++rep) { if (rep) xcd_barrier(bar); p2_prep(F); } SEAM(2);
    if (IN(3)) for (int rep = 0; rep < (MK_REP == 3 ? 2 : 1); ++rep) { if (rep) xcd_barrier(bar); p3_scans(F, rep); } SEAM(3);
    if (IN(4)) for (int rep = 0; rep < (MK_REP == 4 ? 2 : 1); ++rep) { if (rep) xcd_barrier(bar);
        { Gemm g{(const bf16*)(ws + WS_YGB), (const bf16*)(ws + WS_WGLU), MT, DSSM, DSSM}; StaticOrder S; S.init(MT, DSSM, G, bid, DSSM);
          pg8::EpiGlu E{(const bf16*)(ws + WS_YGB), 1024, F.in[19], (bf16*)(ws + WS_MIX), 2048};
          gemm_phase<pg8::EpiGlu, StaticOrder, true, true>(F.lds, g, S, E); }
        p4_post(F, rep);
    } SEAM(4);
    if (IN(5)) for (int rep = 0; rep < (MK_REP == 5 ? 2 : 1); ++rep) { if (rep) xcd_barrier(bar); Gemm g{(const bf16*)(ws + WS_MIX), (const bf16*)(ws + WS_WOUT), MT, DM, DM}; pg8::MixOrder S; S.init(MP, DM, G, bid, DM, 16, 128);
        pg8::EpiRes E{F.in[0], F.in[1], R, DM, ALPHA, PART};
        gemm_phase<pg8::EpiRes, pg8::MixOrder, true, true>(F.lds, g, S, E); } SEAM(5);
    if (IN(6)) for (int rep = 0; rep < (MK_REP == 6 ? 2 : 1); ++rep) { if (rep) xcd_barrier(bar); ln_rows(F, R, F.in[32], F.in[33], X, XB, F.in[1], PART, 16); } SEAM(6);
    if (IN(7)) for (int rep = 0; rep < (MK_REP == 7 ? 2 : 1); ++rep) { if (rep) xcd_barrier(bar); Gemm g{XB, (const bf16*)(ws + WS_WQ), MT, DM, DM}; pg8::MixOrder S; S.init(MP, DM, G, bid, DM, 16, 128);
        pg8::EpiBf16S E{(bf16*)(ws + WS_QB), DM, PART};
        gemm_phase<pg8::EpiBf16S, pg8::MixOrder, true, true>(F.lds, g, S, E); } SEAM(7);
    if (IN(8)) for (int rep = 0; rep < (MK_REP == 8 ? 2 : 1); ++rep) { if (rep) xcd_barrier(bar); p8_attn(F); } SEAM(8);
    if (IN(9)) for (int rep = 0; rep < (MK_REP == 9 ? 2 : 1); ++rep) { if (rep) xcd_barrier(bar); Gemm g{(const bf16*)(ws + WS_OB), (const bf16*)(ws + WS_WO), MT, DM, DM}; pg8::MixOrder S; S.init(MP, DM, G, bid, DM, 16, 128);
        pg8::EpiRes E{X, X + (size_t)MP * DM, R, DM, ALPHA, PART};
        gemm_phase<pg8::EpiRes, pg8::MixOrder, true, true>(F.lds, g, S, E); } SEAM(9);
    if (IN(10)) for (int rep = 0; rep < (MK_REP == 10 ? 2 : 1); ++rep) { if (rep) xcd_barrier(bar); ln_rows(F, R, F.in[38], F.in[39], X, XB, X + (size_t)MP * DM, PART, 16); } SEAM(10);
    if (IN(11)) for (int rep = 0; rep < (MK_REP == 11 ? 2 : 1); ++rep) { if (rep) xcd_barrier(bar); Gemm g{XB, (const bf16*)(ws + WS_WGU), MT, 2 * DFF, DM}; StaticOrder S; S.init(MT, 2 * DFF, G, bid, DM);
        pg8::EpiSwiGLU E{(bf16*)(ws + WS_HFF), DFF};
        gemm_phase<pg8::EpiSwiGLU, StaticOrder, true, true>(F.lds, g, S, E); } SEAM(11);
    if (IN(12)) for (int rep = 0; rep < (MK_REP == 12 ? 2 : 1); ++rep) { if (rep) xcd_barrier(bar); Gemm g{(const bf16*)(ws + WS_HFF), (const bf16*)(ws + WS_WDN), MT, DM, DFF}; pg8::MixOrder S; S.init(MP, DM, G, bid, DFF, 11, 512);
        pg8::EpiRes E{X, X + (size_t)MP * DM, R, DM, ALPHA, PART};
        gemm_phase<pg8::EpiRes, pg8::MixOrder, true, true>(F.lds, g, S, E); } SEAM(12);
    if (IN(13)) for (int rep = 0; rep < (MK_REP == 13 ? 2 : 1); ++rep) { if (rep) xcd_barrier(bar); ln_rows(F, R, F.in[43], F.in[44], F.out + O_Y, nullptr, X + (size_t)MP * DM, PART, 11); }
#undef IN
#undef SEAM
}

#ifndef MK_COOP
#define MK_COOP 0
#endif
#ifndef MK_PH_HI
#define MK_PH_HI NPHASE
#endif
extern "C" void kernel_launch(void* const* d_in, const int* in_sizes, int n_in, void* d_out, int out_size, void* d_ws, size_t ws_size, hipStream_t stream) {
    static int grid = 0;
    if (grid == 0) {
        if (n_in != 45 || out_size != (int)O_END || ws_size < WS_END) { fprintf(stderr, "kernel_launch: unexpected shapes (n_in %d out %d ws %zu)\n", n_in, out_size, ws_size); grid = -1; return; }
        int dev = 0, cus = 0, per_cu = 0;
        (void)hipGetDevice(&dev); (void)hipDeviceGetAttribute(&cus, hipDeviceAttributeMultiprocessorCount, dev);
        (void)hipFuncSetAttribute((const void*)mk_fwd<(MK_COOP != 0)>, hipFuncAttributeMaxDynamicSharedMemorySize, LDS_BYTES);
        (void)hipOccupancyMaxActiveBlocksPerMultiprocessor(&per_cu, (const void*)mk_fwd<(MK_COOP != 0)>, NTHR, LDS_BYTES);
        (void)hipGetLastError();
        if (per_cu < 1) { fprintf(stderr, "kernel_launch: occupancy query says %d blocks per CU\n", per_cu); per_cu = 1; }
        grid = cus;
    }
    if (grid < 0) return;
    (void)hipMemsetAsync((char*)d_ws + WS_CTL, 0, 65536, stream);
    if (MK_PH_HI < NPHASE) (void)hipMemsetAsync(d_out, 0, (size_t)out_size * 4, stream);
#ifdef MK_DUMP_OFF
#ifndef MK_DUMP_BYTES
#define MK_DUMP_BYTES ((size_t)MT * DM * 4)
#endif
#define MK_DUMP_AFTER (void)hipMemcpyAsync(d_out, (char*)d_ws + (MK_DUMP_OFF), MK_DUMP_BYTES, hipMemcpyDeviceToDevice, stream);
#else
#define MK_DUMP_AFTER
#endif
    Args a{};
    for (int i = 0; i < 45; ++i) a.in[i] = (const float*)d_in[i];
    a.out = (float*)d_out; a.ws = (unsigned char*)d_ws;
#if MK_COOP
    a.lo = 0; a.hi = MK_PH_HI;
    void* kargs[] = {&a};
    hipError_t e = hipLaunchCooperativeKernel((const void*)mk_fwd<true>, dim3(grid), dim3(NTHR), kargs, LDS_BYTES, stream);
    if (e != hipSuccess) fprintf(stderr, "cooperative launch failed: %s (grid %d)\n", hipGetErrorString(e), grid);
#else
    for (int p = 0; p < MK_PH_HI; ++p) { a.lo = p; a.hi = p + 1; hipLaunchKernelGGL(mk_fwd<false>, dim3(grid), dim3(NTHR), LDS_BYTES, stream, a); }
#endif
    MK_DUMP_AFTER
}
```

```cpp
#include <hip/hip_runtime.h>
#include <hip/hip_cooperative_groups.h>
#include <cstdio>
#include <cstdint>
namespace cg = cooperative_groups;
#define MK_COOP 1
namespace pg8 {
#define PG8_LAS __attribute__((address_space(3)))
typedef unsigned short bf16_t;
typedef short bf16x8 __attribute__((ext_vector_type(8)));
typedef float f32x4 __attribute__((ext_vector_type(4)));
typedef unsigned u32x4 __attribute__((ext_vector_type(4)));
constexpr int BM = 256, BK = 64, HALF = 128, HTB = HALF * BK * 2  , STAGE_BYTES = 8 * HTB, NXCD = 8, WGM = 8;

__host__ __device__ __forceinline__ int lds_byte(int r, int c) { const int st = (r >> 4) * 2 + (c >> 5), rr = r & 15, cc = c & 31, ob = rr * 64 + cc * 2; return st * 1024 + (ob ^ (((ob >> 9) & 1) << 5)); }
__host__ __device__ __forceinline__ void stage_rc(int b, int& R, int& C) { const int st = b / 1024, sb = b % 1024, swz = sb ^ (((sb >> 9) & 1) << 5); R = (st >> 1) * 16 + swz / 64; C = (st & 1) * 32 + (swz % 64) / 2; }
__host__ __device__ __forceinline__ int perm32(int rho) { const int n = rho >> 4, i = rho & 15; return 8 * (i >> 2) + 4 * n + (i & 3); }

struct Unit { int pm, pn, koff, nt, ks; };
struct Gemm { const bf16_t* A; const bf16_t* Bt; int M, N, K; };

struct StaticOrder {
    int nM, nN, nwg, G, c, ntk;
    __host__ __device__ void init(int M, int N, int G_, int c_, int K_) { nM = M / BM; nN = N / BM; nwg = nM * nN; G = G_; c = c_; ntk = K_ / BK; }
    __host__ __device__ bool next(int i, Unit& u) const {
        const long L = (long)i * G + c; if (L >= nwg) return false;
        int wgid = (int)L; { const int q = nwg / NXCD, r = nwg % NXCD, xcd = wgid % NXCD, off = wgid / NXCD; wgid = (xcd < r ? xcd * (q + 1) : r * (q + 1) + (xcd - r) * q) + off; }
        const int nig = WGM * nN, gid = wgid / nig, fm = gid * WGM, gsz = (nM - fm) < WGM ? (nM - fm) : WGM;
        u.pm = fm + ((wgid % nig) % gsz); u.pn = (wgid % nig) / gsz; u.koff = 0; u.nt = ntk; u.ks = -1; return true;
    }
    __device__ __forceinline__ void a_ready(const Unit&) const {}
    __device__ __forceinline__ void done(const Unit&) const {}
};
struct MixOrder {
    StaticOrder so; int c, nsplit, ksz, nN, pm0;
    __host__ __device__ void init(int M0, int N, int G_, int c_, int K_, int nsplit_, int ksz_) { so.init(M0, N, G_, c_, K_); c = c_; nsplit = nsplit_; ksz = ksz_; nN = N / BM; pm0 = M0 / BM; }
    __host__ __device__ bool next(int i, Unit& u) const {
        if (i == 0) return so.next(0, u);
        if (i == 1) { const int per = 2 * nN; if (c >= nsplit * per) return false; const int tile = c % per, ks = c / per;
            u.pm = pm0 + tile / nN; u.pn = tile % nN; u.koff = ks * ksz; u.nt = ksz / BK; u.ks = ks; return true; }
        return false;
    }
    __device__ __forceinline__ void a_ready(const Unit&) const {}
    __device__ __forceinline__ void done(const Unit&) const {}
};
typedef float f32x2_cv __attribute__((ext_vector_type(2))); typedef __bf16 bf16x2_cv __attribute__((ext_vector_type(2)));
__device__ __forceinline__ unsigned cvt_pk_bf16(float lo, float hi) { const f32x2_cv v = {lo, hi}; const bf16x2_cv b = __builtin_convertvector(v, bf16x2_cv); return __builtin_bit_cast(unsigned, b); }

__device__ __forceinline__ float bf_lo(unsigned w) { return __builtin_bit_cast(float, w << 16); }
__device__ __forceinline__ float bf_hi(unsigned w) { return __builtin_bit_cast(float, w & 0xffff0000u); }
__device__ __forceinline__ u32x4 pack8(const f32x4 a, const f32x4 b) { u32x4 w; w.x = cvt_pk_bf16(a[0], a[1]); w.y = cvt_pk_bf16(a[2], a[3]); w.z = cvt_pk_bf16(b[0], b[1]); w.w = cvt_pk_bf16(b[2], b[3]); return w; }
__device__ __forceinline__ float sigmoidf_(float x) { return __builtin_amdgcn_rcpf(1.0f + __expf(-x)); }

struct EpiF32 {
    static constexpr bool PERM = true, AFTER_DRAIN = false;
    float* O; int ldc;
    __device__ __forceinline__ void operator()(const f32x4 (&acc)[2][2][4][2], const Unit& u, int wr, int wc, int fr, int fq) const {
        const int row0 = u.pm * BM + wr * 64 + fr, col0 = u.pn * BM + wc * 32 + 8 * fq;
#pragma unroll
        for (int ai = 0; ai < 2; ++ai)
#pragma unroll
            for (int m = 0; m < 4; ++m) { float* rowp = O + (size_t)(row0 + ai * HALF + m * 16) * ldc + col0;
#pragma unroll
                for (int bj = 0; bj < 2; ++bj) { *(f32x4*)(rowp + bj * HALF) = acc[ai][bj][m][0]; *(f32x4*)(rowp + bj * HALF + 4) = acc[ai][bj][m][1]; } }
    }
};
struct EpiMemKV {
    static constexpr bool PERM = true, AFTER_DRAIN = false;
    float* outK; float* outV; bf16_t* Kb;
    __device__ __forceinline__ void operator()(const f32x4 (&acc)[2][2][4][2], const Unit& u, int wr, int wc, int fr, int fq) const {
        const int row0 = u.pm * BM + wr * 64 + fr; const int colt = u.pn * BM; const bool isV = colt >= 2048;
        float* o = isV ? outV : outK; const int col0 = (isV ? colt - 2048 : colt) + wc * 32 + 8 * fq;
#pragma unroll
        for (int ai = 0; ai < 2; ++ai)
#pragma unroll
            for (int m = 0; m < 4; ++m)
#pragma unroll
                for (int bj = 0; bj < 2; ++bj) { const size_t off = (size_t)(row0 + ai * HALF + m * 16) * 2048 + col0 + bj * HALF;
                    __builtin_nontemporal_store(acc[ai][bj][m][0], (f32x4*)(o + off)); __builtin_nontemporal_store(acc[ai][bj][m][1], (f32x4*)(o + off + 4));
                    if (!isV) *(u32x4*)(Kb + off) = pack8(acc[ai][bj][m][0], acc[ai][bj][m][1]); }
    }
};
struct EpiBf16S {
    static constexpr bool PERM = true, AFTER_DRAIN = false;
    bf16_t* O; int ldc; float* part;
    __device__ __forceinline__ void operator()(const f32x4 (&acc)[2][2][4][2], const Unit& u, int wr, int wc, int fr, int fq) const {
        const int row0 = u.pm * BM + wr * 64 + fr, col0 = u.pn * BM + wc * 32 + 8 * fq;
        if (u.ks >= 0) {
#pragma unroll
            for (int ai = 0; ai < 2; ++ai)
#pragma unroll
                for (int m = 0; m < 4; ++m) { float* rowp = part + ((size_t)u.ks * 512 + (row0 + ai * HALF + m * 16 - 8192)) * ldc + col0;
#pragma unroll
                    for (int bj = 0; bj < 2; ++bj) { *(f32x4*)(rowp + bj * HALF) = acc[ai][bj][m][0]; *(f32x4*)(rowp + bj * HALF + 4) = acc[ai][bj][m][1]; } }
            return; }
#pragma unroll
        for (int ai = 0; ai < 2; ++ai)
#pragma unroll
            for (int m = 0; m < 4; ++m) { bf16_t* rowp = O + (size_t)(row0 + ai * HALF + m * 16) * ldc + col0;
#pragma unroll
                for (int bj = 0; bj < 2; ++bj) *(u32x4*)(rowp + bj * HALF) = pack8(acc[ai][bj][m][0], acc[ai][bj][m][1]); }
    }
};
struct EpiGlu {
    static constexpr bool PERM = true, AFTER_DRAIN = false;
    const bf16_t* Y; int ldy; const float* bias; bf16_t* O; int ldo;
    __device__ __forceinline__ void operator()(const f32x4 (&acc)[2][2][4][2], const Unit& u, int wr, int wc, int fr, int fq) const {
        const int row0 = u.pm * BM + wr * 64 + fr, col0 = u.pn * BM + wc * 32 + 8 * fq;
#pragma unroll
        for (int bj = 0; bj < 2; ++bj) { const f32x4 b0 = *(const f32x4*)(bias + col0 + bj * HALF), b1 = *(const f32x4*)(bias + col0 + bj * HALF + 4);
#pragma unroll
            for (int ai = 0; ai < 2; ++ai)
#pragma unroll
                for (int m = 0; m < 4; ++m) { const int row = row0 + ai * HALF + m * 16;
                    const u32x4 yv = *(const u32x4*)(Y + (size_t)row * ldy + col0 + bj * HALF);
                    const f32x4 a0 = acc[ai][bj][m][0] + b0, a1 = acc[ai][bj][m][1] + b1; f32x4 z0, z1;
                    z0[0] = bf_lo(yv.x) * sigmoidf_(a0[0]); z0[1] = bf_hi(yv.x) * sigmoidf_(a0[1]); z0[2] = bf_lo(yv.y) * sigmoidf_(a0[2]); z0[3] = bf_hi(yv.y) * sigmoidf_(a0[3]);
                    z1[0] = bf_lo(yv.z) * sigmoidf_(a1[0]); z1[1] = bf_hi(yv.z) * sigmoidf_(a1[1]); z1[2] = bf_lo(yv.w) * sigmoidf_(a1[2]); z1[3] = bf_hi(yv.w) * sigmoidf_(a1[3]);
                    *(u32x4*)(O + (size_t)row * ldo + col0 + bj * HALF) = pack8(z0, z1); } }
    }
};
struct EpiRes {
    static constexpr bool PERM = true, AFTER_DRAIN = false;
    const float* base0; const float* base1; const bf16_t* bbase; bf16_t* O; int ld; float alpha; float* part;
    __device__ __forceinline__ void operator()(const f32x4 (&acc)[2][2][4][2], const Unit& u, int wr, int wc, int fr, int fq) const {
        const int row0 = u.pm * BM + wr * 64 + fr, col0 = u.pn * BM + wc * 32 + 8 * fq;
        if (u.ks >= 0) {
#pragma unroll
            for (int ai = 0; ai < 2; ++ai)
#pragma unroll
                for (int m = 0; m < 4; ++m) { float* rowp = part + ((size_t)u.ks * 512 + (row0 + ai * HALF + m * 16 - 8192)) * ld + col0;
#pragma unroll
                    for (int bj = 0; bj < 2; ++bj) { *(f32x4*)(rowp + bj * HALF) = acc[ai][bj][m][0]; *(f32x4*)(rowp + bj * HALF + 4) = acc[ai][bj][m][1]; } }
            return; }
        const bool lo = (u.pm * BM) < 8192; const float* bp = lo ? base0 : base1; const int rsub = lo ? 0 : 8192;
#pragma unroll
        for (int ai = 0; ai < 2; ++ai)
#pragma unroll
            for (int m = 0; m < 4; ++m) { const int row = row0 + ai * HALF + m * 16; bf16_t* orow = O + (size_t)row * ld + col0;
#pragma unroll
                for (int bj = 0; bj < 2; ++bj) { f32x4 x0, x1;
                    if (bbase) { const u32x4 bv = *(const u32x4*)(bbase + (size_t)row * ld + col0 + bj * HALF);
                        x0 = (f32x4){bf_lo(bv.x), bf_hi(bv.x), bf_lo(bv.y), bf_hi(bv.y)}; x1 = (f32x4){bf_lo(bv.z), bf_hi(bv.z), bf_lo(bv.w), bf_hi(bv.w)}; }
                    else { const float* brow = bp + (size_t)(row - rsub) * ld + col0 + bj * HALF; x0 = __builtin_nontemporal_load((const f32x4*)brow); x1 = __builtin_nontemporal_load((const f32x4*)(brow + 4)); }
                    *(u32x4*)(orow + bj * HALF) = pack8(x0 * alpha + acc[ai][bj][m][0], x1 * alpha + acc[ai][bj][m][1]); } }
    }
};
struct EpiSwiGLU {
    static constexpr bool PERM = true, AFTER_DRAIN = false;
    bf16_t* O; int ldo;
    __device__ __forceinline__ void operator()(const f32x4 (&acc)[2][2][4][2], const Unit& u, int wr, int wc, int fr, int fq) const {
        const int row0 = u.pm * BM + wr * 64 + fr, col0 = u.pn * HALF + wc * 32 + 8 * fq;
#pragma unroll
        for (int ai = 0; ai < 2; ++ai)
#pragma unroll
            for (int m = 0; m < 4; ++m) { f32x4 h0, h1;
#pragma unroll
                for (int j = 0; j < 4; ++j) { const float g0 = acc[ai][0][m][0][j], g1 = acc[ai][0][m][1][j];
                    h0[j] = g0 * sigmoidf_(g0) * acc[ai][1][m][0][j]; h1[j] = g1 * sigmoidf_(g1) * acc[ai][1][m][1][j]; }
                *(u32x4*)(O + (size_t)(row0 + ai * HALF + m * 16) * ldo + col0) = pack8(h0, h1); }
    }
};

template <class Epi, class Sched, bool ALIGN_EPI = false, bool SP2 = false>
__device__ __forceinline__ void gemm_phase(PG8_LAS unsigned char* lds, const Gemm g, const Sched& S, const Epi& E) {
    const int tid = threadIdx.x, wid = __builtin_amdgcn_readfirstlane(tid >> 6), lane = tid & 63, wr = wid >> 2, wc = wid & 3, fr = lane & 15, fq = lane >> 4;
    const int K = g.K;
    unsigned voffA[2], voffB[2];
#pragma unroll
    for (int i = 0; i < 2; ++i) { int R, C; stage_rc(tid * 16 + i * 8192, R, C); const int Rb = Epi::PERM ? ((R & ~31) + perm32(R & 31)) : R;
        voffA[i] = (unsigned)(R * K + C) * 2u; voffB[i] = (unsigned)(Rb * K + C) * 2u; }
    const size_t kstep = (size_t)(BK * 2);
    const size_t hstep = (size_t)HALF * K * 2;
    const size_t tstep = 2 * hstep;
    const unsigned ldsw = (unsigned)wid * 1024u;
    const int aoff = lds_byte(wr * 64 + fr, fq * 8), boff = lds_byte(wc * 32 + fr, fq * 8);
#define PG8_SA(b, h) (((b) * 2 + (h)) * HTB)
#define PG8_SB(b, h) ((4 + (b) * 2 + (h)) * HTB)
#define PG8_STAGE(bufoff, gbase, voff) do { _Pragma("unroll") for (int _i = 0; _i < 2; ++_i) \
        __builtin_amdgcn_global_load_lds((const unsigned*)((const char*)(gbase) + (voff)[_i]), (PG8_LAS unsigned*)(lds + (bufoff) + ldsw + _i * 8192), 16, 0, 0); } while (0)
#define PG8_LDA(dst, b, h) do { _Pragma("unroll") for (int m = 0; m < 4; ++m) _Pragma("unroll") for (int k = 0; k < 2; ++k) dst[m][k] = *(const PG8_LAS bf16x8*)(lds + PG8_SA(b, h) + aoff + m * 2048 + k * 1024); } while (0)
#define PG8_LDB(dst, b, h) do { _Pragma("unroll") for (int n = 0; n < 2; ++n) _Pragma("unroll") for (int k = 0; k < 2; ++k) dst[n][k] = *(const PG8_LAS bf16x8*)(lds + PG8_SB(b, h) + boff + n * 2048 + k * 1024); } while (0)
#define PG8_MMA(ai, bj, At, Bt) do { __builtin_amdgcn_s_setprio(1); _Pragma("unroll") for (int m = 0; m < 4; ++m) _Pragma("unroll") for (int n = 0; n < 2; ++n) _Pragma("unroll") for (int k = 0; k < 2; ++k) \
        acc[ai][bj][m][n] = __builtin_amdgcn_mfma_f32_16x16x32_bf16(Bt[n][k], At[m][k], acc[ai][bj][m][n], 0, 0, 0); __builtin_amdgcn_s_setprio(0); } while (0)
#define PG8_WAIT_V(n) asm volatile("s_waitcnt vmcnt(" #n ")" ::: "memory")
#define PG8_WAIT_L(n) asm volatile("s_waitcnt lgkmcnt(" #n ")" ::: "memory")
#define PG8_BAR __builtin_amdgcn_s_barrier()
#define PG8_SCHED __builtin_amdgcn_sched_barrier(0)
    Unit cur, nxt; int ui = 0;
    if (!S.next(0, cur)) return;
    f32x4 acc[2][2][4][2];
#pragma unroll
    for (int a = 0; a < 2; ++a)
#pragma unroll
        for (int b = 0; b < 2; ++b)
#pragma unroll
            for (int m = 0; m < 4; ++m)
#pragma unroll
                for (int n = 0; n < 2; ++n) acc[a][b][m][n] = (f32x4){0.f, 0.f, 0.f, 0.f};
    bf16x8 At[4][2], B0[2][2], B1[2][2];
    const char* cA = (const char*)g.A + (size_t)cur.pm * tstep + (size_t)cur.koff * 2; const char* cB = (const char*)g.Bt + (size_t)cur.pn * tstep + (size_t)cur.koff * 2;
    S.a_ready(cur);
    if constexpr (SP2) {
        PG8_STAGE(PG8_SB(0, 0), cB, voffB); PG8_STAGE(PG8_SB(0, 1), cB + hstep, voffB); PG8_STAGE(PG8_SA(0, 0), cA, voffA); PG8_STAGE(PG8_SA(0, 1), cA + hstep, voffA);
        if (wr == 1) PG8_BAR;
        PG8_WAIT_V(2); PG8_BAR;
        PG8_STAGE(PG8_SB(1, 0), cB + kstep, voffB); PG8_STAGE(PG8_SA(1, 0), cA + kstep, voffA); PG8_STAGE(PG8_SB(1, 1), cB + hstep + kstep, voffB);
        PG8_WAIT_V(6); PG8_BAR;
    } else {
        PG8_STAGE(PG8_SB(0, 0), cB, voffB); PG8_STAGE(PG8_SA(0, 0), cA, voffA); PG8_STAGE(PG8_SB(0, 1), cB + hstep, voffB); PG8_STAGE(PG8_SA(0, 1), cA + hstep, voffA);
        if (wr == 1) PG8_BAR;
        PG8_WAIT_V(4); PG8_BAR;
        PG8_STAGE(PG8_SB(1, 0), cB + kstep, voffB); PG8_STAGE(PG8_SA(1, 0), cA + kstep, voffA); PG8_STAGE(PG8_SB(1, 1), cB + hstep + kstep, voffB);
        PG8_WAIT_V(6); PG8_BAR;
    }
    for (;;) {
        const bool has_next = S.next(ui + 1, nxt);
        const char* nA = has_next ? (const char*)g.A + (size_t)nxt.pm * tstep + (size_t)nxt.koff * 2 : cA; const char* nB = has_next ? (const char*)g.Bt + (size_t)nxt.pn * tstep + (size_t)nxt.koff * 2 : cB;
        const int nt = cur.nt;
        for (int t = 0; t < nt; t += 2) {
            const bool last = (t == nt - 2);
            const char* a1 = cA + (size_t)(t + 1) * kstep;
            const char* a2 = last ? nA : cA + (size_t)(t + 2) * kstep; const char* b2 = last ? nB : cB + (size_t)(t + 2) * kstep;
            const char* a3 = a2 + kstep; const char* b3 = b2 + kstep;
            if (last && has_next) S.a_ready(nxt);
            if constexpr (SP2) {
            PG8_LDB(B0, 0, 0); PG8_LDB(B1, 0, 1); PG8_SCHED; PG8_LDA(At, 0, 0); PG8_STAGE(PG8_SA(1, 1), a1 + hstep, voffA);
            PG8_WAIT_V(8); PG8_WAIT_L(0); PG8_BAR; PG8_MMA(0, 0, At, B0); PG8_MMA(0, 1, At, B1); PG8_BAR; PG8_SCHED;
            PG8_LDA(At, 0, 1); PG8_STAGE(PG8_SB(0, 0), b2, voffB); PG8_STAGE(PG8_SB(0, 1), b2 + hstep, voffB); PG8_STAGE(PG8_SA(0, 0), a2, voffA);
            PG8_WAIT_V(8); PG8_WAIT_L(0); PG8_BAR; PG8_MMA(1, 0, At, B0); PG8_MMA(1, 1, At, B1); PG8_BAR; PG8_SCHED;
            PG8_LDB(B0, 1, 0); PG8_LDB(B1, 1, 1); PG8_SCHED; PG8_LDA(At, 1, 0); PG8_STAGE(PG8_SA(0, 1), a2 + hstep, voffA);
            PG8_WAIT_V(8); PG8_WAIT_L(0); PG8_BAR; PG8_MMA(0, 0, At, B0); PG8_MMA(0, 1, At, B1); PG8_BAR; PG8_SCHED;
            PG8_LDA(At, 1, 1); PG8_STAGE(PG8_SB(1, 0), b3, voffB); PG8_STAGE(PG8_SB(1, 1), b3 + hstep, voffB); PG8_STAGE(PG8_SA(1, 0), a3, voffA);
            PG8_WAIT_V(8); PG8_WAIT_L(0); PG8_BAR; PG8_MMA(1, 0, At, B0); PG8_MMA(1, 1, At, B1); PG8_BAR; PG8_SCHED;
            } else {
            PG8_LDB(B0, 0, 0); PG8_SCHED; PG8_LDA(At, 0, 0); PG8_STAGE(PG8_SA(1, 1), a1 + hstep, voffA);
            PG8_WAIT_L(8); PG8_BAR; PG8_WAIT_L(0); PG8_MMA(0, 0, At, B0); PG8_BAR; PG8_SCHED;
            PG8_LDB(B1, 0, 1); PG8_STAGE(PG8_SB(0, 0), b2, voffB);
            PG8_BAR; PG8_WAIT_L(0); PG8_MMA(0, 1, At, B1); PG8_BAR;
            PG8_LDA(At, 0, 1); PG8_STAGE(PG8_SA(0, 0), a2, voffA);
            PG8_BAR; PG8_WAIT_L(0); PG8_MMA(1, 0, At, B0); PG8_BAR; PG8_SCHED;
            PG8_STAGE(PG8_SB(0, 1), b2 + hstep, voffB);
            PG8_WAIT_V(6); PG8_BAR; PG8_MMA(1, 1, At, B1); PG8_BAR;
            PG8_LDB(B0, 1, 0); PG8_SCHED; PG8_LDA(At, 1, 0); PG8_STAGE(PG8_SA(0, 1), a2 + hstep, voffA);
            PG8_WAIT_L(8); PG8_BAR; PG8_WAIT_L(0); PG8_MMA(0, 0, At, B0); PG8_BAR; PG8_SCHED;
            PG8_LDB(B1, 1, 1); PG8_STAGE(PG8_SB(1, 0), b3, voffB);
            PG8_BAR; PG8_WAIT_L(0); PG8_MMA(0, 1, At, B1); PG8_BAR;
            PG8_LDA(At, 1, 1); PG8_STAGE(PG8_SA(1, 0), a3, voffA);
            PG8_BAR; PG8_WAIT_L(0); PG8_MMA(1, 0, At, B0); PG8_BAR; PG8_SCHED;
            PG8_STAGE(PG8_SB(1, 1), b3 + hstep, voffB);
            PG8_WAIT_V(6); PG8_BAR; PG8_MMA(1, 1, At, B1); PG8_BAR;
            }
        }
        if constexpr (ALIGN_EPI) { if (wr == 0) PG8_BAR; }
        if constexpr (!Epi::AFTER_DRAIN) { E(acc, cur, wr, wc, fr, fq); S.done(cur); }
        if (!has_next) break;
#pragma unroll
        for (int a = 0; a < 2; ++a)
#pragma unroll
            for (int b = 0; b < 2; ++b)
#pragma unroll
                for (int m = 0; m < 4; ++m)
#pragma unroll
                    for (int n = 0; n < 2; ++n) acc[a][b][m][n] = (f32x4){0.f, 0.f, 0.f, 0.f};
        cur = nxt; cA = nA; cB = nB; ++ui;
        if constexpr (ALIGN_EPI) { if (wr == 1) PG8_BAR; }
    }
    PG8_WAIT_V(0);
    if constexpr (!ALIGN_EPI) { if (wr == 0) PG8_BAR; }
    PG8_BAR;
    if constexpr (Epi::AFTER_DRAIN) { E.fused(acc, cur, wr, wc, fr, fq, lds, wid, lane); S.done(cur); }
#undef PG8_SA
#undef PG8_SB
#undef PG8_STAGE
#undef PG8_LDA
#undef PG8_LDB
#undef PG8_MMA
#undef PG8_WAIT_V
#undef PG8_WAIT_L
#undef PG8_BAR
#undef PG8_SCHED
}
}

#ifndef MK_REP
#define MK_REP -1
#endif
#ifndef MK_TS
#define MK_TS -1
#endif
constexpr int NWAVES = 8, NTHR = 512;
constexpr int MT = 8704, MP = 8192, DM = 2048, DIN = 4352, DSSM = 1024, DRW = 1024, DSH = 3328, DFF = 5632, NMEM = 256;
constexpr float ALPHA = 1.189207115002721f;
constexpr float LN_EPS = 1e-5f, GN_EPS = 64e-5f;
constexpr size_t O_Y = 0, O_SRE_P = (size_t)MT * DM, O_SIM_P = O_SRE_P + 16384, O_WKV_P = O_SIM_P + 16384, O_SH_P = O_WKV_P + 262144, O_MK = O_SH_P + 4 * DSH,
                 O_MV = O_MK + 2097152, O_SRE_S = O_MV + 2097152, O_SIM_S = O_SRE_S + 524288, O_WKV_S = O_SIM_S + 524288, O_SH_S = O_WKV_S + 8388608, O_END = O_SH_S + 128 * DSH;
static_assert(O_END == 32191488, "output size");
constexpr size_t MiB = 1u << 20;
constexpr size_t WS_CTL = 0, WS_WIN = 1 * MiB, WS_WGLU = 18 * MiB, WS_WOUT = 20 * MiB, WS_WQ = 28 * MiB, WS_WKV = 36 * MiB, WS_WO = 52 * MiB, WS_WGU = 60 * MiB, WS_WDN = 104 * MiB,
                 WS_W2T = 126 * MiB, WS_A2T = WS_W2T + 131072, WS_G2T = WS_W2T + 262144, WS_KB = 127 * MiB, WS_VTB = 131 * MiB, WS_XB = 135 * MiB, WS_MB = 169 * MiB,
                 WS_H = 173 * MiB, WS_R = WS_H, WS_X = WS_H + 72 * MiB, WS_PREP = 318 * MiB, WS_BONUS = 706 * MiB, WS_QB = WS_PREP, WS_OB = WS_PREP + 34 * MiB, WS_HFF = WS_PREP + 68 * MiB,
                 WS_YR = 557 * MiB, WS_YGB = 591 * MiB, WS_MIX = 608 * MiB, WS_PART = 642 * MiB, WS_BON4 = 706 * MiB, WS_END = 709 * MiB;
constexpr size_t PREP_STRIDE = 34 * MiB;
constexpr int LDS_BYTES = 135168;
constexpr int MISC_OFF = 131072;
constexpr int NPHASE = 14;

#define LAS __attribute__((address_space(3)))
typedef unsigned short bf16;
typedef unsigned v4u __attribute__((ext_vector_type(4)));
typedef unsigned v2u __attribute__((ext_vector_type(2)));
typedef float f32x4 __attribute__((ext_vector_type(4)));
typedef float f32x2 __attribute__((ext_vector_type(2)));
typedef float f32x16 __attribute__((ext_vector_type(16)));
typedef short bf16x8 __attribute__((ext_vector_type(8)));
#define LDS_WAIT() asm volatile("s_waitcnt lgkmcnt(0)" ::: "memory")

__device__ __forceinline__ unsigned pk2(float lo, float hi) { return pg8::cvt_pk_bf16(lo, hi); }
__device__ __forceinline__ bf16x8 pack_bf8(const f32x4 a, const f32x4 b) { v4u w; w.x = pk2(a[0], a[1]); w.y = pk2(a[2], a[3]); w.z = pk2(b[0], b[1]); w.w = pk2(b[2], b[3]); return __builtin_bit_cast(bf16x8, w); }
__device__ __forceinline__ f32x4 ldbf4(const bf16* p) { const v2u w = *(const v2u*)p; return (f32x4){pg8::bf_lo(w.x), pg8::bf_hi(w.x), pg8::bf_lo(w.y), pg8::bf_hi(w.y)}; }
__device__ __forceinline__ void stnt4(float* p, const f32x4 x) { __builtin_nontemporal_store(x, (f32x4*)p); }
__device__ __forceinline__ f32x4 ldnt4(const float* p) { return __builtin_nontemporal_load((const f32x4*)p); }
__device__ __forceinline__ float wave_sum(float v) {
#pragma unroll
    for (int o = 1; o < 64; o <<= 1) v += __shfl_xor(v, o);
    return v;
}
__device__ __forceinline__ float wave_max(float v) {
#pragma unroll
    for (int o = 1; o < 64; o <<= 1) v = fmaxf(v, __shfl_xor(v, o));
    return v;
}
template <int CTRL> __device__ __forceinline__ float dpp_f(float x) { return __builtin_bit_cast(float, __builtin_amdgcn_update_dpp(0, __builtin_bit_cast(int, x), CTRL, 0xf, 0xf, false)); }
__device__ __forceinline__ float sum16(float x) { x += dpp_f<0xB1>(x); x += dpp_f<0x4E>(x); x += dpp_f<0x141>(x); x += dpp_f<0x140>(x); return x; }
__device__ __forceinline__ float sigm(float x) { return __builtin_amdgcn_rcpf(1.0f + __expf(-x)); }
__device__ __forceinline__ float tanh_(float x) { return 1.0f - 2.0f * __builtin_amdgcn_rcpf(1.0f + __expf(2.0f * x)); }
__device__ __forceinline__ float gelu_tanh(float x) { const float u = 1.5957691216057308f * (x + 0.044715f * x * x * x); return x * __builtin_amdgcn_rcpf(1.0f + __expf(-u)); }
#define MFMA16(a, b, c) __builtin_amdgcn_mfma_f32_16x16x32_bf16((a), (b), (c), 0, 0, 0)
#define MFMA32(a, b, c) __builtin_amdgcn_mfma_f32_32x32x16_bf16((a), (b), (c), 0, 0, 0)

struct Args { const float* in[45]; float* out; unsigned char* ws; int lo, hi; };

struct Frame {
    LAS unsigned char* lds; volatile LAS unsigned* MISC;
    int tid, lane, wave, G, bid;
    const float* const* in; float* out; unsigned char* ws;
};

__device__ __forceinline__ void tr_item(const float* W, int K, int N, bf16* WT, int drow0, int k0, int n0, LAS float* scr, int lane) {
    const int kr = lane >> 4, nq = lane & 15;
    f32x4 t[8];
#pragma unroll
    for (int i = 0; i < 8; ++i) t[i] = ldnt4(W + (size_t)(k0 + 4 * i + kr) * N + n0 + 4 * nq);
#pragma unroll
    for (int i = 0; i < 8; ++i) { const int row = 4 * i + kr, c = i >> 1; *(LAS f32x4*)(scr + row * 68 + ((4 * nq + 8 * c) & 63)) = t[i]; }
    LDS_WAIT(); asm volatile("" ::: "memory");
    const int c = lane & 3;
#pragma unroll
    for (int p = 0; p < 4; ++p) { const int n = (lane >> 2) + 16 * p; const LAS float* s = scr + (8 * c) * 68 + ((n + 8 * c) & 63);
        v4u o; o.x = pk2(s[0 * 68], s[1 * 68]); o.y = pk2(s[2 * 68], s[3 * 68]); o.z = pk2(s[4 * 68], s[5 * 68]); o.w = pk2(s[6 * 68], s[7 * 68]);
        *(v4u*)(WT + (size_t)(drow0 + n) * K + k0 + 8 * c) = o; }
    LDS_WAIT(); asm volatile("" ::: "memory");
}
__device__ __forceinline__ void p0_prologue(Frame& F) {
    LAS float* scr = (LAS float*)(F.lds + F.wave * 16384);
    const int gw = F.bid * NWAVES + F.wave, NGW = F.G * NWAVES, lane = F.lane;
    unsigned char* ws = F.ws;
#define TR_MAT(Wp, Kk, Nn, Dst, ROWMAP) { const int nblk = (Nn) / 64, cnt = ((Kk) / 32) * nblk; if (r < cnt) { const int kb = r / nblk, n0 = (r % nblk) * 64; \
        tr_item((Wp), (Kk), (Nn), (bf16*)(Dst), (ROWMAP), kb * 32, n0, scr, lane); continue; } r -= cnt; }
    constexpr int NITEMS = 32 * 136 + 2 * 32 * 64 + 32 + 32 + 64;
    for (int it = gw; it < NITEMS; it += NGW) {
        int r = it;
        TR_MAT(F.in[9], DM, DIN, ws + WS_WIN, n0)
        TR_MAT(F.in[35], DM, DM, ws + WS_WKV, n0)
        TR_MAT(F.in[36], DM, DM, ws + WS_WKV, 2048 + n0)
        TR_MAT(F.in[22], 64, DRW, ws + WS_W2T, n0)
        TR_MAT(F.in[24], 64, DRW, ws + WS_A2T, n0)
        TR_MAT(F.in[25], 128, DRW, ws + WS_G2T, n0)
    }
#undef TR_MAT
    const size_t gt = (size_t)F.bid * NTHR + F.tid, NGT = (size_t)F.G * NTHR;
    { const f32x4* xp = (const f32x4*)F.in[0]; const f32x4* xs = (const f32x4*)F.in[1]; v4u* xb = (v4u*)(ws + WS_XB);
      const size_t np = (size_t)MP * DM / 8, nt = (size_t)MT * DM / 8;
      for (size_t i0 = gt; i0 < nt; i0 += 4 * NGT) {
          f32x4 a[4], b[4];
#pragma unroll
          for (int u = 0; u < 4; ++u) { const size_t i = i0 + (size_t)u * NGT; if (i < nt) { const f32x4* s_ = i < np ? xp + 2 * i : xs + 2 * (i - np); a[u] = ldnt4((const float*)s_); b[u] = ldnt4((const float*)(s_ + 1)); } }
#pragma unroll
          for (int u = 0; u < 4; ++u) { const size_t i = i0 + (size_t)u * NGT; if (i < nt) xb[i] = pg8::pack8(a[u], b[u]); } } }
    { const f32x4* mp = (const f32x4*)F.in[2]; v4u* mb = (v4u*)(ws + WS_MB); const size_t nm = (size_t)1024 * DM / 8;
      for (size_t i = gt; i < nm; i += NGT) { const f32x4 a = ldnt4((const float*)(mp + 2 * i)), b = ldnt4((const float*)(mp + 2 * i + 1)); mb[i] = pg8::pack8(a, b); } }
}

constexpr int N_TR_LATE = 16 * 32 + 3 * 32 * 64 + 2 * 32 * 176 + 88 * 64;
__device__ __forceinline__ void tr_late_item(Frame& F, int r, LAS float* scr) {
    constexpr int C0 = 16 * 32, C1 = 32 * 64, C4 = 32 * 176;
    int id, rr = r;
    if (rr < C0) id = 0; else { rr -= C0; if (rr < 3 * C1) { id = 1 + rr / C1; rr = rr % C1; } else { rr -= 3 * C1; if (rr < 2 * C4) { id = 4 + rr / C4; rr = rr % C4; } else { rr -= 2 * C4; id = 6; } } }
    const int K = id == 0 ? DSSM : (id == 6 ? DFF : DM), N = id == 0 ? DSSM : ((id == 4 || id == 5) ? DFF : DM);
    const int src = id == 0 ? 18 : id == 1 ? 31 : id == 2 ? 34 : id == 3 ? 37 : id == 4 ? 40 : id == 5 ? 41 : 42;
    const size_t dsto = id == 0 ? WS_WGLU : id == 1 ? WS_WOUT : id == 2 ? WS_WQ : id == 3 ? WS_WO : id == 6 ? WS_WDN : WS_WGU;
    const int nblk = N / 64, kb = rr / nblk, n0 = (rr % nblk) * 64;
    const int drow0 = (id == 4 || id == 5) ? 256 * (n0 / 128) + (n0 % 128) + (id == 5 ? 128 : 0) : n0;
    tr_item(F.in[src], K, N, (bf16*)(F.ws + dsto), drow0, kb * 32, n0, scr, F.lane);
}

__device__ __forceinline__ void p2_prep(Frame& F) {
    const bf16* H = (const bf16*)(F.ws + WS_H);
    const float* mu = F.in[20]; const float* w0 = F.in[21]; const float* a0 = F.in[23]; const float* k_k = F.in[26]; const float* k_a = F.in[27]; const float* r_k = F.in[28];
    const bf16* W2T = (const bf16*)(F.ws + WS_W2T); const bf16* A2T = (const bf16*)(F.ws + WS_A2T); const bf16* G2T = (const bf16*)(F.ws + WS_G2T);
    float* PR = (float*)(F.ws + WS_PREP); constexpr size_t PS = PREP_STRIDE / 4;
    float* BON = (float*)(F.ws + WS_BONUS);
    const int lane = F.lane, fr = lane & 15, fq = lane >> 4, tid = F.tid, w = F.wave;
    LAS bf16* ACT = (LAS bf16*)F.lds;
    LAS float* PRE = (LAS float*)(F.lds + 8448);
    struct CSet { f32x4 mr, mk, mv, w04, a04, kk4, ka4, rk4, r[2], k[2], v[2], rq[2], kq[2], vq[2]; };
#define P2_ALOAD(item_, X0, X1, Q0, Q1) do { const int tk_ = tid >> 5, c8_ = (tid & 31) * 8, m_ = ((item_) >> 1) * 16 + tk_; \
        const bf16* prow_ = H + (size_t)m_ * DIN + 1024 + 3072 + c8_; const bool prompt_ = m_ < MP; const int t_ = prompt_ ? (m_ & 2047) : ((m_ - MP) & 3); \
        X0 = ldbf4(prow_); X1 = ldbf4(prow_ + 4); \
        if (t_ > 0) { Q0 = ldbf4(prow_ - DIN); Q1 = ldbf4(prow_ - DIN + 4); } \
        else if (prompt_) { Q0 = (f32x4){0.f, 0.f, 0.f, 0.f}; Q1 = Q0; } \
        else { const float* qrow_ = F.in[6] + (size_t)((m_ - MP) >> 2) * DSH + 3072 + c8_; Q0 = *(const f32x4*)qrow_; Q1 = *(const f32x4*)(qrow_ + 4); } } while (0)
#define P2_CLOAD(CS, tile_, half_, j_) do { const int col_ = 512 * (half_) + 4 * lane + 256 * (j_); \
        CS.mr = *(const f32x4*)(mu + col_); CS.mk = *(const f32x4*)(mu + 1024 + col_); CS.mv = *(const f32x4*)(mu + 2048 + col_); \
        CS.w04 = *(const f32x4*)(w0 + col_); CS.a04 = *(const f32x4*)(a0 + col_); CS.kk4 = *(const f32x4*)(k_k + col_); CS.ka4 = *(const f32x4*)(k_a + col_); CS.rk4 = *(const f32x4*)(r_k + col_); \
        _Pragma("unroll") for (int tq_ = 0; tq_ < 2; ++tq_) { const int m_ = (tile_) * 16 + 2 * w + tq_; const bf16* prow_ = H + (size_t)m_ * DIN + 1024 + col_; \
            const bool prompt_ = m_ < MP; const int t_ = prompt_ ? (m_ & 2047) : ((m_ - MP) & 3); \
            CS.r[tq_] = ldbf4(prow_); CS.k[tq_] = ldbf4(prow_ + 1024); CS.v[tq_] = ldbf4(prow_ + 2048); \
            if (t_ > 0) { CS.rq[tq_] = ldbf4(prow_ - DIN); CS.kq[tq_] = ldbf4(prow_ - DIN + 1024); CS.vq[tq_] = ldbf4(prow_ - DIN + 2048); } \
            else if (prompt_) { CS.rq[tq_] = (f32x4){0.f, 0.f, 0.f, 0.f}; CS.kq[tq_] = CS.rq[tq_]; CS.vq[tq_] = CS.rq[tq_]; } \
            else { const float* qrow_ = F.in[6] + (size_t)((m_ - MP) >> 2) * DSH + col_; CS.rq[tq_] = *(const f32x4*)qrow_; CS.kq[tq_] = *(const f32x4*)(qrow_ + 1024); CS.vq[tq_] = *(const f32x4*)(qrow_ + 2048); } } } while (0)
#define P2_CCOMP(CS, tile_, half_, j_) do { const int lc_ = 4 * lane + 256 * (j_), col_ = 512 * (half_) + lc_, hd_ = 8 * (half_) + 4 * (j_) + (lane >> 4); \
        _Pragma("unroll") for (int tq_ = 0; tq_ < 2; ++tq_) { const int tk_ = 2 * w + tq_, m_ = (tile_) * 16 + tk_; \
            const f32x4 r4 = CS.r[tq_] + (CS.rq[tq_] - CS.r[tq_]) * CS.mr, k4 = CS.k[tq_] + (CS.kq[tq_] - CS.k[tq_]) * CS.mk, v4 = CS.v[tq_] + (CS.vq[tq_] - CS.v[tq_]) * CS.mv; \
            const f32x4 pW = *(const LAS f32x4*)(PRE + (0 * 16 + tk_) * 516 + lc_), pA = *(const LAS f32x4*)(PRE + (1 * 16 + tk_) * 516 + lc_), pG = *(const LAS f32x4*)(PRE + (2 * 16 + tk_) * 516 + lc_); \
            f32x4 dec, a, km, kkr; float ss = 0.f; \
            _Pragma("unroll") for (int e = 0; e < 4; ++e) {   \
                dec[e] = __expf(-0.6065306597126334f * sigm(CS.w04[e] + pW[e])); a[e] = sigm(CS.a04[e] + pA[e]); km[e] = k4[e] * (1.0f + (a[e] - 1.0f) * CS.ka4[e]); \
                kkr[e] = k4[e] * CS.kk4[e]; ss += kkr[e] * kkr[e]; } \
            ss = sum16(ss); \
            const float inv = rsqrtf(fmaxf(ss, 1e-24f)); \
            const f32x4 kk = kkr * inv, bb = kk * a; \
            float bon = (r4[0] * km[0] * CS.rk4[0] + r4[1] * km[1] * CS.rk4[1]) + (r4[2] * km[2] * CS.rk4[2] + r4[3] * km[3] * CS.rk4[3]); \
            float br = (bb[0] * r4[0] + bb[1] * r4[1]) + (bb[2] * r4[2] + bb[3] * r4[3]); \
            float kr = (km[0] * r4[0] + km[1] * r4[1]) + (km[2] * r4[2] + km[3] * r4[3]); \
            bon = sum16(bon); br = sum16(br); kr = sum16(kr); \
            const size_t o = (size_t)m_ * 1024 + col_; \
            *(f32x4*)(PR + 0 * PS + o) = dec * r4; *(f32x4*)(PR + 1 * PS + o) = dec; *(f32x4*)(PR + 2 * PS + o) = km; *(f32x4*)(PR + 3 * PS + o) = v4; \
            *(f32x4*)(PR + 4 * PS + o) = -kk; *(f32x4*)(PR + 5 * PS + o) = bb; *(f32x4*)(PR + 6 * PS + o) = pG; \
            if ((lane & 15) == 0) *(f32x4*)(BON + ((size_t)m_ * 16 + hd_) * 4) = (f32x4){bon, br, kr, 0.f}; } } while (0)
    const int NIT = 2 * (MT / 16);
    f32x4 ax0, ax1, aq0, aq1;
    if (F.bid < NIT) P2_ALOAD(F.bid, ax0, ax1, aq0, aq1);
    for (int item = F.bid; item < NIT; item += F.G) {
        const int tile = item >> 1, half = item & 1;
        { const int tk = tid >> 5, c8 = (tid & 31) * 8;
          const f32x4 m0 = *(const f32x4*)(mu + 3072 + c8), m1 = *(const f32x4*)(mu + 3072 + c8 + 4);
          f32x4 x0 = ax0 + (aq0 - ax0) * m0, x1 = ax1 + (aq1 - ax1) * m1;
          if (c8 < 64) {
#pragma unroll
              for (int j = 0; j < 4; ++j) { x0[j] = tanh_(x0[j]); x1[j] = tanh_(x1[j]); }
          } else if (c8 >= 128) {
#pragma unroll
              for (int j = 0; j < 4; ++j) { x0[j] = sigm(x0[j]); x1[j] = sigm(x1[j]); } }
          *(LAS bf16x8*)(ACT + tk * 264 + c8) = pack_bf8(x0, x1); }
        CSet c0; P2_CLOAD(c0, tile, half, 0);
        __syncthreads();
        bf16x8 bw[2], ba[2], bg[4];
#pragma unroll
        for (int kc = 0; kc < 2; ++kc) { bw[kc] = *(const LAS bf16x8*)(ACT + fr * 264 + 32 * kc + 8 * fq); ba[kc] = *(const LAS bf16x8*)(ACT + fr * 264 + 64 + 32 * kc + 8 * fq); }
#pragma unroll
        for (int kc = 0; kc < 4; ++kc) bg[kc] = *(const LAS bf16x8*)(ACT + fr * 264 + 128 + 32 * kc + 8 * fq);
        { const int hd = 8 * half + w;
#pragma unroll
          for (int ct = 0; ct < 4; ++ct) { const int c = 64 * hd + 16 * ct + fr;
              f32x4 aW = (f32x4){0.f, 0.f, 0.f, 0.f}, aA = aW, aG = aW;
#pragma unroll
              for (int kc = 0; kc < 2; ++kc) { aW = MFMA16(*(const bf16x8*)(W2T + c * 64 + 32 * kc + 8 * fq), bw[kc], aW);
                                                aA = MFMA16(*(const bf16x8*)(A2T + c * 64 + 32 * kc + 8 * fq), ba[kc], aA); }
#pragma unroll
              for (int kc = 0; kc < 4; ++kc) aG = MFMA16(*(const bf16x8*)(G2T + c * 128 + 32 * kc + 8 * fq), bg[kc], aG);
              const int lc = 64 * w + 16 * ct + 4 * fq;
              *(LAS f32x4*)(PRE + (0 * 16 + fr) * 516 + lc) = aW; *(LAS f32x4*)(PRE + (1 * 16 + fr) * 516 + lc) = aA; *(LAS f32x4*)(PRE + (2 * 16 + fr) * 516 + lc) = aG; } }
        CSet c1; P2_CLOAD(c1, tile, half, 1);
        if (item + F.G < NIT) P2_ALOAD(item + F.G, ax0, ax1, aq0, aq1);
        __syncthreads();
        P2_CCOMP(c0, tile, half, 0);
        P2_CCOMP(c1, tile, half, 1);
        __syncthreads();
    }
#undef P2_ALOAD
#undef P2_CLOAD
#undef P2_CCOMP
    { const int gt = F.bid * NTHR + F.tid, NGT = F.G * NTHR;
      for (int i = gt; i < 132 * (DSH / 4); i += NGT) { const int s = i / (DSH / 4), c4 = i % (DSH / 4);
          const int m = s < 4 ? s * 2048 + 2047 : MP + 4 * (s - 4) + 3;
          float* o = s < 4 ? F.out + O_SH_P + (size_t)s * DSH : F.out + O_SH_S + (size_t)(s - 4) * DSH;
          stnt4(o + 4 * c4, ldbf4(H + (size_t)m * DIN + 1024 + 4 * c4)); } }
}

__device__ __forceinline__ void grp_bar(volatile LAS unsigned* cnt, unsigned& gen, int lane) {
    gen += 4u; LDS_WAIT();
    if (lane == 0) (void)__hip_atomic_fetch_add((LAS unsigned*)cnt, 1u, __ATOMIC_RELAXED, __HIP_MEMORY_SCOPE_WORKGROUP);
    while (*cnt < gen) __builtin_amdgcn_s_sleep(1);
    asm volatile("" ::: "memory");
}
__device__ __forceinline__ void rwkv_scan_prompt(Frame& F, int b, int h, int quarter) {
    const float* PR = (const float*)(F.ws + WS_PREP); constexpr size_t PS = PREP_STRIDE / 4;
    const float* BON = (const float*)(F.ws + WS_BONUS);
    float* YR = (float*)(F.ws + WS_YR);
    const int tid = F.tid, lane = F.lane, rr = lane >> 4, kq = lane & 15, v = 16 * quarter + 4 * F.wave + rr, m0 = b * 2048;
    constexpr int SST = 388, BST = 16 * SST;
    LAS float* buf = (LAS float*)F.lds;
    volatile LAS unsigned* cnt = F.MISC + 16; unsigned gen = 0u;
    f32x4 S = (f32x4){0.f, 0.f, 0.f, 0.f};
    const int step_l = tid >> 4, part = tid & 15;
    f32x4 stP[6], sbP, stQ[6], sbQ;
#define RW_GLOAD(c, ST, SB) do { const size_t off_ = (size_t)(m0 + (c) * 16 + step_l) * 1024 + h * 64 + 4 * part; \
        ST[0] = *(const f32x4*)(PR + 1 * PS + off_); ST[1] = *(const f32x4*)(PR + 4 * PS + off_); ST[2] = *(const f32x4*)(PR + 5 * PS + off_); \
        ST[3] = *(const f32x4*)(PR + 2 * PS + off_); ST[4] = *(const f32x4*)(PR + 0 * PS + off_); ST[5] = *(const f32x4*)(PR + 3 * PS + off_); \
        if (part == 0) SB = *(const f32x4*)(BON + ((size_t)(m0 + (c) * 16 + step_l) * 16 + h) * 4); } while (0)
#define RW_LSTORE(bi, ST, SB) do { LAS float* d_ = buf + (bi) * BST + step_l * SST + 4 * part; _Pragma("unroll") for (int q = 0; q < 6; ++q) *(LAS f32x4*)(d_ + q * 64) = ST[q]; \
        if (part == 0) *(LAS f32x4*)(d_ + 384) = SB; } while (0)
#define RW_LREAD(sb_, W_, NK_, B_, K_, WR_, VV_, SC_) do { W_ = *(const LAS f32x4*)((sb_) + 4 * kq); NK_ = *(const LAS f32x4*)((sb_) + 64 + 4 * kq); B_ = *(const LAS f32x4*)((sb_) + 128 + 4 * kq); \
        K_ = *(const LAS f32x4*)((sb_) + 192 + 4 * kq); WR_ = *(const LAS f32x4*)((sb_) + 256 + 4 * kq); VV_ = (sb_)[320 + v]; SC_ = *(const LAS f32x4*)((sb_) + 384); } while (0)
#define RW_CHUNK(c, cb) do { float yk = 0.f; f32x4 nw, nnk, nb, nk, nwr, nsc; float nvv; \
        RW_LREAD((cb), nw, nnk, nb, nk, nwr, nvv, nsc); \
        _Pragma("unroll") for (int s = 0; s < 16; ++s) { \
            const f32x4 w4 = nw, nk4 = nnk, b4 = nb, k4 = nk, wr4 = nwr, sc = nsc; const float vv = nvv; \
            if (s + 1 < 16) RW_LREAD((cb) + (s + 1) * SST, nw, nnk, nb, nk, nwr, nvv, nsc); \
            float sa = (S[0] * nk4[0] + S[1] * nk4[1]) + (S[2] * nk4[2] + S[3] * nk4[3]); \
            float p = (S[0] * wr4[0] + S[1] * wr4[1]) + (S[2] * wr4[2] + S[3] * wr4[3]); \
            sa += dpp_f<0xB1>(sa); p += dpp_f<0xB1>(p); sa += dpp_f<0x4E>(sa); p += dpp_f<0x4E>(p); \
            sa += dpp_f<0x141>(sa); p += dpp_f<0x141>(p); sa += dpp_f<0x140>(sa); p += dpp_f<0x140>(p); \
            S = S * w4 + (b4 * sa + k4 * vv); \
            const float y = p + sa * sc[1] + vv * sc[2]; \
            yk = (kq == s) ? y : yk; } \
        YR[(size_t)(m0 + 16 * (c) + kq) * 1024 + h * 64 + v] = yk; } while (0)
    sbP = (f32x4){0.f, 0.f, 0.f, 0.f}; sbQ = sbP;
    RW_GLOAD(0, stP, sbP); RW_LSTORE(0, stP, sbP); RW_GLOAD(1, stP, sbP); RW_GLOAD(2, stQ, sbQ); grp_bar(cnt, gen, lane);
    for (int c = 0; c < 128; c += 2) {
        RW_CHUNK(c, buf);
        RW_LSTORE(1, stP, sbP); grp_bar(cnt, gen, lane);
        if (c + 3 < 128) RW_GLOAD(c + 3, stP, sbP);
        RW_CHUNK(c + 1, buf + BST);
        if (c + 2 < 128) RW_LSTORE(0, stQ, sbQ);
        grp_bar(cnt, gen, lane);
        if (c + 4 < 128) RW_GLOAD(c + 4, stQ, sbQ);
    }
#undef RW_CHUNK
#undef RW_GLOAD
#undef RW_LSTORE
#undef RW_LREAD
    stnt4(F.out + O_WKV_P + (size_t)(b * 16 + h) * 4096 + v * 64 + 4 * kq, S);
}
__device__ __forceinline__ void rwkv_sample_item(Frame& F, int b, int h) {
    const float* PR = (const float*)(F.ws + WS_PREP); constexpr size_t PS = PREP_STRIDE / 4;
    const float* BON = (const float*)(F.ws + WS_BONUS);
    float* YR = (float*)(F.ws + WS_YR);
    const int lane = F.lane, rr = lane >> 4, kq = lane & 15, m0 = MP + 4 * b;
    const float* s_in = F.in[5] + (size_t)(b * 16 + h) * 4096; float* s_out = F.out + O_WKV_S + (size_t)(b * 16 + h) * 4096;
    f32x4 w4[4], nk4[4], b4[4], k4[4], wr4[4], sc[4];
#pragma unroll
    for (int t = 0; t < 4; ++t) { const size_t off = (size_t)(m0 + t) * 1024 + h * 64 + 4 * kq;
        w4[t] = *(const f32x4*)(PR + 1 * PS + off); nk4[t] = *(const f32x4*)(PR + 4 * PS + off); b4[t] = *(const f32x4*)(PR + 5 * PS + off);
        k4[t] = *(const f32x4*)(PR + 2 * PS + off); wr4[t] = *(const f32x4*)(PR + 0 * PS + off); sc[t] = *(const f32x4*)(BON + ((size_t)(m0 + t) * 16 + h) * 4); }
#pragma unroll 4
    for (int rg = 0; rg < 16; ++rg) { const int v = 4 * rg + rr;
        f32x4 S = ldnt4(s_in + v * 64 + 4 * kq);
        float vv[4];
#pragma unroll
        for (int t = 0; t < 4; ++t) vv[t] = PR[3 * PS + (size_t)(m0 + t) * 1024 + h * 64 + v];
        float yk = 0.f;
#pragma unroll
        for (int t = 0; t < 4; ++t) {
            float sa = (S[0] * nk4[t][0] + S[1] * nk4[t][1]) + (S[2] * nk4[t][2] + S[3] * nk4[t][3]);
            float p = (S[0] * wr4[t][0] + S[1] * wr4[t][1]) + (S[2] * wr4[t][2] + S[3] * wr4[t][3]);
            sa = sum16(sa); p = sum16(p);
            S = S * w4[t] + (b4[t] * sa + k4[t] * vv[t]);
            const float y = p + sa * sc[t][1] + vv[t] * sc[t][2];
            yk = (kq == t) ? y : yk;
        }
        if (kq < 4) YR[(size_t)(m0 + kq) * 1024 + h * 64 + v] = yk;
        stnt4(s_out + v * 64 + 4 * kq, S); }
}

template <int SEG> __device__ __forceinline__ void ssm_item(Frame& F, int g, int sel) {
    const bf16* H = (const bf16*)(F.ws + WS_H);
    bf16* YG = (bf16*)(F.ws + WS_YGB);
    const int lane = F.lane, n = lane & 31, hh = lane >> 5, fr = lane & 15, fq = lane >> 4;
    LAS bf16* ldsS = (LAS bf16*)(F.lds + 50176 + F.wave * 8704);
    const float dt = __expf(F.in[17][g]);
    float lr[2], li[2]; bf16x8 Bre[2], Bim[2];
#pragma unroll
    for (int pp = 0; pp < 2; ++pp) { const int p = 2 * n + pp; const float are = F.in[10][g * 64 + p], aim = F.in[11][g * 64 + p];
        const float mag = expf(are * dt), ang = aim * dt; float sn, cs; sincosf(ang, &sn, &cs); lr[pp] = mag * cs; li[pp] = mag * sn;
        const float sh = sinf(0.5f * ang); const float xr = expm1f(are * dt) * cs - 2.0f * sh * sh, xi = mag * sn;
        const float den = 1.0f / (are * are + aim * aim); const float qr = (xr * are + xi * aim) * den, qi = (xi * are - xr * aim) * den;
        const float* brp = F.in[12] + (size_t)(g * 64 + p) * 16 + 8 * hh; const float* bip = F.in[13] + (size_t)(g * 64 + p) * 16 + 8 * hh;
        const f32x4 br0 = *(const f32x4*)brp, br1 = *(const f32x4*)(brp + 4), bi0 = *(const f32x4*)bip, bi1 = *(const f32x4*)(bip + 4);
        Bre[pp] = pack_bf8(br0 * qr - bi0 * qi, br1 * qr - bi1 * qi); Bim[pp] = pack_bf8(bi0 * qr + br0 * qi, bi1 * qr + br1 * qi); }
    bf16x8 Cop[4];
#pragma unroll
    for (int kc = 0; kc < 4; ++kc) { const float* cp = (kc < 2 ? F.in[14] : F.in[15]) + (size_t)(g * 16 + fr) * 64 + 32 * (kc & 1) + 8 * fq; const float sg = kc < 2 ? 1.0f : -1.0f;
        Cop[kc] = pack_bf8(*(const f32x4*)cp * sg, *(const f32x4*)(cp + 4) * sg); }
    const f32x4 d4 = *(const f32x4*)(F.in[16] + 16 * g + 4 * fq);
    float sre[2] = {0.f, 0.f}, sim[2] = {0.f, 0.f};
    const int ntile = SEG == 16 ? 128 : 1;
    const int hr = (n >> 2) & 1, ir = 4 * (n >> 3) + (n & 3);
#define SSM_AROW(t_) (SEG == 16 ? (2 * sel + hr) * 2048 + (t_) * 16 + ir : MP + 4 * (8 * sel + 4 * hr + (ir >> 2)) + (ir & 3))
#define SSM_OROW(t_, rg_) (SEG == 16 ? (2 * sel + (rg_)) * 2048 + (t_) * 16 + fr : MP + 4 * (8 * sel + 4 * (rg_) + (fr >> 2)) + (fr & 3))
#define SSM_LOAD(t_, A0, A1_, U0, U1) do { A0 = *(const bf16x8*)(H + (size_t)SSM_AROW(t_) * DIN + 16 * g + 8 * hh); A1_ = A0; \
        U0 = *(const v2u*)(H + (size_t)SSM_OROW(t_, 0) * DIN + 16 * g + 4 * fq); U1 = *(const v2u*)(H + (size_t)SSM_OROW(t_, 1) * DIN + 16 * g + 4 * fq); } while (0)
    bf16x8 pa0[2], pa1[2]; v2u pu0[2], pu1[2];
    SSM_LOAD(0, pa0[0], pa1[0], pu0[0], pu1[0]);
    if (ntile > 1) SSM_LOAD(1, pa0[1], pa1[1], pu0[1], pu1[1]); else { pa0[1] = pa0[0]; pa1[1] = pa1[0]; pu0[1] = pu0[0]; pu1[1] = pu1[0]; }
    for (int tile = 0; tile < ntile; ++tile) {
        const bf16x8 ca0 = pa0[0]; const v2u cu[2] = {pu0[0], pu1[0]};
        pa0[0] = pa0[1]; pa1[0] = pa1[1]; pu0[0] = pu0[1]; pu1[0] = pu1[1];
        if (tile + 2 < ntile) SSM_LOAD(tile + 2, pa0[1], pa1[1], pu0[1], pu1[1]);
        const bf16x8 A1 = ca0;
        const f32x16 z16 = {0.f, 0.f, 0.f, 0.f, 0.f, 0.f, 0.f, 0.f, 0.f, 0.f, 0.f, 0.f, 0.f, 0.f, 0.f, 0.f};
        f32x16 aRe[2], aIm[2];
#pragma unroll
        for (int pp = 0; pp < 2; ++pp) { aRe[pp] = MFMA32(A1, Bre[pp], z16); aIm[pp] = MFMA32(A1, Bim[pp], z16); }
#pragma unroll
        for (int i = 0; i < 16; ++i) {
            if (SEG == 4 && (i & 3) == 0) { const int batch = 8 * sel + 4 * hh + (i >> 2); const size_t so = (size_t)(batch * 64 + g) * 64 + 2 * n;
                const f32x2 a = *(const f32x2*)(F.in[3] + so), b = *(const f32x2*)(F.in[4] + so); sre[0] = a[0]; sre[1] = a[1]; sim[0] = b[0]; sim[1] = b[1]; }
#pragma unroll
            for (int pp = 0; pp < 2; ++pp) { const float nr = lr[pp] * sre[pp] - li[pp] * sim[pp] + aRe[pp][i], ni = lr[pp] * sim[pp] + li[pp] * sre[pp] + aIm[pp][i]; sre[pp] = nr; sim[pp] = ni; }
            *(LAS unsigned*)(ldsS + (16 * hh + i) * 136 + 2 * n) = pk2(sre[0], sre[1]);
            *(LAS unsigned*)(ldsS + (16 * hh + i) * 136 + 64 + 2 * n) = pk2(sim[0], sim[1]);
            if (SEG == 4 && (i & 3) == 3) { const int batch = 8 * sel + 4 * hh + (i >> 2); const size_t so = (size_t)(batch * 64 + g) * 64 + 2 * n;
                *(f32x2*)(F.out + O_SRE_S + so) = (f32x2){sre[0], sre[1]}; *(f32x2*)(F.out + O_SIM_S + so) = (f32x2){sim[0], sim[1]}; }
        }
        LDS_WAIT(); asm volatile("" ::: "memory");
#pragma unroll
        for (int rg = 0; rg < 2; ++rg) {
            f32x4 aY = (f32x4){0.f, 0.f, 0.f, 0.f};
#pragma unroll
            for (int kc = 0; kc < 4; ++kc) aY = MFMA16(Cop[kc], *(const LAS bf16x8*)(ldsS + (16 * rg + fr) * 136 + 32 * kc + 8 * fq), aY);
            const int orow = SSM_OROW(tile, rg);
            const f32x4 u4 = (f32x4){pg8::bf_lo(cu[rg].x), pg8::bf_hi(cu[rg].x), pg8::bf_lo(cu[rg].y), pg8::bf_hi(cu[rg].y)};
            const f32x4 y = aY + d4 * u4;
            v2u w; w.x = pk2(gelu_tanh(y[0]), gelu_tanh(y[1])); w.y = pk2(gelu_tanh(y[2]), gelu_tanh(y[3]));
            *(v2u*)(YG + (size_t)orow * 1024 + 16 * g + 4 * fq) = w;
        }
        LDS_WAIT(); asm volatile("" ::: "memory");
    }
    if (SEG == 16) { const size_t so = (size_t)((2 * sel + hh) * 64 + g) * 64 + 2 * n;
        *(f32x2*)(F.out + O_SRE_P + so) = (f32x2){sre[0], sre[1]}; *(f32x2*)(F.out + O_SIM_P + so) = (f32x2){sim[0], sim[1]}; }
}

__device__ __forceinline__ void p3_scans(Frame& F, int rep) {
    unsigned* ctr = (unsigned*)(F.ws + WS_CTL) + 128 * rep;
    constexpr int N_SP = 128, N_RS = 2048, N_SS = 1024, TOTAL = N_SP + N_RS + N_SS + N_TR_LATE;
    if (F.tid == 0) F.MISC[16] = 0u;
    __syncthreads();
    if (F.wave < 4) { __builtin_amdgcn_s_setprio(3); for (int it = F.bid; it < 256; it += F.G) rwkv_scan_prompt(F, it >> 6, (it >> 2) & 15, it & 3); __builtin_amdgcn_s_setprio(0); }
    if (MK_TS >= 200 && F.bid == 0 && F.tid == 0) ((unsigned long long*)(F.ws + WS_CTL + 32768))[20] = __builtin_amdgcn_s_memrealtime();
    (void)ctr;
    if (F.wave >= 4) {
        const int q = (F.wave - 4) * F.G + F.bid, NQ = 4 * F.G;
        if (q < N_SP) { __builtin_amdgcn_s_setprio(2); ssm_item<16>(F, q >> 1, q & 1); __builtin_amdgcn_s_setprio(0); }
        else { const int i0 = q - N_SP, st = NQ - N_SP;
            for (int it = i0; it < N_RS; it += st) rwkv_sample_item(F, it >> 4, it & 15);
            for (int it = i0; it < N_SS; it += st) ssm_item<4>(F, it >> 4, it & 15);
            for (int it = i0; it < N_TR_LATE; it += st) tr_late_item(F, it, (LAS float*)(F.lds + 50176 + F.wave * 8704)); }
    }
    if (MK_TS >= 200 && F.bid == 0 && F.tid == 256) ((unsigned long long*)(F.ws + WS_CTL + 32768))[21] = __builtin_amdgcn_s_memrealtime();
}

__device__ __forceinline__ void p4_post(Frame& F, int rep) {
    unsigned* ctr = (unsigned*)(F.ws + WS_CTL) + 64 + 128 * rep;
    const float* PR = (const float*)(F.ws + WS_PREP); constexpr size_t PS = PREP_STRIDE / 4;
    const float* YR = (const float*)(F.ws + WS_YR); const float* BON = (const float*)(F.ws + WS_BONUS);
    const float* lg = F.in[29]; const float* lb = F.in[30];
    bf16* MIX = (bf16*)(F.ws + WS_MIX);
    const int lane = F.lane;
    for (;;) {
        __syncthreads();
        if (F.tid == 0) F.MISC[0] = atomicAdd(ctr, 1u);
        __syncthreads();
        const int it = (int)F.MISC[0];
        if (it >= MT / 16) break;
#pragma unroll
        for (int q = 0; q < 2; ++q) { const int m = it * 16 + 2 * F.wave + q;
#pragma unroll
            for (int j = 0; j < 4; ++j) { const int col = 256 * j + 4 * lane, hd = 4 * j + (lane >> 4); const size_t o = (size_t)m * 1024 + col;
                const f32x4 y = *(const f32x4*)(YR + o);
                const float mean = sum16((y[0] + y[1]) + (y[2] + y[3])) * (1.0f / 64.0f);
                const f32x4 d = y - mean;
                const float var = sum16((d[0] * d[0] + d[1] * d[1]) + (d[2] * d[2] + d[3] * d[3])) * (1.0f / 64.0f);
                const float rstd = rsqrtf(var + GN_EPS), bon = BON[((size_t)m * 16 + hd) * 4];
                const f32x4 v4 = *(const f32x4*)(PR + 3 * PS + o), g4 = *(const f32x4*)(PR + 6 * PS + o), lg4 = *(const f32x4*)(lg + col), lb4 = *(const f32x4*)(lb + col);
                const f32x4 ov = (d * rstd * lg4 + lb4 + v4 * bon) * g4;
                v2u w; w.x = pk2(ov[0], ov[1]); w.y = pk2(ov[2], ov[3]);
                *(v2u*)(MIX + (size_t)m * 2048 + 1024 + col) = w; } }
    }
}

__device__ __forceinline__ void ln_rows(Frame& F, const bf16* src, const float* gam, const float* bet, float* dstf, bf16* dstb, const float* sbase_f, const bf16* sbase_b, const float* part, int nsplit) {
    const int gw = F.bid * NWAVES + F.wave, NGW = F.G * NWAVES, lane = F.lane;
    const bool has_s = (gw & 3) == 0 && (gw >> 2) < (MT - MP);
#define LN_UNPK(W_, A_, B_) do { A_ = (f32x4){pg8::bf_lo(W_.x), pg8::bf_hi(W_.x), pg8::bf_lo(W_.y), pg8::bf_hi(W_.y)}; B_ = (f32x4){pg8::bf_lo(W_.z), pg8::bf_hi(W_.z), pg8::bf_lo(W_.w), pg8::bf_hi(W_.w)}; } while (0)
    for (int it = has_s ? -1 : 0; it < MP / NGW; it += (it < 0 ? 1 : 2)) {
        const int row0 = it < 0 ? MP + (gw >> 2) : gw + it * NGW, row1 = it < 0 ? row0 : row0 + NGW;
        f32x4 v[2][8];
        if (it < 0) {
            if (sbase_f) { const f32x4* sb = (const f32x4*)(sbase_f + (size_t)(row0 - MP) * DM) + 2 * lane;
#pragma unroll
                for (int j = 0; j < 4; ++j) { v[0][2 * j] = sb[128 * j] * ALPHA; v[0][2 * j + 1] = sb[128 * j + 1] * ALPHA; } }
            else { const v4u* sb = (const v4u*)(sbase_b + (size_t)(row0 - MP) * DM) + lane;
#pragma unroll
                for (int j = 0; j < 4; ++j) { const v4u w = sb[64 * j]; LN_UNPK(w, v[0][2 * j], v[0][2 * j + 1]); v[0][2 * j] = v[0][2 * j] * ALPHA; v[0][2 * j + 1] = v[0][2 * j + 1] * ALPHA; } }
#pragma unroll 4
            for (int ks = 0; ks < nsplit; ++ks) { const f32x4* pp = (const f32x4*)(part + ((size_t)ks * 512 + (row0 - MP)) * DM) + 2 * lane;
#pragma unroll
                for (int j = 0; j < 4; ++j) { v[0][2 * j] += pp[128 * j]; v[0][2 * j + 1] += pp[128 * j + 1]; } }
#pragma unroll
            for (int j = 0; j < 8; ++j) v[1][j] = v[0][j];
        } else { const v4u* s0 = (const v4u*)(src + (size_t)row0 * DM) + lane; const v4u* s1 = (const v4u*)(src + (size_t)row1 * DM) + lane;
#pragma unroll
            for (int j = 0; j < 4; ++j) { const v4u w0 = s0[64 * j], w1 = s1[64 * j]; LN_UNPK(w0, v[0][2 * j], v[0][2 * j + 1]); LN_UNPK(w1, v[1][2 * j], v[1][2 * j + 1]); } }
        float sm0 = 0.f, sm1 = 0.f;
#pragma unroll
        for (int j = 0; j < 8; ++j) { sm0 += (v[0][j][0] + v[0][j][1]) + (v[0][j][2] + v[0][j][3]); sm1 += (v[1][j][0] + v[1][j][1]) + (v[1][j][2] + v[1][j][3]); }
#pragma unroll
        for (int o = 1; o < 64; o <<= 1) { sm0 += __shfl_xor(sm0, o); sm1 += __shfl_xor(sm1, o); }
        const float mean0 = sm0 * (1.0f / DM), mean1 = sm1 * (1.0f / DM); float q0 = 0.f, q1 = 0.f;
#pragma unroll
        for (int j = 0; j < 8; ++j) { v[0][j] = v[0][j] - mean0; v[1][j] = v[1][j] - mean1;
            q0 += (v[0][j][0] * v[0][j][0] + v[0][j][1] * v[0][j][1]) + (v[0][j][2] * v[0][j][2] + v[0][j][3] * v[0][j][3]);
            q1 += (v[1][j][0] * v[1][j][0] + v[1][j][1] * v[1][j][1]) + (v[1][j][2] * v[1][j][2] + v[1][j][3] * v[1][j][3]); }
#pragma unroll
        for (int o = 1; o < 64; o <<= 1) { q0 += __shfl_xor(q0, o); q1 += __shfl_xor(q1, o); }
        const float rstd0 = rsqrtf(q0 * (1.0f / DM) + LN_EPS), rstd1 = rsqrtf(q1 * (1.0f / DM) + LN_EPS);
#pragma unroll
        for (int j = 0; j < 4; ++j) { const int c8 = 8 * (lane + 64 * j);
            const f32x4 g0 = *(const f32x4*)(gam + c8), g1 = *(const f32x4*)(gam + c8 + 4), b0 = *(const f32x4*)(bet + c8), b1 = *(const f32x4*)(bet + c8 + 4);
            const f32x4 o00 = v[0][2 * j] * rstd0 * g0 + b0, o01 = v[0][2 * j + 1] * rstd0 * g1 + b1, o10 = v[1][2 * j] * rstd1 * g0 + b0, o11 = v[1][2 * j + 1] * rstd1 * g1 + b1;
            if (dstf) { float* d0 = dstf + (size_t)row0 * DM + c8; __builtin_nontemporal_store(o00, (f32x4*)d0); __builtin_nontemporal_store(o01, (f32x4*)(d0 + 4));
                if (it >= 0) { float* d1 = dstf + (size_t)row1 * DM + c8; __builtin_nontemporal_store(o10, (f32x4*)d1); __builtin_nontemporal_store(o11, (f32x4*)(d1 + 4)); } }
            if (dstb) { *(v4u*)(dstb + (size_t)row0 * DM + c8) = pg8::pack8(o00, o01); if (it >= 0) *(v4u*)(dstb + (size_t)row1 * DM + c8) = pg8::pack8(o10, o11); } }
    }
#undef LN_UNPK
}

__device__ __forceinline__ void attn_prompt_unit(Frame& F, int b, int h, int qt) {
    const bf16* Qb = (const bf16*)(F.ws + WS_QB); const bf16* Kb = (const bf16*)(F.ws + WS_KB); const bf16* VT = (const bf16*)(F.ws + WS_VTB);
    bf16* Ob = (bf16*)(F.ws + WS_OB);
    const int lane = F.lane, fr = lane & 15, fq = lane >> 4, tid = F.tid;
    const int m = b * 2048 + qt * 128 + 16 * F.wave + fr;
    constexpr int BUFB = 33792;
    v4u stg[2][4];
#define AT_GLOAD(ch, ST) do { _Pragma("unroll") for (int i_ = 0; i_ < 4; ++i_) { const int seg_ = i_ * 512 + tid; \
        if ((ch) < 8) { const int r_ = seg_ >> 6, sg_ = seg_ & 63; ST[i_] = *(const v4u*)(Kb + (size_t)(b * NMEM + 32 * (ch) + r_) * DM + h * 512 + sg_ * 8); } \
        else { const int r_ = seg_ >> 5, sg_ = seg_ & 31; ST[i_] = *(const v4u*)(VT + (size_t)(h * 512 + 64 * ((ch) - 8) + r_) * 1024 + b * NMEM + sg_ * 8); } } } while (0)
#define AT_LSTORE(ch, ST) do { LAS unsigned char* d_ = F.lds + ((ch) & 1) * BUFB; _Pragma("unroll") for (int i_ = 0; i_ < 4; ++i_) { const int seg_ = i_ * 512 + tid; \
        if ((ch) < 8) { const int r_ = seg_ >> 6, sg_ = seg_ & 63; *(LAS v4u*)(d_ + r_ * 1040 + sg_ * 16) = ST[i_]; } \
        else { const int r_ = seg_ >> 5, sg_ = seg_ & 31; *(LAS v4u*)(d_ + r_ * 528 + sg_ * 16) = ST[i_]; } } } while (0)
    AT_GLOAD(0, stg[0]); AT_GLOAD(1, stg[1]);
    bf16x8 Qf[16];
#pragma unroll
    for (int kc = 0; kc < 16; ++kc) Qf[kc] = *(const bf16x8*)(Qb + (size_t)m * DM + h * 512 + 32 * kc + 8 * fq);
    AT_LSTORE(0, stg[0]); __syncthreads();
    f32x4 s[8][2]; bf16x8 Pf[8];
#pragma unroll
    for (int ch = 0; ch < 16; ++ch) {
        if (ch + 2 < 16) AT_GLOAD(ch + 2, stg[ch & 1]);
        const LAS unsigned char* cb = F.lds + (ch & 1) * BUFB;
        if (ch < 8) {
#pragma unroll
            for (int sb = 0; sb < 2; ++sb) { const LAS unsigned char* krow = cb + (8 * (fr >> 2) + 4 * sb + (fr & 3)) * 1040 + 16 * fq; f32x4 acc = (f32x4){0.f, 0.f, 0.f, 0.f};
#pragma unroll
                for (int kc = 0; kc < 16; ++kc) acc = MFMA16(*(const LAS bf16x8*)(krow + 64 * kc), Qf[kc], acc);
                s[ch & 7][sb] = acc; }
            if (ch == 7) {
                float mx = -3.0e38f;
#pragma unroll
                for (int c = 0; c < 8; ++c)
#pragma unroll
                    for (int sb = 0; sb < 2; ++sb)
#pragma unroll
                        for (int j = 0; j < 4; ++j) mx = fmaxf(mx, s[c][sb][j]);
                mx = fmaxf(mx, __shfl_xor(mx, 16)); mx = fmaxf(mx, __shfl_xor(mx, 32));
                const float sc2 = 0.044194173824159216f * 1.4426950408889634f;
                float sum = 0.f;
#pragma unroll
                for (int c = 0; c < 8; ++c)
#pragma unroll
                    for (int sb = 0; sb < 2; ++sb)
#pragma unroll
                        for (int j = 0; j < 4; ++j) { const float p = exp2f((s[c][sb][j] - mx) * sc2); s[c][sb][j] = p; sum += p; }
                sum += __shfl_xor(sum, 16); sum += __shfl_xor(sum, 32);
                const float inv = 1.0f / sum;
#pragma unroll
                for (int c = 0; c < 8; ++c) Pf[c] = pack_bf8(s[c][0] * inv, s[c][1] * inv);
            }
        } else {
#pragma unroll
            for (int dl = 0; dl < 4; ++dl) { const LAS unsigned char* vrow = cb + (16 * dl + fr) * 528 + 16 * fq; f32x4 acc = (f32x4){0.f, 0.f, 0.f, 0.f};
#pragma unroll
                for (int c = 0; c < 8; ++c) acc = MFMA16(*(const LAS bf16x8*)(vrow + 64 * c), Pf[c], acc);
                v2u w; w.x = pk2(acc[0], acc[1]); w.y = pk2(acc[2], acc[3]);
                *(v2u*)(Ob + (size_t)m * DM + h * 512 + 64 * (ch - 8) + 16 * dl + 4 * fq) = w; }
        }
        if (ch + 1 < 16) AT_LSTORE(ch + 1, stg[(ch + 1) & 1]);
        __syncthreads();
    }
#undef AT_GLOAD
#undef AT_LSTORE
}
__device__ __forceinline__ void attn_sample_unit(Frame& F, int b, int h) {
    bf16* Ob = (bf16*)(F.ws + WS_OB);
    const float* CK = F.in[7]; const float* CV = F.in[8];
    const int lane = F.lane, fr = lane & 15, fq = lane >> 4, w = F.wave, tid = F.tid;
    LAS float* Pw = (LAS float*)F.lds + w * 128;
    LAS float* ML = (LAS float*)(F.lds + 4096);
    LAS float* red = (LAS float*)(F.lds + 8192);
    LAS bf16* qs = (LAS bf16*)(F.lds + 73728);
    { const float* PART = (const float*)(F.ws + WS_PART); const int q = tid >> 7, d4 = (tid & 127) * 4; f32x4 o = (f32x4){0.f, 0.f, 0.f, 0.f};
      f32x4 pv[8];
#pragma unroll
      for (int ks = 0; ks < 8; ++ks) pv[ks] = *(const f32x4*)(PART + ((size_t)ks * 512 + 4 * b + q) * DM + h * 512 + d4);
#pragma unroll
      for (int ks = 0; ks < 8; ++ks) o += pv[ks];
      v2u pw; pw.x = pk2(o[0], o[1]); pw.y = pk2(o[2], o[3]); *(LAS v2u*)(qs + q * 512 + d4) = pw; }
    __syncthreads();
    bf16x8 Qf[16];
#pragma unroll
    for (int kc = 0; kc < 16; ++kc) { const bf16x8 z = {0, 0, 0, 0, 0, 0, 0, 0};
        Qf[kc] = fr < 4 ? *(const LAS bf16x8*)(qs + fr * 512 + 32 * kc + 8 * fq) : z; }
    f32x4 sc[2];
#pragma unroll
    for (int tl = 0; tl < 2; ++tl) { const int mem = 32 * w + 16 * tl + fr; const float* krow = CK + (size_t)(b * NMEM + mem) * DM + h * 512 + 8 * fq; f32x4 acc = (f32x4){0.f, 0.f, 0.f, 0.f};
#pragma unroll
        for (int kc = 0; kc < 16; ++kc) acc = MFMA16(pack_bf8(ldnt4(krow + 32 * kc), ldnt4(krow + 32 * kc + 4)), Qf[kc], acc);
        sc[tl] = acc * 0.044194173824159216f; }
    float mx = fmaxf(fmaxf(fmaxf(sc[0][0], sc[0][1]), fmaxf(sc[0][2], sc[0][3])), fmaxf(fmaxf(sc[1][0], sc[1][1]), fmaxf(sc[1][2], sc[1][3])));
    mx = fmaxf(mx, __shfl_xor(mx, 16)); mx = fmaxf(mx, __shfl_xor(mx, 32));
    float ls = 0.f;
#pragma unroll
    for (int tl = 0; tl < 2; ++tl)
#pragma unroll
        for (int j = 0; j < 4; ++j) { const float p = __expf(sc[tl][j] - mx); sc[tl][j] = p; ls += p; }
    ls += __shfl_xor(ls, 16); ls += __shfl_xor(ls, 32);
    if (fr < 4) {
#pragma unroll
        for (int tl = 0; tl < 2; ++tl)
#pragma unroll
            for (int j = 0; j < 4; ++j) Pw[(16 * tl + 4 * fq + j) * 4 + fr] = sc[tl][j];
        if (fq == 0) { ML[(w * 4 + fr) * 2] = mx; ML[(w * 4 + fr) * 2 + 1] = ls; } }
    LDS_WAIT(); asm volatile("" ::: "memory");
    f32x4 a0[4], a1[4];
#pragma unroll
    for (int q = 0; q < 4; ++q) { a0[q] = (f32x4){0.f, 0.f, 0.f, 0.f}; a1[q] = a0[q]; }
#pragma unroll 16
    for (int i = 0; i < 32; ++i) { const int mem = 32 * w + i; const float* vrow = CV + (size_t)(b * NMEM + mem) * DM + h * 512;
        const f32x4 v0 = ldnt4(vrow + 4 * lane), v1 = ldnt4(vrow + 256 + 4 * lane); const f32x4 p4 = *(const LAS f32x4*)(Pw + i * 4);
#pragma unroll
        for (int q = 0; q < 4; ++q) { a0[q] += v0 * p4[q]; a1[q] += v1 * p4[q]; } }
#pragma unroll
    for (int q = 0; q < 4; ++q) { *(LAS f32x4*)(red + (w * 4 + q) * 512 + 4 * lane) = a0[q]; *(LAS f32x4*)(red + (w * 4 + q) * 512 + 256 + 4 * lane) = a1[q]; }
    __syncthreads();
    { const int q = tid >> 7, d4 = (tid & 127) * 4; float M = -3.0e38f;
#pragma unroll
      for (int ww = 0; ww < 8; ++ww) M = fmaxf(M, ML[(ww * 4 + q) * 2]);
      float L = 0.f; f32x4 o = (f32x4){0.f, 0.f, 0.f, 0.f};
#pragma unroll
      for (int ww = 0; ww < 8; ++ww) { const float e = __expf(ML[(ww * 4 + q) * 2] - M); L += ML[(ww * 4 + q) * 2 + 1] * e; o += *(const LAS f32x4*)(red + (ww * 4 + q) * 512 + d4) * e; }
      const float inv = 1.0f / L; o = o * inv;
      v2u pw; pw.x = pk2(o[0], o[1]); pw.y = pk2(o[2], o[3]);
      *(v2u*)(Ob + (size_t)(MP + 4 * b + q) * DM + h * 512 + d4) = pw; }
    __syncthreads();
}
__device__ __forceinline__ void p8_attn(Frame& F) {
#ifndef MK_ATT_SKIP
#define MK_ATT_SKIP 0
#endif
    for (int rp = 0; rp < (MK_REP == 80 ? 2 : 1); ++rp) for (int u = F.bid; u < 512; u += F.G) attn_sample_unit(F, u >> 2, u & 3);
    for (int rp = 0; rp < (MK_REP == 81 ? 2 : 1); ++rp) for (int u = F.bid; u < 256; u += F.G) attn_prompt_unit(F, u >> 6, (u >> 4) & 3, u & 15);
}

#define XB_TMO      128
#define XB_XCNT(j)  (256  + 64 * (j))
#define XB_XSUB(j)  (1280 + 64 * (j))
#define XB_XGEN(j)  (2304 + 64 * (j))
#define XB_TOP      3328
#define XB_TOPGEN   3392
#define XCD_BAR_WORDS 3456
#define XB_SPIN_CAP (1u << 18)

__device__ __forceinline__ unsigned xb_ld(unsigned* p)              { return __hip_atomic_load(p, __ATOMIC_RELAXED, __HIP_MEMORY_SCOPE_AGENT); }
__device__ __forceinline__ unsigned xb_add(unsigned* p, unsigned v) { return __hip_atomic_fetch_add(p, v, __ATOMIC_RELAXED, __HIP_MEMORY_SCOPE_AGENT); }
__device__ __forceinline__ unsigned xb_xcc_id() { return (unsigned)__builtin_amdgcn_s_getreg((3 << 11) | 20) & 0xFu; }
#define XB_SPIN(cond, bar) do { unsigned _sp = 0; while (cond) { __builtin_amdgcn_s_sleep(1); \
    if ((++_sp & 255u) == 0u) { if (xb_ld(&(bar)[XB_TMO])) break; if (_sp > XB_SPIN_CAP) { atomicAdd(&(bar)[XB_TMO], 1u); break; } } } } while (0)

struct XcdBarrier {
    unsigned* bar; unsigned x;
    volatile LAS unsigned* st;
};

__device__ __forceinline__ XcdBarrier xcd_barrier_post(unsigned* bar, volatile LAS unsigned* st) {
    XcdBarrier b; b.bar = bar; b.x = xb_xcc_id(); b.st = st;
    if (threadIdx.x == 0) (void)xb_add(&bar[XB_XCNT(b.x)], 1u);
    return b;
}
__device__ __forceinline__ void xcd_barrier_complete(unsigned* bar, unsigned x, unsigned& nloc, unsigned& nx) {
    const unsigned G = gridDim.x * gridDim.y * gridDim.z;
    unsigned sum, cnt, mine, sp = 0u;
    for (;;) {
        sum = 0u; cnt = 0u; mine = 0u;
#pragma unroll
        for (unsigned j = 0; j < 16; ++j) { const unsigned c = xb_ld(&bar[XB_XCNT(j)]); sum += c; cnt += (c > 0u) ? 1u : 0u; mine = (j == x) ? c : mine; }
        if (sum == G) break;
        __builtin_amdgcn_s_sleep(1);
        if ((++sp & 255u) == 0u) { if (xb_ld(&bar[XB_TMO])) break; if (sp > XB_SPIN_CAP) { atomicAdd(&bar[XB_TMO], 1u); break; } }
    }
    nloc = mine > 0u ? mine : 1u; nx = cnt > 0u ? cnt : 1u;
}

__device__ __forceinline__ void xcd_barrier(const XcdBarrier& b) {
    asm volatile("s_waitcnt vmcnt(0)" ::: "memory");
    __syncthreads();
    if (threadIdx.x == 0) {
        unsigned* bar = b.bar;
        __builtin_amdgcn_s_waitcnt(0);
        unsigned nloc = b.st[0], nx = b.st[1];
        if (nloc == 0u) { xcd_barrier_complete(bar, b.x, nloc, nx); b.st[0] = nloc; b.st[1] = nx; }
        const unsigned old = xb_add(&bar[XB_XSUB(b.x)], 1u);
        const unsigned gen = old / nloc;
        if (old + 1u == (gen + 1u) * nloc) {
            __builtin_amdgcn_fence(__ATOMIC_RELEASE, "agent");
            asm volatile("s_waitcnt vmcnt(0)" ::: "memory");
            const unsigned og = xb_add(&bar[XB_TOP], 1u);
            const unsigned tg = og / nx;
            if (og + 1u == (tg + 1u) * nx) xb_add(&bar[XB_TOPGEN], 1u);
            else XB_SPIN(xb_ld(&bar[XB_TOPGEN]) == tg, bar);
            __builtin_amdgcn_fence(__ATOMIC_ACQUIRE, "agent");
            xb_add(&bar[XB_XGEN(b.x)], 1u);
            asm volatile("s_waitcnt vmcnt(0)" ::: "memory");
        } else {
            XB_SPIN(xb_ld(&bar[XB_XGEN(b.x)]) == gen, bar);
            __builtin_amdgcn_fence(__ATOMIC_ACQUIRE, "agent");
            asm volatile("s_waitcnt vmcnt(0)" ::: "memory");
        }
    }
    __syncthreads();
}

template <bool COOP>
__global__ void __launch_bounds__(NTHR, 2) mk_fwd(Args args) {
    extern __shared__ __attribute__((aligned(16))) unsigned char lds_raw[];
    Frame F;
    F.lds = (LAS unsigned char*)lds_raw; F.MISC = (volatile LAS unsigned*)(F.lds + MISC_OFF);
    F.tid = threadIdx.x; F.lane = F.tid & 63; F.wave = __builtin_amdgcn_readfirstlane(F.tid >> 6); F.G = gridDim.x; F.bid = blockIdx.x;
    F.in = args.in; F.out = args.out; F.ws = args.ws;
    unsigned char* ws = args.ws;
    const int lo = args.lo, hi = args.hi, bid = F.bid, G = F.G;
#define IN(k) (lo <= (k) && (k) < hi)
    XcdBarrier bar; bar.bar = (unsigned*)(ws + WS_CTL) + 4096; bar.x = 0; bar.st = nullptr;
    if (COOP) { if (F.tid < 2) F.MISC[8 + F.tid] = 0u; __syncthreads(); bar = xcd_barrier_post((unsigned*)(ws + WS_CTL) + 4096, F.MISC + 8); }
    unsigned long long* tsb = (unsigned long long*)(ws + WS_CTL + 32768);
    if (MK_TS >= 0 && bid == 0 && F.tid == 0) tsb[0] = __builtin_amdgcn_s_memrealtime();
#define SEAM(k) do { if (COOP) { if (IN(k) && IN((k) + 1)) { if (lo < 0) cg::this_grid().sync(); else xcd_barrier(bar); } } \
        if (MK_TS >= 0 && bid == 0 && F.tid == 0) tsb[(k) + 1] = __builtin_amdgcn_s_memrealtime(); } while (0)
    using pg8::Gemm; using pg8::StaticOrder; using pg8::gemm_phase;
    bf16* XB = (bf16*)(ws + WS_XB); bf16* Hh = (bf16*)(ws + WS_H); bf16* R = (bf16*)(ws + WS_R); float* PART = (float*)(ws + WS_PART);

    if (IN(0)) for (int rep = 0; rep < (MK_REP == 0 ? 2 : 1); ++rep) { if (rep) xcd_barrier(bar); p0_prologue(F); } SEAM(0);
    if (IN(1)) for (int rep = 0; rep < (MK_REP == 1 ? 2 : 1); ++rep) { if (rep) xcd_barrier(bar);
        { Gemm g{XB, (const bf16*)(ws + WS_WIN), MT, DIN, DM}; StaticOrder S; S.init(MT, DIN, G, bid, DM); pg8::EpiBf16S E{Hh, DIN, nullptr};
          gemm_phase<pg8::EpiBf16S, StaticOrder, true, true>(F.lds, g, S, E); }
        { Gemm g{(const bf16*)(ws + WS_MB), (const bf16*)(ws + WS_WKV), 1024, 4096, DM}; StaticOrder S; S.init(1024, 4096, G, (bid + G - 66) % G, DM);
          pg8::EpiMemKV E{F.out + O_MK, F.out + O_MV, (bf16*)(ws + WS_KB)};
          gemm_phase<pg8::EpiMemKV, StaticOrder, true, true>(F.lds, g, S, E); }
        { Gemm g{(const bf16*)(ws + WS_WKV) + (size_t)2048 * DM, (const bf16*)(ws + WS_MB), 2048, 1024, DM}; StaticOrder S; S.init(2048, 1024, G, (bid + G - 130) % G, DM);
          pg8::EpiBf16S E{(bf16*)(ws + WS_VTB), 1024, nullptr};
          gemm_phase<pg8::EpiBf16S, StaticOrder, true, true>(F.lds, g, S, E); }
    } SEAM(1);
    if (IN(2)) for (int rep = 0; rep < (MK_REP == 2 ? 2 : 1); ++rep) { if (rep) xcd_barrier(bar); p2_prep(F); } SEAM(2);
    if (IN(3)) for (int rep = 0; rep < (MK_REP == 3 ? 2 : 1); ++rep) { if (rep) xcd_barrier(bar); p3_scans(F, rep); } SEAM(3);
    if (IN(4)) for (int rep = 0; rep < (MK_REP == 4 ? 2 : 1); ++rep) { if (rep) xcd_barrier(bar);
        { Gemm g{(const bf16*)(ws + WS_YGB), (const bf16*)(ws + WS_WGLU), MT, DSSM, DSSM}; StaticOrder S; S.init(MT, DSSM, G, bid, DSSM);
          pg8::EpiGlu E{(const bf16*)(ws + WS_YGB), 1024, F.in[19], (bf16*)(ws + WS_MIX), 2048};
          gemm_phase<pg8::EpiGlu, StaticOrder, true, true>(F.lds, g, S, E); }
        p4_post(F, rep);
    } SEAM(4);
    if (IN(5)) for (int rep = 0; rep < (MK_REP == 5 ? 2 : 1); ++rep) { if (rep) xcd_barrier(bar); Gemm g{(const bf16*)(ws + WS_MIX), (const bf16*)(ws + WS_WOUT), MT, DM, DM}; pg8::MixOrder S; S.init(MP, DM, G, bid, DM, 8, 256);
        pg8::EpiRes E{F.in[0], F.in[1], nullptr, R, DM, ALPHA, PART};
        gemm_phase<pg8::EpiRes, pg8::MixOrder, true, true>(F.lds, g, S, E); } SEAM(5);
    if (IN(6)) for (int rep = 0; rep < (MK_REP == 6 ? 2 : 1); ++rep) { if (rep) xcd_barrier(bar); ln_rows(F, R, F.in[32], F.in[33], nullptr, XB, F.in[1], nullptr, PART, 8); } SEAM(6);
    if (IN(7)) for (int rep = 0; rep < (MK_REP == 7 ? 2 : 1); ++rep) { if (rep) xcd_barrier(bar); Gemm g{XB, (const bf16*)(ws + WS_WQ), MT, DM, DM}; pg8::MixOrder S; S.init(MP, DM, G, bid, DM, 8, 256);
        pg8::EpiBf16S E{(bf16*)(ws + WS_QB), DM, PART};
        gemm_phase<pg8::EpiBf16S, pg8::MixOrder, true, true>(F.lds, g, S, E); } SEAM(7);
    if (IN(8)) for (int rep = 0; rep < (MK_REP == 8 ? 2 : 1); ++rep) { if (rep) xcd_barrier(bar); p8_attn(F); } SEAM(8);
    if (IN(9)) for (int rep = 0; rep < (MK_REP == 9 ? 2 : 1); ++rep) { if (rep) xcd_barrier(bar); Gemm g{(const bf16*)(ws + WS_OB), (const bf16*)(ws + WS_WO), MT, DM, DM}; pg8::MixOrder S; S.init(MP, DM, G, bid, DM, 8, 256);
        pg8::EpiRes E{nullptr, nullptr, XB, R, DM, ALPHA, PART};
        gemm_phase<pg8::EpiRes, pg8::MixOrder, true, true>(F.lds, g, S, E); } SEAM(9);
    if (IN(10)) for (int rep = 0; rep < (MK_REP == 10 ? 2 : 1); ++rep) { if (rep) xcd_barrier(bar); ln_rows(F, R, F.in[38], F.in[39], nullptr, XB, nullptr, XB + (size_t)MP * DM, PART, 8); } SEAM(10);
    if (IN(11)) for (int rep = 0; rep < (MK_REP == 11 ? 2 : 1); ++rep) { if (rep) xcd_barrier(bar); Gemm g{XB, (const bf16*)(ws + WS_WGU), MT, 2 * DFF, DM}; StaticOrder S; S.init(MT, 2 * DFF, G, bid, DM);
        pg8::EpiSwiGLU E{(bf16*)(ws + WS_HFF), DFF};
        gemm_phase<pg8::EpiSwiGLU, StaticOrder, true, true>(F.lds, g, S, E); } SEAM(11);
    if (IN(12)) for (int rep = 0; rep < (MK_REP == 12 ? 2 : 1); ++rep) { if (rep) xcd_barrier(bar); Gemm g{(const bf16*)(ws + WS_HFF), (const bf16*)(ws + WS_WDN), MT, DM, DFF}; pg8::MixOrder S; S.init(MP, DM, G, bid, DFF, 11, 512);
        pg8::EpiRes E{nullptr, nullptr, XB, R, DM, ALPHA, PART};
        gemm_phase<pg8::EpiRes, pg8::MixOrder, true, true>(F.lds, g, S, E); } SEAM(12);
    if (IN(13)) for (int rep = 0; rep < (MK_REP == 13 ? 2 : 1); ++rep) { if (rep) xcd_barrier(bar); ln_rows(F, R, F.in[43], F.in[44], F.out + O_Y, nullptr, nullptr, XB + (size_t)MP * DM, PART, 11); }
    if (MK_TS >= 0 && bid == 0) {
        if (F.tid == 0) tsb[NPHASE] = __builtin_amdgcn_s_memrealtime();
        __syncthreads();
        const int k0 = MK_TS >= 200 ? 3 : (MK_TS >= 100 ? 0 : MK_TS), k1 = MK_TS >= 200 ? MK_TS - 183 : (MK_TS >= 100 ? NPHASE : MK_TS + 1);
        const float t_us = (float)(tsb[k1] - tsb[k0]) * 0.01f; const float sc = 1.0f + sqrtf(t_us * 1e-6f);
        for (int i = F.tid; i < 16384; i += NTHR) F.out[O_SRE_P + i] *= sc; }
#undef IN
#undef SEAM
}

#ifndef MK_COOP
#define MK_COOP 0
#endif
#ifndef MK_PH_HI
#define MK_PH_HI NPHASE
#endif
extern "C" void kernel_launch(void* const* d_in, const int* in_sizes, int n_in, void* d_out, int out_size, void* d_ws, size_t ws_size, hipStream_t stream) {
    static int grid = 0;
    if (grid == 0) {
        if (n_in != 45 || out_size != (int)O_END || ws_size < WS_END) { fprintf(stderr, "kernel_launch: unexpected shapes (n_in %d out %d ws %zu)\n", n_in, out_size, ws_size); grid = -1; return; }
        int dev = 0, cus = 0, per_cu = 0;
        (void)hipGetDevice(&dev); (void)hipDeviceGetAttribute(&cus, hipDeviceAttributeMultiprocessorCount, dev);
        (void)hipFuncSetAttribute((const void*)mk_fwd<(MK_COOP != 0)>, hipFuncAttributeMaxDynamicSharedMemorySize, LDS_BYTES);
        (void)hipOccupancyMaxActiveBlocksPerMultiprocessor(&per_cu, (const void*)mk_fwd<(MK_COOP != 0)>, NTHR, LDS_BYTES);
        (void)hipGetLastError();
        if (per_cu < 1) { fprintf(stderr, "kernel_launch: occupancy query says %d blocks per CU\n", per_cu); per_cu = 1; }
        grid = cus;
    }
    if (grid < 0) return;
    (void)hipMemsetAsync((char*)d_ws + WS_CTL, 0, 65536, stream);
    if (MK_PH_HI < NPHASE) (void)hipMemsetAsync(d_out, 0, (size_t)out_size * 4, stream);
#ifdef MK_DUMP_OFF
#ifndef MK_DUMP_BYTES
#define MK_DUMP_BYTES ((size_t)MT * DM * 4)
#endif
#define MK_DUMP_AFTER (void)hipMemcpyAsync(d_out, (char*)d_ws + (MK_DUMP_OFF), MK_DUMP_BYTES, hipMemcpyDeviceToDevice, stream);
#else
#define MK_DUMP_AFTER
#endif
    Args a{};
    for (int i = 0; i < 45; ++i) a.in[i] = (const float*)d_in[i];
    a.out = (float*)d_out; a.ws = (unsigned char*)d_ws;
#if MK_COOP
    a.lo = 0; a.hi = MK_PH_HI;
    void* kargs[] = {&a};
    hipError_t e = hipLaunchCooperativeKernel((const void*)mk_fwd<true>, dim3(grid), dim3(NTHR), kargs, LDS_BYTES, stream);
    if (e != hipSuccess) fprintf(stderr, "cooperative launch failed: %s (grid %d)\n", hipGetErrorString(e), grid);
#else
    for (int p = 0; p < MK_PH_HI; ++p) { a.lo = p; a.hi = p + 1; hipLaunchKernelGGL(mk_fwd<false>, dim3(grid), dim3(NTHR), LDS_BYTES, stream, a); }
#endif
    MK_DUMP_AFTER
}
```

```cpp
#include <hip/hip_runtime.h>
#include <hip/hip_cooperative_groups.h>
#include <cstdio>
#include <cstdint>
namespace cg = cooperative_groups;
#define MK_COOP 1
namespace pg8 {
#define PG8_LAS __attribute__((address_space(3)))
typedef unsigned short bf16_t;
typedef short bf16x8 __attribute__((ext_vector_type(8)));
typedef float f32x4 __attribute__((ext_vector_type(4)));
typedef unsigned u32x4 __attribute__((ext_vector_type(4)));
constexpr int BM = 256, BK = 64, HALF = 128, HTB = HALF * BK * 2  , STAGE_BYTES = 8 * HTB, NXCD = 8, WGM = 8;

__host__ __device__ __forceinline__ int lds_byte(int r, int c) { const int st = (r >> 4) * 2 + (c >> 5), rr = r & 15, cc = c & 31, ob = rr * 64 + cc * 2; return st * 1024 + (ob ^ (((ob >> 9) & 1) << 5)); }
__host__ __device__ __forceinline__ void stage_rc(int b, int& R, int& C) { const int st = b / 1024, sb = b % 1024, swz = sb ^ (((sb >> 9) & 1) << 5); R = (st >> 1) * 16 + swz / 64; C = (st & 1) * 32 + (swz % 64) / 2; }
__host__ __device__ __forceinline__ int perm32(int rho) { const int n = rho >> 4, i = rho & 15; return 8 * (i >> 2) + 4 * n + (i & 3); }

struct Unit { int pm, pn, koff, nt, ks; };
struct Gemm { const bf16_t* A; const bf16_t* Bt; int M, N, K; };

struct StaticOrder {
    int nM, nN, nwg, G, c, ntk;
    __host__ __device__ void init(int M, int N, int G_, int c_, int K_) { nM = M / BM; nN = N / BM; nwg = nM * nN; G = G_; c = c_; ntk = K_ / BK; }
    __host__ __device__ bool next(int i, Unit& u) const {
        const long L = (long)i * G + c; if (L >= nwg) return false;
        int wgid = (int)L; { const int q = nwg / NXCD, r = nwg % NXCD, xcd = wgid % NXCD, off = wgid / NXCD; wgid = (xcd < r ? xcd * (q + 1) : r * (q + 1) + (xcd - r) * q) + off; }
        const int nig = WGM * nN, gid = wgid / nig, fm = gid * WGM, gsz = (nM - fm) < WGM ? (nM - fm) : WGM;
        u.pm = fm + ((wgid % nig) % gsz); u.pn = (wgid % nig) / gsz; u.koff = 0; u.nt = ntk; u.ks = -1; return true;
    }
    __device__ __forceinline__ void a_ready(const Unit&) const {}
    __device__ __forceinline__ void done(const Unit&) const {}
};
struct MixOrder {
    StaticOrder so; int c, nsplit, ksz, nN, pm0;
    __host__ __device__ void init(int M0, int N, int G_, int c_, int K_, int nsplit_, int ksz_) { so.init(M0, N, G_, c_, K_); c = c_; nsplit = nsplit_; ksz = ksz_; nN = N / BM; pm0 = M0 / BM; }
    __host__ __device__ bool next(int i, Unit& u) const {
        if (i == 0) return so.next(0, u);
        if (i == 1) { const int per = 2 * nN; if (c >= nsplit * per) return false; const int tile = c % per, ks = c / per;
            u.pm = pm0 + tile / nN; u.pn = tile % nN; u.koff = ks * ksz; u.nt = ksz / BK; u.ks = ks; return true; }
        return false;
    }
    __device__ __forceinline__ void a_ready(const Unit&) const {}
    __device__ __forceinline__ void done(const Unit&) const {}
};
typedef float f32x2_cv __attribute__((ext_vector_type(2))); typedef __bf16 bf16x2_cv __attribute__((ext_vector_type(2)));
__device__ __forceinline__ unsigned cvt_pk_bf16(float lo, float hi) { const f32x2_cv v = {lo, hi}; const bf16x2_cv b = __builtin_convertvector(v, bf16x2_cv); return __builtin_bit_cast(unsigned, b); }

__device__ __forceinline__ float bf_lo(unsigned w) { return __builtin_bit_cast(float, w << 16); }
__device__ __forceinline__ float bf_hi(unsigned w) { return __builtin_bit_cast(float, w & 0xffff0000u); }
__device__ __forceinline__ u32x4 pack8(const f32x4 a, const f32x4 b) { u32x4 w; w.x = cvt_pk_bf16(a[0], a[1]); w.y = cvt_pk_bf16(a[2], a[3]); w.z = cvt_pk_bf16(b[0], b[1]); w.w = cvt_pk_bf16(b[2], b[3]); return w; }
__device__ __forceinline__ float sigmoidf_(float x) { return __builtin_amdgcn_rcpf(1.0f + __expf(-x)); }

struct EpiF32 {
    static constexpr bool PERM = true, AFTER_DRAIN = false;
    float* O; int ldc;
    __device__ __forceinline__ void operator()(const f32x4 (&acc)[2][2][4][2], const Unit& u, int wr, int wc, int fr, int fq) const {
        const int row0 = u.pm * BM + wr * 64 + fr, col0 = u.pn * BM + wc * 32 + 8 * fq;
#pragma unroll
        for (int ai = 0; ai < 2; ++ai)
#pragma unroll
            for (int m = 0; m < 4; ++m) { float* rowp = O + (size_t)(row0 + ai * HALF + m * 16) * ldc + col0;
#pragma unroll
                for (int bj = 0; bj < 2; ++bj) { *(f32x4*)(rowp + bj * HALF) = acc[ai][bj][m][0]; *(f32x4*)(rowp + bj * HALF + 4) = acc[ai][bj][m][1]; } }
    }
};
struct EpiMemKV {
    static constexpr bool PERM = true, AFTER_DRAIN = false;
    float* outK; float* outV; bf16_t* Kb;
    __device__ __forceinline__ void operator()(const f32x4 (&acc)[2][2][4][2], const Unit& u, int wr, int wc, int fr, int fq) const {
        const int row0 = u.pm * BM + wr * 64 + fr; const int colt = u.pn * BM; const bool isV = colt >= 2048;
        float* o = isV ? outV : outK; const int col0 = (isV ? colt - 2048 : colt) + wc * 32 + 8 * fq;
#pragma unroll
        for (int ai = 0; ai < 2; ++ai)
#pragma unroll
            for (int m = 0; m < 4; ++m)
#pragma unroll
                for (int bj = 0; bj < 2; ++bj) { const size_t off = (size_t)(row0 + ai * HALF + m * 16) * 2048 + col0 + bj * HALF;
                    __builtin_nontemporal_store(acc[ai][bj][m][0], (f32x4*)(o + off)); __builtin_nontemporal_store(acc[ai][bj][m][1], (f32x4*)(o + off + 4));
                    if (!isV) *(u32x4*)(Kb + off) = pack8(acc[ai][bj][m][0], acc[ai][bj][m][1]); }
    }
};
struct EpiBf16S {
    static constexpr bool PERM = true, AFTER_DRAIN = false;
    bf16_t* O; int ldc; float* part;
    __device__ __forceinline__ void operator()(const f32x4 (&acc)[2][2][4][2], const Unit& u, int wr, int wc, int fr, int fq) const {
        const int row0 = u.pm * BM + wr * 64 + fr, col0 = u.pn * BM + wc * 32 + 8 * fq;
        if (u.ks >= 0) {
#pragma unroll
            for (int ai = 0; ai < 2; ++ai)
#pragma unroll
                for (int m = 0; m < 4; ++m) { float* rowp = part + ((size_t)u.ks * 512 + (row0 + ai * HALF + m * 16 - 8192)) * ldc + col0;
#pragma unroll
                    for (int bj = 0; bj < 2; ++bj) { *(f32x4*)(rowp + bj * HALF) = acc[ai][bj][m][0]; *(f32x4*)(rowp + bj * HALF + 4) = acc[ai][bj][m][1]; } }
            return; }
#pragma unroll
        for (int ai = 0; ai < 2; ++ai)
#pragma unroll
            for (int m = 0; m < 4; ++m) { bf16_t* rowp = O + (size_t)(row0 + ai * HALF + m * 16) * ldc + col0;
#pragma unroll
                for (int bj = 0; bj < 2; ++bj) *(u32x4*)(rowp + bj * HALF) = pack8(acc[ai][bj][m][0], acc[ai][bj][m][1]); }
    }
};
struct EpiGlu {
    static constexpr bool PERM = true, AFTER_DRAIN = false;
    const bf16_t* Y; int ldy; const float* bias; bf16_t* O; int ldo;
    __device__ __forceinline__ void operator()(const f32x4 (&acc)[2][2][4][2], const Unit& u, int wr, int wc, int fr, int fq) const {
        const int row0 = u.pm * BM + wr * 64 + fr, col0 = u.pn * BM + wc * 32 + 8 * fq;
#pragma unroll
        for (int bj = 0; bj < 2; ++bj) { const f32x4 b0 = *(const f32x4*)(bias + col0 + bj * HALF), b1 = *(const f32x4*)(bias + col0 + bj * HALF + 4);
#pragma unroll
            for (int ai = 0; ai < 2; ++ai)
#pragma unroll
                for (int m = 0; m < 4; ++m) { const int row = row0 + ai * HALF + m * 16;
                    const u32x4 yv = *(const u32x4*)(Y + (size_t)row * ldy + col0 + bj * HALF);
                    const f32x4 a0 = acc[ai][bj][m][0] + b0, a1 = acc[ai][bj][m][1] + b1; f32x4 z0, z1;
                    z0[0] = bf_lo(yv.x) * sigmoidf_(a0[0]); z0[1] = bf_hi(yv.x) * sigmoidf_(a0[1]); z0[2] = bf_lo(yv.y) * sigmoidf_(a0[2]); z0[3] = bf_hi(yv.y) * sigmoidf_(a0[3]);
                    z1[0] = bf_lo(yv.z) * sigmoidf_(a1[0]); z1[1] = bf_hi(yv.z) * sigmoidf_(a1[1]); z1[2] = bf_lo(yv.w) * sigmoidf_(a1[2]); z1[3] = bf_hi(yv.w) * sigmoidf_(a1[3]);
                    *(u32x4*)(O + (size_t)row * ldo + col0 + bj * HALF) = pack8(z0, z1); } }
    }
};
struct EpiRes {
    static constexpr bool PERM = true, AFTER_DRAIN = false;
    const float* base0; const float* base1; const bf16_t* bbase; bf16_t* O; int ld; float alpha; float* part;
    __device__ __forceinline__ void operator()(const f32x4 (&acc)[2][2][4][2], const Unit& u, int wr, int wc, int fr, int fq) const {
        const int row0 = u.pm * BM + wr * 64 + fr, col0 = u.pn * BM + wc * 32 + 8 * fq;
        if (u.ks >= 0) {
#pragma unroll
            for (int ai = 0; ai < 2; ++ai)
#pragma unroll
                for (int m = 0; m < 4; ++m) { float* rowp = part + ((size_t)u.ks * 512 + (row0 + ai * HALF + m * 16 - 8192)) * ld + col0;
#pragma unroll
                    for (int bj = 0; bj < 2; ++bj) { *(f32x4*)(rowp + bj * HALF) = acc[ai][bj][m][0]; *(f32x4*)(rowp + bj * HALF + 4) = acc[ai][bj][m][1]; } }
            return; }
        const bool lo = (u.pm * BM) < 8192; const float* bp = lo ? base0 : base1; const int rsub = lo ? 0 : 8192;
#pragma unroll
        for (int ai = 0; ai < 2; ++ai)
#pragma unroll
            for (int m = 0; m < 4; ++m) { const int row = row0 + ai * HALF + m * 16; bf16_t* orow = O + (size_t)row * ld + col0;
#pragma unroll
                for (int bj = 0; bj < 2; ++bj) { f32x4 x0, x1;
                    if (bbase) { const u32x4 bv = *(const u32x4*)(bbase + (size_t)row * ld + col0 + bj * HALF);
                        x0 = (f32x4){bf_lo(bv.x), bf_hi(bv.x), bf_lo(bv.y), bf_hi(bv.y)}; x1 = (f32x4){bf_lo(bv.z), bf_hi(bv.z), bf_lo(bv.w), bf_hi(bv.w)}; }
                    else { const float* brow = bp + (size_t)(row - rsub) * ld + col0 + bj * HALF; x0 = __builtin_nontemporal_load((const f32x4*)brow); x1 = __builtin_nontemporal_load((const f32x4*)(brow + 4)); }
                    *(u32x4*)(orow + bj * HALF) = pack8(x0 * alpha + acc[ai][bj][m][0], x1 * alpha + acc[ai][bj][m][1]); } }
    }
};
struct EpiSwiGLU {
    static constexpr bool PERM = true, AFTER_DRAIN = false;
    bf16_t* O; int ldo;
    __device__ __forceinline__ void operator()(const f32x4 (&acc)[2][2][4][2], const Unit& u, int wr, int wc, int fr, int fq) const {
        const int row0 = u.pm * BM + wr * 64 + fr, col0 = u.pn * HALF + wc * 32 + 8 * fq;
#pragma unroll
        for (int ai = 0; ai < 2; ++ai)
#pragma unroll
            for (int m = 0; m < 4; ++m) { f32x4 h0, h1;
#pragma unroll
                for (int j = 0; j < 4; ++j) { const float g0 = acc[ai][0][m][0][j], g1 = acc[ai][0][m][1][j];
                    h0[j] = g0 * sigmoidf_(g0) * acc[ai][1][m][0][j]; h1[j] = g1 * sigmoidf_(g1) * acc[ai][1][m][1][j]; }
                *(u32x4*)(O + (size_t)(row0 + ai * HALF + m * 16) * ldo + col0) = pack8(h0, h1); }
    }
};

template <class Epi, class Sched, bool ALIGN_EPI = false, bool SP2 = false>
__device__ __forceinline__ void gemm_phase(PG8_LAS unsigned char* lds, const Gemm g, const Sched& S, const Epi& E) {
    const int tid = threadIdx.x, wid = __builtin_amdgcn_readfirstlane(tid >> 6), lane = tid & 63, wr = wid >> 2, wc = wid & 3, fr = lane & 15, fq = lane >> 4;
    const int K = g.K;
    unsigned voffA[2], voffB[2];
#pragma unroll
    for (int i = 0; i < 2; ++i) { int R, C; stage_rc(tid * 16 + i * 8192, R, C); const int Rb = Epi::PERM ? ((R & ~31) + perm32(R & 31)) : R;
        voffA[i] = (unsigned)(R * K + C) * 2u; voffB[i] = (unsigned)(Rb * K + C) * 2u; }
    const size_t kstep = (size_t)(BK * 2);
    const size_t hstep = (size_t)HALF * K * 2;
    const size_t tstep = 2 * hstep;
    const unsigned ldsw = (unsigned)wid * 1024u;
    const int aoff = lds_byte(wr * 64 + fr, fq * 8), boff = lds_byte(wc * 32 + fr, fq * 8);
#define PG8_SA(b, h) (((b) * 2 + (h)) * HTB)
#define PG8_SB(b, h) ((4 + (b) * 2 + (h)) * HTB)
#define PG8_STAGE(bufoff, gbase, voff) do { _Pragma("unroll") for (int _i = 0; _i < 2; ++_i) \
        __builtin_amdgcn_global_load_lds((const unsigned*)((const char*)(gbase) + (voff)[_i]), (PG8_LAS unsigned*)(lds + (bufoff) + ldsw + _i * 8192), 16, 0, 0); } while (0)
#define PG8_LDA(dst, b, h) do { _Pragma("unroll") for (int m = 0; m < 4; ++m) _Pragma("unroll") for (int k = 0; k < 2; ++k) dst[m][k] = *(const PG8_LAS bf16x8*)(lds + PG8_SA(b, h) + aoff + m * 2048 + k * 1024); } while (0)
#define PG8_LDB(dst, b, h) do { _Pragma("unroll") for (int n = 0; n < 2; ++n) _Pragma("unroll") for (int k = 0; k < 2; ++k) dst[n][k] = *(const PG8_LAS bf16x8*)(lds + PG8_SB(b, h) + boff + n * 2048 + k * 1024); } while (0)
#define PG8_MMA(ai, bj, At, Bt) do { __builtin_amdgcn_s_setprio(1); _Pragma("unroll") for (int m = 0; m < 4; ++m) _Pragma("unroll") for (int n = 0; n < 2; ++n) _Pragma("unroll") for (int k = 0; k < 2; ++k) \
        acc[ai][bj][m][n] = __builtin_amdgcn_mfma_f32_16x16x32_bf16(Bt[n][k], At[m][k], acc[ai][bj][m][n], 0, 0, 0); __builtin_amdgcn_s_setprio(0); } while (0)
#define PG8_WAIT_V(n) asm volatile("s_waitcnt vmcnt(" #n ")" ::: "memory")
#define PG8_WAIT_L(n) asm volatile("s_waitcnt lgkmcnt(" #n ")" ::: "memory")
#define PG8_BAR __builtin_amdgcn_s_barrier()
#define PG8_SCHED __builtin_amdgcn_sched_barrier(0)
    Unit cur, nxt; int ui = 0;
    if (!S.next(0, cur)) return;
    f32x4 acc[2][2][4][2];
#pragma unroll
    for (int a = 0; a < 2; ++a)
#pragma unroll
        for (int b = 0; b < 2; ++b)
#pragma unroll
            for (int m = 0; m < 4; ++m)
#pragma unroll
                for (int n = 0; n < 2; ++n) acc[a][b][m][n] = (f32x4){0.f, 0.f, 0.f, 0.f};
    bf16x8 At[4][2], B0[2][2], B1[2][2];
    const char* cA = (const char*)g.A + (size_t)cur.pm * tstep + (size_t)cur.koff * 2; const char* cB = (const char*)g.Bt + (size_t)cur.pn * tstep + (size_t)cur.koff * 2;
    S.a_ready(cur);
    if constexpr (SP2) {
        PG8_STAGE(PG8_SB(0, 0), cB, voffB); PG8_STAGE(PG8_SB(0, 1), cB + hstep, voffB); PG8_STAGE(PG8_SA(0, 0), cA, voffA); PG8_STAGE(PG8_SA(0, 1), cA + hstep, voffA);
        if (wr == 1) PG8_BAR;
        PG8_WAIT_V(2); PG8_BAR;
        PG8_STAGE(PG8_SB(1, 0), cB + kstep, voffB); PG8_STAGE(PG8_SA(1, 0), cA + kstep, voffA); PG8_STAGE(PG8_SB(1, 1), cB + hstep + kstep, voffB);
        PG8_WAIT_V(6); PG8_BAR;
    } else {
        PG8_STAGE(PG8_SB(0, 0), cB, voffB); PG8_STAGE(PG8_SA(0, 0), cA, voffA); PG8_STAGE(PG8_SB(0, 1), cB + hstep, voffB); PG8_STAGE(PG8_SA(0, 1), cA + hstep, voffA);
        if (wr == 1) PG8_BAR;
        PG8_WAIT_V(4); PG8_BAR;
        PG8_STAGE(PG8_SB(1, 0), cB + kstep, voffB); PG8_STAGE(PG8_SA(1, 0), cA + kstep, voffA); PG8_STAGE(PG8_SB(1, 1), cB + hstep + kstep, voffB);
        PG8_WAIT_V(6); PG8_BAR;
    }
    for (;;) {
        const bool has_next = S.next(ui + 1, nxt);
        const char* nA = has_next ? (const char*)g.A + (size_t)nxt.pm * tstep + (size_t)nxt.koff * 2 : cA; const char* nB = has_next ? (const char*)g.Bt + (size_t)nxt.pn * tstep + (size_t)nxt.koff * 2 : cB;
        const int nt = cur.nt;
        for (int t = 0; t < nt; t += 2) {
            const bool last = (t == nt - 2);
            const char* a1 = cA + (size_t)(t + 1) * kstep;
            const char* a2 = last ? nA : cA + (size_t)(t + 2) * kstep; const char* b2 = last ? nB : cB + (size_t)(t + 2) * kstep;
            const char* a3 = a2 + kstep; const char* b3 = b2 + kstep;
            if (last && has_next) S.a_ready(nxt);
            if constexpr (SP2) {
            PG8_LDB(B0, 0, 0); PG8_LDB(B1, 0, 1); PG8_SCHED; PG8_LDA(At, 0, 0); PG8_STAGE(PG8_SA(1, 1), a1 + hstep, voffA);
            PG8_WAIT_V(8); PG8_WAIT_L(0); PG8_BAR; PG8_MMA(0, 0, At, B0); PG8_MMA(0, 1, At, B1); PG8_BAR; PG8_SCHED;
            PG8_LDA(At, 0, 1); PG8_STAGE(PG8_SB(0, 0), b2, voffB); PG8_STAGE(PG8_SB(0, 1), b2 + hstep, voffB); PG8_STAGE(PG8_SA(0, 0), a2, voffA);
            PG8_WAIT_V(8); PG8_WAIT_L(0); PG8_BAR; PG8_MMA(1, 0, At, B0); PG8_MMA(1, 1, At, B1); PG8_BAR; PG8_SCHED;
            PG8_LDB(B0, 1, 0); PG8_LDB(B1, 1, 1); PG8_SCHED; PG8_LDA(At, 1, 0); PG8_STAGE(PG8_SA(0, 1), a2 + hstep, voffA);
            PG8_WAIT_V(8); PG8_WAIT_L(0); PG8_BAR; PG8_MMA(0, 0, At, B0); PG8_MMA(0, 1, At, B1); PG8_BAR; PG8_SCHED;
            PG8_LDA(At, 1, 1); PG8_STAGE(PG8_SB(1, 0), b3, voffB); PG8_STAGE(PG8_SB(1, 1), b3 + hstep, voffB); PG8_STAGE(PG8_SA(1, 0), a3, voffA);
            PG8_WAIT_V(8); PG8_WAIT_L(0); PG8_BAR; PG8_MMA(1, 0, At, B0); PG8_MMA(1, 1, At, B1); PG8_BAR; PG8_SCHED;
            } else {
            PG8_LDB(B0, 0, 0); PG8_SCHED; PG8_LDA(At, 0, 0); PG8_STAGE(PG8_SA(1, 1), a1 + hstep, voffA);
            PG8_WAIT_L(8); PG8_BAR; PG8_WAIT_L(0); PG8_MMA(0, 0, At, B0); PG8_BAR; PG8_SCHED;
            PG8_LDB(B1, 0, 1); PG8_STAGE(PG8_SB(0, 0), b2, voffB);
            PG8_BAR; PG8_WAIT_L(0); PG8_MMA(0, 1, At, B1); PG8_BAR;
            PG8_LDA(At, 0, 1); PG8_STAGE(PG8_SA(0, 0), a2, voffA);
            PG8_BAR; PG8_WAIT_L(0); PG8_MMA(1, 0, At, B0); PG8_BAR; PG8_SCHED;
            PG8_STAGE(PG8_SB(0, 1), b2 + hstep, voffB);
            PG8_WAIT_V(6); PG8_BAR; PG8_MMA(1, 1, At, B1); PG8_BAR;
            PG8_LDB(B0, 1, 0); PG8_SCHED; PG8_LDA(At, 1, 0); PG8_STAGE(PG8_SA(0, 1), a2 + hstep, voffA);
            PG8_WAIT_L(8); PG8_BAR; PG8_WAIT_L(0); PG8_MMA(0, 0, At, B0); PG8_BAR; PG8_SCHED;
            PG8_LDB(B1, 1, 1); PG8_STAGE(PG8_SB(1, 0), b3, voffB);
            PG8_BAR; PG8_WAIT_L(0); PG8_MMA(0, 1, At, B1); PG8_BAR;
            PG8_LDA(At, 1, 1); PG8_STAGE(PG8_SA(1, 0), a3, voffA);
            PG8_BAR; PG8_WAIT_L(0); PG8_MMA(1, 0, At, B0); PG8_BAR; PG8_SCHED;
            PG8_STAGE(PG8_SB(1, 1), b3 + hstep, voffB);
            PG8_WAIT_V(6); PG8_BAR; PG8_MMA(1, 1, At, B1); PG8_BAR;
            }
        }
        if constexpr (ALIGN_EPI) { if (wr == 0) PG8_BAR; }
        if constexpr (!Epi::AFTER_DRAIN) { E(acc, cur, wr, wc, fr, fq); S.done(cur); }
        if (!has_next) break;
#pragma unroll
        for (int a = 0; a < 2; ++a)
#pragma unroll
            for (int b = 0; b < 2; ++b)
#pragma unroll
                for (int m = 0; m < 4; ++m)
#pragma unroll
                    for (int n = 0; n < 2; ++n) acc[a][b][m][n] = (f32x4){0.f, 0.f, 0.f, 0.f};
        cur = nxt; cA = nA; cB = nB; ++ui;
        if constexpr (ALIGN_EPI) { if (wr == 1) PG8_BAR; }
    }
    PG8_WAIT_V(0);
    if constexpr (!ALIGN_EPI) { if (wr == 0) PG8_BAR; }
    PG8_BAR;
    if constexpr (Epi::AFTER_DRAIN) { E.fused(acc, cur, wr, wc, fr, fq, lds, wid, lane); S.done(cur); }
#undef PG8_SA
#undef PG8_SB
#undef PG8_STAGE
#undef PG8_LDA
#undef PG8_LDB
#undef PG8_MMA
#undef PG8_WAIT_V
#undef PG8_WAIT_L
#undef PG8_BAR
#undef PG8_SCHED
}
}

#ifndef MK_REP
#define MK_REP -1
#endif
#ifndef MK_TS
#define MK_TS -1
#endif
constexpr int NWAVES = 8, NTHR = 512;
constexpr int MT = 8704, MP = 8192, DM = 2048, DIN = 4352, DSSM = 1024, DRW = 1024, DSH = 3328, DFF = 5632, NMEM = 256;
constexpr float ALPHA = 1.189207115002721f;
constexpr float LN_EPS = 1e-5f, GN_EPS = 64e-5f;
constexpr size_t O_Y = 0, O_SRE_P = (size_t)MT * DM, O_SIM_P = O_SRE_P + 16384, O_WKV_P = O_SIM_P + 16384, O_SH_P = O_WKV_P + 262144, O_MK = O_SH_P + 4 * DSH,
                 O_MV = O_MK + 2097152, O_SRE_S = O_MV + 2097152, O_SIM_S = O_SRE_S + 524288, O_WKV_S = O_SIM_S + 524288, O_SH_S = O_WKV_S + 8388608, O_END = O_SH_S + 128 * DSH;
static_assert(O_END == 32191488, "output size");
constexpr size_t MiB = 1u << 20;
constexpr size_t WS_CTL = 0, WS_WIN = 1 * MiB, WS_WGLU = 18 * MiB, WS_WOUT = 20 * MiB, WS_WQ = 28 * MiB, WS_WKV = 36 * MiB, WS_WO = 52 * MiB, WS_WGU = 60 * MiB, WS_WDN = 104 * MiB,
                 WS_W2T = 126 * MiB, WS_A2T = WS_W2T + 131072, WS_G2T = WS_W2T + 262144, WS_KB = 127 * MiB, WS_VTB = 131 * MiB, WS_XB = 135 * MiB, WS_MB = 169 * MiB,
                 WS_H = 173 * MiB, WS_R = WS_H, WS_X = WS_H + 72 * MiB, WS_PREP = 318 * MiB, WS_BONUS = 706 * MiB, WS_QB = WS_PREP, WS_OB = WS_PREP + 34 * MiB, WS_HFF = WS_PREP + 68 * MiB,
                 WS_YR = 557 * MiB, WS_YGB = 591 * MiB, WS_MIX = 608 * MiB, WS_PART = 642 * MiB, WS_BON4 = 706 * MiB, WS_END = 709 * MiB;
constexpr size_t PREP_STRIDE = 34 * MiB;
constexpr int LDS_BYTES = 135168;
constexpr int MISC_OFF = 131072;
constexpr int NPHASE = 14;

#define LAS __attribute__((address_space(3)))
typedef unsigned short bf16;
typedef unsigned v4u __attribute__((ext_vector_type(4)));
typedef unsigned v2u __attribute__((ext_vector_type(2)));
typedef float f32x4 __attribute__((ext_vector_type(4)));
typedef float f32x2 __attribute__((ext_vector_type(2)));
typedef float f32x16 __attribute__((ext_vector_type(16)));
typedef short bf16x8 __attribute__((ext_vector_type(8)));
#define LDS_WAIT() asm volatile("s_waitcnt lgkmcnt(0)" ::: "memory")

__device__ __forceinline__ unsigned pk2(float lo, float hi) { return pg8::cvt_pk_bf16(lo, hi); }
__device__ __forceinline__ bf16x8 pack_bf8(const f32x4 a, const f32x4 b) { v4u w; w.x = pk2(a[0], a[1]); w.y = pk2(a[2], a[3]); w.z = pk2(b[0], b[1]); w.w = pk2(b[2], b[3]); return __builtin_bit_cast(bf16x8, w); }
__device__ __forceinline__ f32x4 ldbf4(const bf16* p) { const v2u w = *(const v2u*)p; return (f32x4){pg8::bf_lo(w.x), pg8::bf_hi(w.x), pg8::bf_lo(w.y), pg8::bf_hi(w.y)}; }
__device__ __forceinline__ void stnt4(float* p, const f32x4 x) { __builtin_nontemporal_store(x, (f32x4*)p); }
__device__ __forceinline__ f32x4 ldnt4(const float* p) { return __builtin_nontemporal_load((const f32x4*)p); }
__device__ __forceinline__ float wave_sum(float v) {
#pragma unroll
    for (int o = 1; o < 64; o <<= 1) v += __shfl_xor(v, o);
    return v;
}
__device__ __forceinline__ float wave_max(float v) {
#pragma unroll
    for (int o = 1; o < 64; o <<= 1) v = fmaxf(v, __shfl_xor(v, o));
    return v;
}
template <int CTRL> __device__ __forceinline__ float dpp_f(float x) { return __builtin_bit_cast(float, __builtin_amdgcn_update_dpp(0, __builtin_bit_cast(int, x), CTRL, 0xf, 0xf, false)); }
__device__ __forceinline__ float sum16(float x) { x += dpp_f<0xB1>(x); x += dpp_f<0x4E>(x); x += dpp_f<0x141>(x); x += dpp_f<0x140>(x); return x; }
__device__ __forceinline__ float sigm(float x) { return __builtin_amdgcn_rcpf(1.0f + __expf(-x)); }
__device__ __forceinline__ float tanh_(float x) { return 1.0f - 2.0f * __builtin_amdgcn_rcpf(1.0f + __expf(2.0f * x)); }
__device__ __forceinline__ float gelu_tanh(float x) { const float u = 1.5957691216057308f * (x + 0.044715f * x * x * x); return x * __builtin_amdgcn_rcpf(1.0f + __expf(-u)); }
#define MFMA16(a, b, c) __builtin_amdgcn_mfma_f32_16x16x32_bf16((a), (b), (c), 0, 0, 0)
#define MFMA32(a, b, c) __builtin_amdgcn_mfma_f32_32x32x16_bf16((a), (b), (c), 0, 0, 0)

struct Args { const float* in[45]; float* out; unsigned char* ws; int lo, hi; };

struct Frame {
    LAS unsigned char* lds; volatile LAS unsigned* MISC;
    int tid, lane, wave, G, bid;
    const float* const* in; float* out; unsigned char* ws;
};

__device__ __forceinline__ void tr_item(const float* W, int K, int N, bf16* WT, int drow0, int k0, int n0, LAS float* scr, int lane) {
    const int kr = lane >> 4, nq = lane & 15;
    f32x4 t[8];
#pragma unroll
    for (int i = 0; i < 8; ++i) t[i] = ldnt4(W + (size_t)(k0 + 4 * i + kr) * N + n0 + 4 * nq);
#pragma unroll
    for (int i = 0; i < 8; ++i) { const int row = 4 * i + kr, c = i >> 1; *(LAS f32x4*)(scr + row * 68 + ((4 * nq + 8 * c) & 63)) = t[i]; }
    LDS_WAIT(); asm volatile("" ::: "memory");
    const int c = lane & 3;
#pragma unroll
    for (int p = 0; p < 4; ++p) { const int n = (lane >> 2) + 16 * p; const LAS float* s = scr + (8 * c) * 68 + ((n + 8 * c) & 63);
        v4u o; o.x = pk2(s[0 * 68], s[1 * 68]); o.y = pk2(s[2 * 68], s[3 * 68]); o.z = pk2(s[4 * 68], s[5 * 68]); o.w = pk2(s[6 * 68], s[7 * 68]);
        *(v4u*)(WT + (size_t)(drow0 + n) * K + k0 + 8 * c) = o; }
    LDS_WAIT(); asm volatile("" ::: "memory");
}
__device__ __forceinline__ void p0_prologue(Frame& F) {
    LAS float* scr = (LAS float*)(F.lds + F.wave * 16384);
    const int gw = F.bid * NWAVES + F.wave, NGW = F.G * NWAVES, lane = F.lane;
    unsigned char* ws = F.ws;
#define TR_MAT(Wp, Kk, Nn, Dst, ROWMAP) { const int nblk = (Nn) / 64, cnt = ((Kk) / 32) * nblk; if (r < cnt) { const int kb = r / nblk, n0 = (r % nblk) * 64; \
        tr_item((Wp), (Kk), (Nn), (bf16*)(Dst), (ROWMAP), kb * 32, n0, scr, lane); continue; } r -= cnt; }
    constexpr int NITEMS = 32 * 136 + 2 * 32 * 64 + 32 + 32 + 64;
    for (int it = gw; it < NITEMS; it += NGW) {
        int r = it;
        TR_MAT(F.in[9], DM, DIN, ws + WS_WIN, n0)
        TR_MAT(F.in[35], DM, DM, ws + WS_WKV, n0)
        TR_MAT(F.in[36], DM, DM, ws + WS_WKV, 2048 + n0)
        TR_MAT(F.in[22], 64, DRW, ws + WS_W2T, n0)
        TR_MAT(F.in[24], 64, DRW, ws + WS_A2T, n0)
        TR_MAT(F.in[25], 128, DRW, ws + WS_G2T, n0)
    }
#undef TR_MAT
    const size_t gt = (size_t)F.bid * NTHR + F.tid, NGT = (size_t)F.G * NTHR;
    { const f32x4* xp = (const f32x4*)F.in[0]; const f32x4* xs = (const f32x4*)F.in[1]; v4u* xb = (v4u*)(ws + WS_XB);
      const size_t np = (size_t)MP * DM / 8, nt = (size_t)MT * DM / 8;
      for (size_t i0 = gt; i0 < nt; i0 += 4 * NGT) {
          f32x4 a[4], b[4];
#pragma unroll
          for (int u = 0; u < 4; ++u) { const size_t i = i0 + (size_t)u * NGT; if (i < nt) { const f32x4* s_ = i < np ? xp + 2 * i : xs + 2 * (i - np); a[u] = ldnt4((const float*)s_); b[u] = ldnt4((const float*)(s_ + 1)); } }
#pragma unroll
          for (int u = 0; u < 4; ++u) { const size_t i = i0 + (size_t)u * NGT; if (i < nt) xb[i] = pg8::pack8(a[u], b[u]); } } }
    { const f32x4* mp = (const f32x4*)F.in[2]; v4u* mb = (v4u*)(ws + WS_MB); const size_t nm = (size_t)1024 * DM / 8;
      for (size_t i = gt; i < nm; i += NGT) { const f32x4 a = ldnt4((const float*)(mp + 2 * i)), b = ldnt4((const float*)(mp + 2 * i + 1)); mb[i] = pg8::pack8(a, b); } }
}

constexpr int N_TR_LATE = 16 * 32 + 3 * 32 * 64 + 2 * 32 * 176 + 88 * 64;
__device__ __forceinline__ void tr_late_item(Frame& F, int r, LAS float* scr) {
    constexpr int C0 = 16 * 32, C1 = 32 * 64, C4 = 32 * 176;
    int id, rr = r;
    if (rr < C0) id = 0; else { rr -= C0; if (rr < 3 * C1) { id = 1 + rr / C1; rr = rr % C1; } else { rr -= 3 * C1; if (rr < 2 * C4) { id = 4 + rr / C4; rr = rr % C4; } else { rr -= 2 * C4; id = 6; } } }
    const int K = id == 0 ? DSSM : (id == 6 ? DFF : DM), N = id == 0 ? DSSM : ((id == 4 || id == 5) ? DFF : DM);
    const int src = id == 0 ? 18 : id == 1 ? 31 : id == 2 ? 34 : id == 3 ? 37 : id == 4 ? 40 : id == 5 ? 41 : 42;
    const size_t dsto = id == 0 ? WS_WGLU : id == 1 ? WS_WOUT : id == 2 ? WS_WQ : id == 3 ? WS_WO : id == 6 ? WS_WDN : WS_WGU;
    const int nblk = N / 64, kb = rr / nblk, n0 = (rr % nblk) * 64;
    const int drow0 = (id == 4 || id == 5) ? 256 * (n0 / 128) + (n0 % 128) + (id == 5 ? 128 : 0) : n0;
    tr_item(F.in[src], K, N, (bf16*)(F.ws + dsto), drow0, kb * 32, n0, scr, F.lane);
}

__device__ __forceinline__ void p2_prep(Frame& F) {
    const bf16* H = (const bf16*)(F.ws + WS_H);
    const float* mu = F.in[20]; const float* w0 = F.in[21]; const float* a0 = F.in[23]; const float* k_k = F.in[26]; const float* k_a = F.in[27]; const float* r_k = F.in[28];
    const bf16* W2T = (const bf16*)(F.ws + WS_W2T); const bf16* A2T = (const bf16*)(F.ws + WS_A2T); const bf16* G2T = (const bf16*)(F.ws + WS_G2T);
    float* PR = (float*)(F.ws + WS_PREP); constexpr size_t PS = PREP_STRIDE / 4;
    float* BON = (float*)(F.ws + WS_BONUS);
    const int lane = F.lane, fr = lane & 15, fq = lane >> 4, tid = F.tid, w = F.wave;
    LAS bf16* ACT = (LAS bf16*)F.lds;
    LAS float* PRE = (LAS float*)(F.lds + 8448);
    struct CSet { f32x4 mr, mk, mv, w04, a04, kk4, ka4, rk4, r[2], k[2], v[2], rq[2], kq[2], vq[2]; };
#define P2_ALOAD(item_, X0, X1, Q0, Q1) do { const int tk_ = tid >> 5, c8_ = (tid & 31) * 8, m_ = ((item_) >> 1) * 16 + tk_; \
        const bf16* prow_ = H + (size_t)m_ * DIN + 1024 + 3072 + c8_; const bool prompt_ = m_ < MP; const int t_ = prompt_ ? (m_ & 2047) : ((m_ - MP) & 3); \
        X0 = ldbf4(prow_); X1 = ldbf4(prow_ + 4); \
        if (t_ > 0) { Q0 = ldbf4(prow_ - DIN); Q1 = ldbf4(prow_ - DIN + 4); } \
        else if (prompt_) { Q0 = (f32x4){0.f, 0.f, 0.f, 0.f}; Q1 = Q0; } \
        else { const float* qrow_ = F.in[6] + (size_t)((m_ - MP) >> 2) * DSH + 3072 + c8_; Q0 = *(const f32x4*)qrow_; Q1 = *(const f32x4*)(qrow_ + 4); } } while (0)
#define P2_CLOAD(CS, tile_, half_, j_) do { const int col_ = 512 * (half_) + 4 * lane + 256 * (j_); \
        CS.mr = *(const f32x4*)(mu + col_); CS.mk = *(const f32x4*)(mu + 1024 + col_); CS.mv = *(const f32x4*)(mu + 2048 + col_); \
        CS.w04 = *(const f32x4*)(w0 + col_); CS.a04 = *(const f32x4*)(a0 + col_); CS.kk4 = *(const f32x4*)(k_k + col_); CS.ka4 = *(const f32x4*)(k_a + col_); CS.rk4 = *(const f32x4*)(r_k + col_); \
        _Pragma("unroll") for (int tq_ = 0; tq_ < 2; ++tq_) { const int m_ = (tile_) * 16 + 2 * w + tq_; const bf16* prow_ = H + (size_t)m_ * DIN + 1024 + col_; \
            const bool prompt_ = m_ < MP; const int t_ = prompt_ ? (m_ & 2047) : ((m_ - MP) & 3); \
            CS.r[tq_] = ldbf4(prow_); CS.k[tq_] = ldbf4(prow_ + 1024); CS.v[tq_] = ldbf4(prow_ + 2048); \
            if (t_ > 0) { CS.rq[tq_] = ldbf4(prow_ - DIN); CS.kq[tq_] = ldbf4(prow_ - DIN + 1024); CS.vq[tq_] = ldbf4(prow_ - DIN + 2048); } \
            else if (prompt_) { CS.rq[tq_] = (f32x4){0.f, 0.f, 0.f, 0.f}; CS.kq[tq_] = CS.rq[tq_]; CS.vq[tq_] = CS.rq[tq_]; } \
            else { const float* qrow_ = F.in[6] + (size_t)((m_ - MP) >> 2) * DSH + col_; CS.rq[tq_] = *(const f32x4*)qrow_; CS.kq[tq_] = *(const f32x4*)(qrow_ + 1024); CS.vq[tq_] = *(const f32x4*)(qrow_ + 2048); } } } while (0)
#define P2_CCOMP(CS, tile_, half_, j_) do { const int lc_ = 4 * lane + 256 * (j_), col_ = 512 * (half_) + lc_, hd_ = 8 * (half_) + 4 * (j_) + (lane >> 4); \
        _Pragma("unroll") for (int tq_ = 0; tq_ < 2; ++tq_) { const int tk_ = 2 * w + tq_, m_ = (tile_) * 16 + tk_; \
            const f32x4 r4 = CS.r[tq_] + (CS.rq[tq_] - CS.r[tq_]) * CS.mr, k4 = CS.k[tq_] + (CS.kq[tq_] - CS.k[tq_]) * CS.mk, v4 = CS.v[tq_] + (CS.vq[tq_] - CS.v[tq_]) * CS.mv; \
            const f32x4 pW = *(const LAS f32x4*)(PRE + (0 * 16 + tk_) * 516 + lc_), pA = *(const LAS f32x4*)(PRE + (1 * 16 + tk_) * 516 + lc_), pG = *(const LAS f32x4*)(PRE + (2 * 16 + tk_) * 516 + lc_); \
            f32x4 dec, a, km, kkr; float ss = 0.f; \
            _Pragma("unroll") for (int e = 0; e < 4; ++e) {   \
                dec[e] = __expf(-0.6065306597126334f * sigm(CS.w04[e] + pW[e])); a[e] = sigm(CS.a04[e] + pA[e]); km[e] = k4[e] * (1.0f + (a[e] - 1.0f) * CS.ka4[e]); \
                kkr[e] = k4[e] * CS.kk4[e]; ss += kkr[e] * kkr[e]; } \
            ss = sum16(ss); \
            const float inv = rsqrtf(fmaxf(ss, 1e-24f)); \
            const f32x4 kk = kkr * inv, bb = kk * a; \
            float bon = (r4[0] * km[0] * CS.rk4[0] + r4[1] * km[1] * CS.rk4[1]) + (r4[2] * km[2] * CS.rk4[2] + r4[3] * km[3] * CS.rk4[3]); \
            float br = (bb[0] * r4[0] + bb[1] * r4[1]) + (bb[2] * r4[2] + bb[3] * r4[3]); \
            float kr = (km[0] * r4[0] + km[1] * r4[1]) + (km[2] * r4[2] + km[3] * r4[3]); \
            bon = sum16(bon); br = sum16(br); kr = sum16(kr); \
            const size_t o = (size_t)m_ * 1024 + col_; \
            *(f32x4*)(PR + 0 * PS + o) = dec * r4; *(f32x4*)(PR + 1 * PS + o) = dec; *(f32x4*)(PR + 2 * PS + o) = km; *(f32x4*)(PR + 3 * PS + o) = v4; \
            *(f32x4*)(PR + 4 * PS + o) = -kk; *(f32x4*)(PR + 5 * PS + o) = bb; *(f32x4*)(PR + 6 * PS + o) = pG; \
            if ((lane & 15) == 0) *(f32x4*)(BON + ((size_t)m_ * 16 + hd_) * 4) = (f32x4){bon, br, kr, 0.f}; } } while (0)
    const int NIT = 2 * (MT / 16);
    f32x4 ax0, ax1, aq0, aq1;
    if (F.bid < NIT) P2_ALOAD(F.bid, ax0, ax1, aq0, aq1);
    for (int item = F.bid; item < NIT; item += F.G) {
        const int tile = item >> 1, half = item & 1;
        { const int tk = tid >> 5, c8 = (tid & 31) * 8;
          const f32x4 m0 = *(const f32x4*)(mu + 3072 + c8), m1 = *(const f32x4*)(mu + 3072 + c8 + 4);
          f32x4 x0 = ax0 + (aq0 - ax0) * m0, x1 = ax1 + (aq1 - ax1) * m1;
          if (c8 < 64) {
#pragma unroll
              for (int j = 0; j < 4; ++j) { x0[j] = tanh_(x0[j]); x1[j] = tanh_(x1[j]); }
          } else if (c8 >= 128) {
#pragma unroll
              for (int j = 0; j < 4; ++j) { x0[j] = sigm(x0[j]); x1[j] = sigm(x1[j]); } }
          *(LAS bf16x8*)(ACT + tk * 264 + c8) = pack_bf8(x0, x1); }
        CSet c0; P2_CLOAD(c0, tile, half, 0);
        __syncthreads();
        bf16x8 bw[2], ba[2], bg[4];
#pragma unroll
        for (int kc = 0; kc < 2; ++kc) { bw[kc] = *(const LAS bf16x8*)(ACT + fr * 264 + 32 * kc + 8 * fq); ba[kc] = *(const LAS bf16x8*)(ACT + fr * 264 + 64 + 32 * kc + 8 * fq); }
#pragma unroll
        for (int kc = 0; kc < 4; ++kc) bg[kc] = *(const LAS bf16x8*)(ACT + fr * 264 + 128 + 32 * kc + 8 * fq);
        { const int hd = 8 * half + w;
#pragma unroll
          for (int ct = 0; ct < 4; ++ct) { const int c = 64 * hd + 16 * ct + fr;
              f32x4 aW = (f32x4){0.f, 0.f, 0.f, 0.f}, aA = aW, aG = aW;
#pragma unroll
              for (int kc = 0; kc < 2; ++kc) { aW = MFMA16(*(const bf16x8*)(W2T + c * 64 + 32 * kc + 8 * fq), bw[kc], aW);
                                                aA = MFMA16(*(const bf16x8*)(A2T + c * 64 + 32 * kc + 8 * fq), ba[kc], aA); }
#pragma unroll
              for (int kc = 0; kc < 4; ++kc) aG = MFMA16(*(const bf16x8*)(G2T + c * 128 + 32 * kc + 8 * fq), bg[kc], aG);
              const int lc = 64 * w + 16 * ct + 4 * fq;
              *(LAS f32x4*)(PRE + (0 * 16 + fr) * 516 + lc) = aW; *(LAS f32x4*)(PRE + (1 * 16 + fr) * 516 + lc) = aA; *(LAS f32x4*)(PRE + (2 * 16 + fr) * 516 + lc) = aG; } }
        CSet c1; P2_CLOAD(c1, tile, half, 1);
        if (item + F.G < NIT) P2_ALOAD(item + F.G, ax0, ax1, aq0, aq1);
        __syncthreads();
        P2_CCOMP(c0, tile, half, 0);
        P2_CCOMP(c1, tile, half, 1);
        __syncthreads();
    }
#undef P2_ALOAD
#undef P2_CLOAD
#undef P2_CCOMP
    { const int gt = F.bid * NTHR + F.tid, NGT = F.G * NTHR;
      for (int i = gt; i < 132 * (DSH / 4); i += NGT) { const int s = i / (DSH / 4), c4 = i % (DSH / 4);
          const int m = s < 4 ? s * 2048 + 2047 : MP + 4 * (s - 4) + 3;
          float* o = s < 4 ? F.out + O_SH_P + (size_t)s * DSH : F.out + O_SH_S + (size_t)(s - 4) * DSH;
          stnt4(o + 4 * c4, ldbf4(H + (size_t)m * DIN + 1024 + 4 * c4)); } }
}

__device__ __forceinline__ void grp_bar(volatile LAS unsigned* cnt, unsigned& gen, int lane) {
    gen += 4u; LDS_WAIT();
    if (lane == 0) (void)__hip_atomic_fetch_add((LAS unsigned*)cnt, 1u, __ATOMIC_RELAXED, __HIP_MEMORY_SCOPE_WORKGROUP);
    while (*cnt < gen) __builtin_amdgcn_s_sleep(1);
    asm volatile("" ::: "memory");
}
__device__ __forceinline__ void rwkv_scan_prompt(Frame& F, int b, int h, int quarter) {
    const float* PR = (const float*)(F.ws + WS_PREP); constexpr size_t PS = PREP_STRIDE / 4;
    const float* BON = (const float*)(F.ws + WS_BONUS);
    float* YR = (float*)(F.ws + WS_YR);
    const int tid = F.tid, lane = F.lane, rr = lane >> 4, kq = lane & 15, v = 16 * quarter + 4 * F.wave + rr, m0 = b * 2048;
    constexpr int SST = 388, BST = 16 * SST;
    LAS float* buf = (LAS float*)F.lds;
    volatile LAS unsigned* cnt = F.MISC + 16; unsigned gen = 0u;
    f32x4 S = (f32x4){0.f, 0.f, 0.f, 0.f};
    const int step_l = tid >> 4, part = tid & 15;
    f32x4 stP[6], sbP, stQ[6], sbQ;
#define RW_GLOAD(c, ST, SB) do { const size_t off_ = (size_t)(m0 + (c) * 16 + step_l) * 1024 + h * 64 + 4 * part; \
        ST[0] = *(const f32x4*)(PR + 1 * PS + off_); ST[1] = *(const f32x4*)(PR + 4 * PS + off_); ST[2] = *(const f32x4*)(PR + 5 * PS + off_); \
        ST[3] = *(const f32x4*)(PR + 2 * PS + off_); ST[4] = *(const f32x4*)(PR + 0 * PS + off_); ST[5] = *(const f32x4*)(PR + 3 * PS + off_); \
        if (part == 0) SB = *(const f32x4*)(BON + ((size_t)(m0 + (c) * 16 + step_l) * 16 + h) * 4); } while (0)
#define RW_LSTORE(bi, ST, SB) do { LAS float* d_ = buf + (bi) * BST + step_l * SST + 4 * part; _Pragma("unroll") for (int q = 0; q < 6; ++q) *(LAS f32x4*)(d_ + q * 64) = ST[q]; \
        if (part == 0) *(LAS f32x4*)(d_ + 384) = SB; } while (0)
#define RW_LREAD(sb_, W_, NK_, B_, K_, WR_, VV_, SC_) do { W_ = *(const LAS f32x4*)((sb_) + 4 * kq); NK_ = *(const LAS f32x4*)((sb_) + 64 + 4 * kq); B_ = *(const LAS f32x4*)((sb_) + 128 + 4 * kq); \
        K_ = *(const LAS f32x4*)((sb_) + 192 + 4 * kq); WR_ = *(const LAS f32x4*)((sb_) + 256 + 4 * kq); VV_ = (sb_)[320 + v]; SC_ = *(const LAS f32x4*)((sb_) + 384); } while (0)
#define RW_CHUNK(c, cb) do { float yk = 0.f; f32x4 nw, nnk, nb, nk, nwr, nsc; float nvv; \
        RW_LREAD((cb), nw, nnk, nb, nk, nwr, nvv, nsc); \
        _Pragma("unroll") for (int s = 0; s < 16; ++s) { \
            const f32x4 w4 = nw, nk4 = nnk, b4 = nb, k4 = nk, wr4 = nwr, sc = nsc; const float vv = nvv; \
            if (s + 1 < 16) RW_LREAD((cb) + (s + 1) * SST, nw, nnk, nb, nk, nwr, nvv, nsc); \
            float sa = (S[0] * nk4[0] + S[1] * nk4[1]) + (S[2] * nk4[2] + S[3] * nk4[3]); \
            float p = (S[0] * wr4[0] + S[1] * wr4[1]) + (S[2] * wr4[2] + S[3] * wr4[3]); \
            sa += dpp_f<0xB1>(sa); p += dpp_f<0xB1>(p); sa += dpp_f<0x4E>(sa); p += dpp_f<0x4E>(p); \
            sa += dpp_f<0x141>(sa); p += dpp_f<0x141>(p); sa += dpp_f<0x140>(sa); p += dpp_f<0x140>(p); \
            S = S * w4 + (b4 * sa + k4 * vv); \
            const float y = p + sa * sc[1] + vv * sc[2]; \
            yk = (kq == s) ? y : yk; } \
        YR[(size_t)(m0 + 16 * (c) + kq) * 1024 + h * 64 + v] = yk; } while (0)
    sbP = (f32x4){0.f, 0.f, 0.f, 0.f}; sbQ = sbP;
    RW_GLOAD(0, stP, sbP); RW_LSTORE(0, stP, sbP); RW_GLOAD(1, stP, sbP); RW_GLOAD(2, stQ, sbQ); grp_bar(cnt, gen, lane);
    for (int c = 0; c < 128; c += 2) {
        RW_CHUNK(c, buf);
        RW_LSTORE(1, stP, sbP); grp_bar(cnt, gen, lane);
        if (c + 3 < 128) RW_GLOAD(c + 3, stP, sbP);
        RW_CHUNK(c + 1, buf + BST);
        if (c + 2 < 128) RW_LSTORE(0, stQ, sbQ);
        grp_bar(cnt, gen, lane);
        if (c + 4 < 128) RW_GLOAD(c + 4, stQ, sbQ);
    }
#undef RW_CHUNK
#undef RW_GLOAD
#undef RW_LSTORE
#undef RW_LREAD
    stnt4(F.out + O_WKV_P + (size_t)(b * 16 + h) * 4096 + v * 64 + 4 * kq, S);
}
__device__ __forceinline__ void rwkv_sample_item(Frame& F, int b, int h) {
    const float* PR = (const float*)(F.ws + WS_PREP); constexpr size_t PS = PREP_STRIDE / 4;
    const float* BON = (const float*)(F.ws + WS_BONUS);
    float* YR = (float*)(F.ws + WS_YR);
    const int lane = F.lane, rr = lane >> 4, kq = lane & 15, m0 = MP + 4 * b;
    const float* s_in = F.in[5] + (size_t)(b * 16 + h) * 4096; float* s_out = F.out + O_WKV_S + (size_t)(b * 16 + h) * 4096;
    f32x4 w4[4], nk4[4], b4[4], k4[4], wr4[4], sc[4];
#pragma unroll
    for (int t = 0; t < 4; ++t) { const size_t off = (size_t)(m0 + t) * 1024 + h * 64 + 4 * kq;
        w4[t] = *(const f32x4*)(PR + 1 * PS + off); nk4[t] = *(const f32x4*)(PR + 4 * PS + off); b4[t] = *(const f32x4*)(PR + 5 * PS + off);
        k4[t] = *(const f32x4*)(PR + 2 * PS + off); wr4[t] = *(const f32x4*)(PR + 0 * PS + off); sc[t] = *(const f32x4*)(BON + ((size_t)(m0 + t) * 16 + h) * 4); }
#pragma unroll 4
    for (int rg = 0; rg < 16; ++rg) { const int v = 4 * rg + rr;
        f32x4 S = ldnt4(s_in + v * 64 + 4 * kq);
        float vv[4];
#pragma unroll
        for (int t = 0; t < 4; ++t) vv[t] = PR[3 * PS + (size_t)(m0 + t) * 1024 + h * 64 + v];
        float yk = 0.f;
#pragma unroll
        for (int t = 0; t < 4; ++t) {
            float sa = (S[0] * nk4[t][0] + S[1] * nk4[t][1]) + (S[2] * nk4[t][2] + S[3] * nk4[t][3]);
            float p = (S[0] * wr4[t][0] + S[1] * wr4[t][1]) + (S[2] * wr4[t][2] + S[3] * wr4[t][3]);
            sa = sum16(sa); p = sum16(p);
            S = S * w4[t] + (b4[t] * sa + k4[t] * vv[t]);
            const float y = p + sa * sc[t][1] + vv[t] * sc[t][2];
            yk = (kq == t) ? y : yk;
        }
        if (kq < 4) YR[(size_t)(m0 + kq) * 1024 + h * 64 + v] = yk;
        stnt4(s_out + v * 64 + 4 * kq, S); }
}

template <int SEG> __device__ __forceinline__ void ssm_item(Frame& F, int g, int sel) {
    const bf16* H = (const bf16*)(F.ws + WS_H);
    bf16* YG = (bf16*)(F.ws + WS_YGB);
    const int lane = F.lane, n = lane & 31, hh = lane >> 5, fr = lane & 15, fq = lane >> 4;
    LAS bf16* ldsS = (LAS bf16*)(F.lds + 50176 + F.wave * 8704);
    const float dt = __expf(F.in[17][g]);
    float lr[2], li[2]; bf16x8 Bre[2], Bim[2];
#pragma unroll
    for (int pp = 0; pp < 2; ++pp) { const int p = 2 * n + pp; const float are = F.in[10][g * 64 + p], aim = F.in[11][g * 64 + p];
        const float mag = expf(are * dt), ang = aim * dt; float sn, cs; sincosf(ang, &sn, &cs); lr[pp] = mag * cs; li[pp] = mag * sn;
        const float sh = sinf(0.5f * ang); const float xr = expm1f(are * dt) * cs - 2.0f * sh * sh, xi = mag * sn;
        const float den = 1.0f / (are * are + aim * aim); const float qr = (xr * are + xi * aim) * den, qi = (xi * are - xr * aim) * den;
        const float* brp = F.in[12] + (size_t)(g * 64 + p) * 16 + 8 * hh; const float* bip = F.in[13] + (size_t)(g * 64 + p) * 16 + 8 * hh;
        const f32x4 br0 = *(const f32x4*)brp, br1 = *(const f32x4*)(brp + 4), bi0 = *(const f32x4*)bip, bi1 = *(const f32x4*)(bip + 4);
        Bre[pp] = pack_bf8(br0 * qr - bi0 * qi, br1 * qr - bi1 * qi); Bim[pp] = pack_bf8(bi0 * qr + br0 * qi, bi1 * qr + br1 * qi); }
    bf16x8 Cop[4];
#pragma unroll
    for (int kc = 0; kc < 4; ++kc) { const float* cp = (kc < 2 ? F.in[14] : F.in[15]) + (size_t)(g * 16 + fr) * 64 + 32 * (kc & 1) + 8 * fq; const float sg = kc < 2 ? 1.0f : -1.0f;
        Cop[kc] = pack_bf8(*(const f32x4*)cp * sg, *(const f32x4*)(cp + 4) * sg); }
    const f32x4 d4 = *(const f32x4*)(F.in[16] + 16 * g + 4 * fq);
    float sre[2] = {0.f, 0.f}, sim[2] = {0.f, 0.f};
    const int ntile = SEG == 16 ? 128 : 1;
    const int hr = (n >> 2) & 1, ir = 4 * (n >> 3) + (n & 3);
#define SSM_AROW(t_) (SEG == 16 ? (2 * sel + hr) * 2048 + (t_) * 16 + ir : MP + 4 * (8 * sel + 4 * hr + (ir >> 2)) + (ir & 3))
#define SSM_OROW(t_, rg_) (SEG == 16 ? (2 * sel + (rg_)) * 2048 + (t_) * 16 + fr : MP + 4 * (8 * sel + 4 * (rg_) + (fr >> 2)) + (fr & 3))
#define SSM_LOAD(t_, A0, A1_, U0, U1) do { A0 = *(const bf16x8*)(H + (size_t)SSM_AROW(t_) * DIN + 16 * g + 8 * hh); A1_ = A0; \
        U0 = *(const v2u*)(H + (size_t)SSM_OROW(t_, 0) * DIN + 16 * g + 4 * fq); U1 = *(const v2u*)(H + (size_t)SSM_OROW(t_, 1) * DIN + 16 * g + 4 * fq); } while (0)
    bf16x8 pa0[2], pa1[2]; v2u pu0[2], pu1[2];
    SSM_LOAD(0, pa0[0], pa1[0], pu0[0], pu1[0]);
    if (ntile > 1) SSM_LOAD(1, pa0[1], pa1[1], pu0[1], pu1[1]); else { pa0[1] = pa0[0]; pa1[1] = pa1[0]; pu0[1] = pu0[0]; pu1[1] = pu1[0]; }
    for (int tile = 0; tile < ntile; ++tile) {
        const bf16x8 ca0 = pa0[0]; const v2u cu[2] = {pu0[0], pu1[0]};
        pa0[0] = pa0[1]; pa1[0] = pa1[1]; pu0[0] = pu0[1]; pu1[0] = pu1[1];
        if (tile + 2 < ntile) SSM_LOAD(tile + 2, pa0[1], pa1[1], pu0[1], pu1[1]);
        const bf16x8 A1 = ca0;
        const f32x16 z16 = {0.f, 0.f, 0.f, 0.f, 0.f, 0.f, 0.f, 0.f, 0.f, 0.f, 0.f, 0.f, 0.f, 0.f, 0.f, 0.f};
        f32x16 aRe[2], aIm[2];
#pragma unroll
        for (int pp = 0; pp < 2; ++pp) { aRe[pp] = MFMA32(A1, Bre[pp], z16); aIm[pp] = MFMA32(A1, Bim[pp], z16); }
#pragma unroll
        for (int i = 0; i < 16; ++i) {
            if (SEG == 4 && (i & 3) == 0) { const int batch = 8 * sel + 4 * hh + (i >> 2); const size_t so = (size_t)(batch * 64 + g) * 64 + 2 * n;
                const f32x2 a = *(const f32x2*)(F.in[3] + so), b = *(const f32x2*)(F.in[4] + so); sre[0] = a[0]; sre[1] = a[1]; sim[0] = b[0]; sim[1] = b[1]; }
#pragma unroll
            for (int pp = 0; pp < 2; ++pp) { const float nr = lr[pp] * sre[pp] - li[pp] * sim[pp] + aRe[pp][i], ni = lr[pp] * sim[pp] + li[pp] * sre[pp] + aIm[pp][i]; sre[pp] = nr; sim[pp] = ni; }
            *(LAS unsigned*)(ldsS + (16 * hh + i) * 136 + 2 * n) = pk2(sre[0], sre[1]);
            *(LAS unsigned*)(ldsS + (16 * hh + i) * 136 + 64 + 2 * n) = pk2(sim[0], sim[1]);
            if (SEG == 4 && (i & 3) == 3) { const int batch = 8 * sel + 4 * hh + (i >> 2); const size_t so = (size_t)(batch * 64 + g) * 64 + 2 * n;
                *(f32x2*)(F.out + O_SRE_S + so) = (f32x2){sre[0], sre[1]}; *(f32x2*)(F.out + O_SIM_S + so) = (f32x2){sim[0], sim[1]}; }
        }
        LDS_WAIT(); asm volatile("" ::: "memory");
#pragma unroll
        for (int rg = 0; rg < 2; ++rg) {
            f32x4 aY = (f32x4){0.f, 0.f, 0.f, 0.f};
#pragma unroll
            for (int kc = 0; kc < 4; ++kc) aY = MFMA16(Cop[kc], *(const LAS bf16x8*)(ldsS + (16 * rg + fr) * 136 + 32 * kc + 8 * fq), aY);
            const int orow = SSM_OROW(tile, rg);
            const f32x4 u4 = (f32x4){pg8::bf_lo(cu[rg].x), pg8::bf_hi(cu[rg].x), pg8::bf_lo(cu[rg].y), pg8::bf_hi(cu[rg].y)};
            const f32x4 y = aY + d4 * u4;
            v2u w; w.x = pk2(gelu_tanh(y[0]), gelu_tanh(y[1])); w.y = pk2(gelu_tanh(y[2]), gelu_tanh(y[3]));
            *(v2u*)(YG + (size_t)orow * 1024 + 16 * g + 4 * fq) = w;
        }
        LDS_WAIT(); asm volatile("" ::: "memory");
    }
    if (SEG == 16) { const size_t so = (size_t)((2 * sel + hh) * 64 + g) * 64 + 2 * n;
        *(f32x2*)(F.out + O_SRE_P + so) = (f32x2){sre[0], sre[1]}; *(f32x2*)(F.out + O_SIM_P + so) = (f32x2){sim[0], sim[1]}; }
}

__device__ __forceinline__ void p3_scans(Frame& F, int rep) {
    unsigned* ctr = (unsigned*)(F.ws + WS_CTL) + 128 * rep;
    constexpr int N_SP = 128, N_RS = 2048, N_SS = 1024, TOTAL = N_SP + N_RS + N_SS + N_TR_LATE;
    if (F.tid == 0) F.MISC[16] = 0u;
    __syncthreads();
    if (F.wave < 4) { __builtin_amdgcn_s_setprio(3); for (int it = F.bid; it < 256; it += F.G) rwkv_scan_prompt(F, it >> 6, (it >> 2) & 15, it & 3); __builtin_amdgcn_s_setprio(0); }
    if (MK_TS >= 200 && F.bid == 0 && F.tid == 0) ((unsigned long long*)(F.ws + WS_CTL + 32768))[20] = __builtin_amdgcn_s_memrealtime();
    (void)ctr;
    if (F.wave >= 4) {
        const int q = (F.wave - 4) * F.G + F.bid, NQ = 4 * F.G;
        if (q < N_SP) { __builtin_amdgcn_s_setprio(2); ssm_item<16>(F, q >> 1, q & 1); __builtin_amdgcn_s_setprio(0); }
        else { const int i0 = q - N_SP, st = NQ - N_SP;
            for (int it = i0; it < N_RS; it += st) rwkv_sample_item(F, it >> 4, it & 15);
            for (int it = i0; it < N_SS; it += st) ssm_item<4>(F, it >> 4, it & 15);
            for (int it = i0; it < N_TR_LATE; it += st) tr_late_item(F, it, (LAS float*)(F.lds + 50176 + F.wave * 8704)); }
    }
    if (MK_TS >= 200 && F.bid == 0 && F.tid == 256) ((unsigned long long*)(F.ws + WS_CTL + 32768))[21] = __builtin_amdgcn_s_memrealtime();
}

__device__ __forceinline__ void p4_post(Frame& F, int rep) {
    unsigned* ctr = (unsigned*)(F.ws + WS_CTL) + 64 + 128 * rep;
    const float* PR = (const float*)(F.ws + WS_PREP); constexpr size_t PS = PREP_STRIDE / 4;
    const float* YR = (const float*)(F.ws + WS_YR); const float* BON = (const float*)(F.ws + WS_BONUS);
    const float* lg = F.in[29]; const float* lb = F.in[30];
    bf16* MIX = (bf16*)(F.ws + WS_MIX);
    const int lane = F.lane;
    for (;;) {
        __syncthreads();
        if (F.tid == 0) F.MISC[0] = atomicAdd(ctr, 1u);
        __syncthreads();
        const int it = (int)F.MISC[0];
        if (it >= MT / 16) break;
#pragma unroll
        for (int q = 0; q < 2; ++q) { const int m = it * 16 + 2 * F.wave + q;
#pragma unroll
            for (int j = 0; j < 4; ++j) { const int col = 256 * j + 4 * lane, hd = 4 * j + (lane >> 4); const size_t o = (size_t)m * 1024 + col;
                const f32x4 y = *(const f32x4*)(YR + o);
                const float mean = sum16((y[0] + y[1]) + (y[2] + y[3])) * (1.0f / 64.0f);
                const f32x4 d = y - mean;
                const float var = sum16((d[0] * d[0] + d[1] * d[1]) + (d[2] * d[2] + d[3] * d[3])) * (1.0f / 64.0f);
                const float rstd = rsqrtf(var + GN_EPS), bon = BON[((size_t)m * 16 + hd) * 4];
                const f32x4 v4 = *(const f32x4*)(PR + 3 * PS + o), g4 = *(const f32x4*)(PR + 6 * PS + o), lg4 = *(const f32x4*)(lg + col), lb4 = *(const f32x4*)(lb + col);
                const f32x4 ov = (d * rstd * lg4 + lb4 + v4 * bon) * g4;
                v2u w; w.x = pk2(ov[0], ov[1]); w.y = pk2(ov[2], ov[3]);
                *(v2u*)(MIX + (size_t)m * 2048 + 1024 + col) = w; } }
    }
}

__device__ __forceinline__ void ln_rows(Frame& F, const bf16* src, const float* gam, const float* bet, float* dstf, bf16* dstb, const float* sbase_f, const bf16* sbase_b, const float* part, int nsplit) {
    const int gw = F.bid * NWAVES + F.wave, NGW = F.G * NWAVES, lane = F.lane;
    const bool has_s = (gw & 3) == 0 && (gw >> 2) < (MT - MP);
#define LN_UNPK(W_, A_, B_) do { A_ = (f32x4){pg8::bf_lo(W_.x), pg8::bf_hi(W_.x), pg8::bf_lo(W_.y), pg8::bf_hi(W_.y)}; B_ = (f32x4){pg8::bf_lo(W_.z), pg8::bf_hi(W_.z), pg8::bf_lo(W_.w), pg8::bf_hi(W_.w)}; } while (0)
    for (int it = has_s ? -1 : 0; it < MP / NGW; it += (it < 0 ? 1 : 2)) {
        const int row0 = it < 0 ? MP + (gw >> 2) : gw + it * NGW, row1 = it < 0 ? row0 : row0 + NGW;
        f32x4 v[2][8];
        if (it < 0) {
            if (sbase_f) { const f32x4* sb = (const f32x4*)(sbase_f + (size_t)(row0 - MP) * DM) + 2 * lane;
#pragma unroll
                for (int j = 0; j < 4; ++j) { v[0][2 * j] = sb[128 * j] * ALPHA; v[0][2 * j + 1] = sb[128 * j + 1] * ALPHA; } }
            else { const v4u* sb = (const v4u*)(sbase_b + (size_t)(row0 - MP) * DM) + lane;
#pragma unroll
                for (int j = 0; j < 4; ++j) { const v4u w = sb[64 * j]; LN_UNPK(w, v[0][2 * j], v[0][2 * j + 1]); v[0][2 * j] = v[0][2 * j] * ALPHA; v[0][2 * j + 1] = v[0][2 * j + 1] * ALPHA; } }
#pragma unroll 4
            for (int ks = 0; ks < nsplit; ++ks) { const f32x4* pp = (const f32x4*)(part + ((size_t)ks * 512 + (row0 - MP)) * DM) + 2 * lane;
#pragma unroll
                for (int j = 0; j < 4; ++j) { v[0][2 * j] += pp[128 * j]; v[0][2 * j + 1] += pp[128 * j + 1]; } }
#pragma unroll
            for (int j = 0; j < 8; ++j) v[1][j] = v[0][j];
        } else { const v4u* s0 = (const v4u*)(src + (size_t)row0 * DM) + lane; const v4u* s1 = (const v4u*)(src + (size_t)row1 * DM) + lane;
#pragma unroll
            for (int j = 0; j < 4; ++j) { const v4u w0 = s0[64 * j], w1 = s1[64 * j]; LN_UNPK(w0, v[0][2 * j], v[0][2 * j + 1]); LN_UNPK(w1, v[1][2 * j], v[1][2 * j + 1]); } }
        float sm0 = 0.f, sm1 = 0.f;
#pragma unroll
        for (int j = 0; j < 8; ++j) { sm0 += (v[0][j][0] + v[0][j][1]) + (v[0][j][2] + v[0][j][3]); sm1 += (v[1][j][0] + v[1][j][1]) + (v[1][j][2] + v[1][j][3]); }
#pragma unroll
        for (int o = 1; o < 64; o <<= 1) { sm0 += __shfl_xor(sm0, o); sm1 += __shfl_xor(sm1, o); }
        const float mean0 = sm0 * (1.0f / DM), mean1 = sm1 * (1.0f / DM); float q0 = 0.f, q1 = 0.f;
#pragma unroll
        for (int j = 0; j < 8; ++j) { v[0][j] = v[0][j] - mean0; v[1][j] = v[1][j] - mean1;
            q0 += (v[0][j][0] * v[0][j][0] + v[0][j][1] * v[0][j][1]) + (v[0][j][2] * v[0][j][2] + v[0][j][3] * v[0][j][3]);
            q1 += (v[1][j][0] * v[1][j][0] + v[1][j][1] * v[1][j][1]) + (v[1][j][2] * v[1][j][2] + v[1][j][3] * v[1][j][3]); }
#pragma unroll
        for (int o = 1; o < 64; o <<= 1) { q0 += __shfl_xor(q0, o); q1 += __shfl_xor(q1, o); }
        const float rstd0 = rsqrtf(q0 * (1.0f / DM) + LN_EPS), rstd1 = rsqrtf(q1 * (1.0f / DM) + LN_EPS);
#pragma unroll
        for (int j = 0; j < 4; ++j) { const int c8 = 8 * (lane + 64 * j);
            const f32x4 g0 = *(const f32x4*)(gam + c8), g1 = *(const f32x4*)(gam + c8 + 4), b0 = *(const f32x4*)(bet + c8), b1 = *(const f32x4*)(bet + c8 + 4);
            const f32x4 o00 = v[0][2 * j] * rstd0 * g0 + b0, o01 = v[0][2 * j + 1] * rstd0 * g1 + b1, o10 = v[1][2 * j] * rstd1 * g0 + b0, o11 = v[1][2 * j + 1] * rstd1 * g1 + b1;
            if (dstf) { float* d0 = dstf + (size_t)row0 * DM + c8; __builtin_nontemporal_store(o00, (f32x4*)d0); __builtin_nontemporal_store(o01, (f32x4*)(d0 + 4));
                if (it >= 0) { float* d1 = dstf + (size_t)row1 * DM + c8; __builtin_nontemporal_store(o10, (f32x4*)d1); __builtin_nontemporal_store(o11, (f32x4*)(d1 + 4)); } }
            if (dstb) { *(v4u*)(dstb + (size_t)row0 * DM + c8) = pg8::pack8(o00, o01); if (it >= 0) *(v4u*)(dstb + (size_t)row1 * DM + c8) = pg8::pack8(o10, o11); } }
    }
#undef LN_UNPK
}

__device__ __forceinline__ void attn_prompt_unit(Frame& F, int b, int h, int qt) {
    const bf16* Qb = (const bf16*)(F.ws + WS_QB); const bf16* Kb = (const bf16*)(F.ws + WS_KB); const bf16* VT = (const bf16*)(F.ws + WS_VTB);
    bf16* Ob = (bf16*)(F.ws + WS_OB);
    const int lane = F.lane, fr = lane & 15, fq = lane >> 4, tid = F.tid;
    const int m = b * 2048 + qt * 128 + 16 * F.wave + fr;
    constexpr int BUFB = 33792;
    v4u stg[2][4];
#define AT_GLOAD(ch, ST) do { _Pragma("unroll") for (int i_ = 0; i_ < 4; ++i_) { const int seg_ = i_ * 512 + tid; \
        if ((ch) < 8) { const int r_ = seg_ >> 6, sg_ = seg_ & 63; ST[i_] = *(const v4u*)(Kb + (size_t)(b * NMEM + 32 * (ch) + r_) * DM + h * 512 + sg_ * 8); } \
        else { const int r_ = seg_ >> 5, sg_ = seg_ & 31; ST[i_] = *(const v4u*)(VT + (size_t)(h * 512 + 64 * ((ch) - 8) + r_) * 1024 + b * NMEM + sg_ * 8); } } } while (0)
#define AT_LSTORE(ch, ST) do { LAS unsigned char* d_ = F.lds + ((ch) & 1) * BUFB; _Pragma("unroll") for (int i_ = 0; i_ < 4; ++i_) { const int seg_ = i_ * 512 + tid; \
        if ((ch) < 8) { const int r_ = seg_ >> 6, sg_ = seg_ & 63; *(LAS v4u*)(d_ + r_ * 1040 + sg_ * 16) = ST[i_]; } \
        else { const int r_ = seg_ >> 5, sg_ = seg_ & 31; *(LAS v4u*)(d_ + r_ * 528 + sg_ * 16) = ST[i_]; } } } while (0)
    AT_GLOAD(0, stg[0]); AT_GLOAD(1, stg[1]);
    bf16x8 Qf[16];
#pragma unroll
    for (int kc = 0; kc < 16; ++kc) Qf[kc] = *(const bf16x8*)(Qb + (size_t)m * DM + h * 512 + 32 * kc + 8 * fq);
    AT_LSTORE(0, stg[0]); __syncthreads();
    f32x4 s[8][2]; bf16x8 Pf[8];
#pragma unroll
    for (int ch = 0; ch < 16; ++ch) {
        if (ch + 2 < 16) AT_GLOAD(ch + 2, stg[ch & 1]);
        const LAS unsigned char* cb = F.lds + (ch & 1) * BUFB;
        if (ch < 8) {
#pragma unroll
            for (int sb = 0; sb < 2; ++sb) { const LAS unsigned char* krow = cb + (8 * (fr >> 2) + 4 * sb + (fr & 3)) * 1040 + 16 * fq; f32x4 acc = (f32x4){0.f, 0.f, 0.f, 0.f};
#pragma unroll
                for (int kc = 0; kc < 16; ++kc) acc = MFMA16(*(const LAS bf16x8*)(krow + 64 * kc), Qf[kc], acc);
                s[ch & 7][sb] = acc; }
            if (ch == 7) {
                float mx = -3.0e38f;
#pragma unroll
                for (int c = 0; c < 8; ++c)
#pragma unroll
                    for (int sb = 0; sb < 2; ++sb)
#pragma unroll
                        for (int j = 0; j < 4; ++j) mx = fmaxf(mx, s[c][sb][j]);
                mx = fmaxf(mx, __shfl_xor(mx, 16)); mx = fmaxf(mx, __shfl_xor(mx, 32));
                const float sc2 = 0.044194173824159216f * 1.4426950408889634f;
                float sum = 0.f;
#pragma unroll
                for (int c = 0; c < 8; ++c)
#pragma unroll
                    for (int sb = 0; sb < 2; ++sb)
#pragma unroll
                        for (int j = 0; j < 4; ++j) { const float p = exp2f((s[c][sb][j] - mx) * sc2); s[c][sb][j] = p; sum += p; }
                sum += __shfl_xor(sum, 16); sum += __shfl_xor(sum, 32);
                const float inv = 1.0f / sum;
#pragma unroll
                for (int c = 0; c < 8; ++c) Pf[c] = pack_bf8(s[c][0] * inv, s[c][1] * inv);
            }
        } else {
#pragma unroll
            for (int dl = 0; dl < 4; ++dl) { const LAS unsigned char* vrow = cb + (16 * dl + fr) * 528 + 16 * fq; f32x4 acc = (f32x4){0.f, 0.f, 0.f, 0.f};
#pragma unroll
                for (int c = 0; c < 8; ++c) acc = MFMA16(*(const LAS bf16x8*)(vrow + 64 * c), Pf[c], acc);
                v2u w; w.x = pk2(acc[0], acc[1]); w.y = pk2(acc[2], acc[3]);
                *(v2u*)(Ob + (size_t)m * DM + h * 512 + 64 * (ch - 8) + 16 * dl + 4 * fq) = w; }
        }
        if (ch + 1 < 16) AT_LSTORE(ch + 1, stg[(ch + 1) & 1]);
        __syncthreads();
    }
#undef AT_GLOAD
#undef AT_LSTORE
}
__device__ __forceinline__ void attn_sample_unit(Frame& F, int b, int h) {
    bf16* Ob = (bf16*)(F.ws + WS_OB);
    const float* CK = F.in[7]; const float* CV = F.in[8];
    const int lane = F.lane, fr = lane & 15, fq = lane >> 4, w = F.wave, tid = F.tid;
    LAS float* Pw = (LAS float*)F.lds + w * 128;
    LAS float* ML = (LAS float*)(F.lds + 4096);
    LAS float* red = (LAS float*)(F.lds + 8192);
    LAS bf16* qs = (LAS bf16*)(F.lds + 73728);
    { const float* PART = (const float*)(F.ws + WS_PART); const int q = tid >> 7, d4 = (tid & 127) * 4; f32x4 o = (f32x4){0.f, 0.f, 0.f, 0.f};
      f32x4 pv[8];
#pragma unroll
      for (int ks = 0; ks < 8; ++ks) pv[ks] = *(const f32x4*)(PART + ((size_t)ks * 512 + 4 * b + q) * DM + h * 512 + d4);
#pragma unroll
      for (int ks = 0; ks < 8; ++ks) o += pv[ks];
      v2u pw; pw.x = pk2(o[0], o[1]); pw.y = pk2(o[2], o[3]); *(LAS v2u*)(qs + q * 512 + d4) = pw; }
    __syncthreads();
    bf16x8 Qf[16];
#pragma unroll
    for (int kc = 0; kc < 16; ++kc) { const bf16x8 z = {0, 0, 0, 0, 0, 0, 0, 0};
        Qf[kc] = fr < 4 ? *(const LAS bf16x8*)(qs + fr * 512 + 32 * kc + 8 * fq) : z; }
    f32x4 sc[2];
#pragma unroll
    for (int tl = 0; tl < 2; ++tl) { const int mem = 32 * w + 16 * tl + fr; const float* krow = CK + (size_t)(b * NMEM + mem) * DM + h * 512 + 8 * fq; f32x4 acc = (f32x4){0.f, 0.f, 0.f, 0.f};
#pragma unroll
        for (int kc = 0; kc < 16; ++kc) acc = MFMA16(pack_bf8(ldnt4(krow + 32 * kc), ldnt4(krow + 32 * kc + 4)), Qf[kc], acc);
        sc[tl] = acc * 0.044194173824159216f; }
    float mx = fmaxf(fmaxf(fmaxf(sc[0][0], sc[0][1]), fmaxf(sc[0][2], sc[0][3])), fmaxf(fmaxf(sc[1][0], sc[1][1]), fmaxf(sc[1][2], sc[1][3])));
    mx = fmaxf(mx, __shfl_xor(mx, 16)); mx = fmaxf(mx, __shfl_xor(mx, 32));
    float ls = 0.f;
#pragma unroll
    for (int tl = 0; tl < 2; ++tl)
#pragma unroll
        for (int j = 0; j < 4; ++j) { const float p = __expf(sc[tl][j] - mx); sc[tl][j] = p; ls += p; }
    ls += __shfl_xor(ls, 16); ls += __shfl_xor(ls, 32);
    if (fr < 4) {
#pragma unroll
        for (int tl = 0; tl < 2; ++tl)
#pragma unroll
            for (int j = 0; j < 4; ++j) Pw[(16 * tl + 4 * fq + j) * 4 + fr] = sc[tl][j];
        if (fq == 0) { ML[(w * 4 + fr) * 2] = mx; ML[(w * 4 + fr) * 2 + 1] = ls; } }
    LDS_WAIT(); asm volatile("" ::: "memory");
    f32x4 a0[4], a1[4];
#pragma unroll
    for (int q = 0; q < 4; ++q) { a0[q] = (f32x4){0.f, 0.f, 0.f, 0.f}; a1[q] = a0[q]; }
#pragma unroll 4
    for (int i = 0; i < 32; ++i) { const int mem = 32 * w + i; const float* vrow = CV + (size_t)(b * NMEM + mem) * DM + h * 512;
        const f32x4 v0 = ldnt4(vrow + 4 * lane), v1 = ldnt4(vrow + 256 + 4 * lane); const f32x4 p4 = *(const LAS f32x4*)(Pw + i * 4);
#pragma unroll
        for (int q = 0; q < 4; ++q) { a0[q] += v0 * p4[q]; a1[q] += v1 * p4[q]; } }
#pragma unroll
    for (int q = 0; q < 4; ++q) { *(LAS f32x4*)(red + (w * 4 + q) * 512 + 4 * lane) = a0[q]; *(LAS f32x4*)(red + (w * 4 + q) * 512 + 256 + 4 * lane) = a1[q]; }
    __syncthreads();
    { const int q = tid >> 7, d4 = (tid & 127) * 4; float M = -3.0e38f;
#pragma unroll
      for (int ww = 0; ww < 8; ++ww) M = fmaxf(M, ML[(ww * 4 + q) * 2]);
      float L = 0.f; f32x4 o = (f32x4){0.f, 0.f, 0.f, 0.f};
#pragma unroll
      for (int ww = 0; ww < 8; ++ww) { const float e = __expf(ML[(ww * 4 + q) * 2] - M); L += ML[(ww * 4 + q) * 2 + 1] * e; o += *(const LAS f32x4*)(red + (ww * 4 + q) * 512 + d4) * e; }
      const float inv = 1.0f / L; o = o * inv;
      v2u pw; pw.x = pk2(o[0], o[1]); pw.y = pk2(o[2], o[3]);
      *(v2u*)(Ob + (size_t)(MP + 4 * b + q) * DM + h * 512 + d4) = pw; }
    __syncthreads();
}
__device__ __forceinline__ void p8_attn(Frame& F) {
#ifndef MK_ATT_SKIP
#define MK_ATT_SKIP 0
#endif
    for (int rp = 0; rp < (MK_REP == 80 ? 2 : 1); ++rp) for (int u = F.bid; u < 512; u += F.G) attn_sample_unit(F, u >> 2, u & 3);
    for (int rp = 0; rp < (MK_REP == 81 ? 2 : 1); ++rp) for (int u = F.bid; u < 256; u += F.G) attn_prompt_unit(F, u >> 6, (u >> 4) & 3, u & 15);
}

#define XB_TMO      128
#define XB_XCNT(j)  (256  + 64 * (j))
#define XB_XSUB(j)  (1280 + 64 * (j))
#define XB_XGEN(j)  (2304 + 64 * (j))
#define XB_TOP      3328
#define XB_TOPGEN   3392
#define XCD_BAR_WORDS 3456
#define XB_SPIN_CAP (1u << 18)

__device__ __forceinline__ unsigned xb_ld(unsigned* p)              { return __hip_atomic_load(p, __ATOMIC_RELAXED, __HIP_MEMORY_SCOPE_AGENT); }
__device__ __forceinline__ unsigned xb_add(unsigned* p, unsigned v) { return __hip_atomic_fetch_add(p, v, __ATOMIC_RELAXED, __HIP_MEMORY_SCOPE_AGENT); }
__device__ __forceinline__ unsigned xb_xcc_id() { return (unsigned)__builtin_amdgcn_s_getreg((3 << 11) | 20) & 0xFu; }
#define XB_SPIN(cond, bar) do { unsigned _sp = 0; while (cond) { __builtin_amdgcn_s_sleep(1); \
    if ((++_sp & 255u) == 0u) { if (xb_ld(&(bar)[XB_TMO])) break; if (_sp > XB_SPIN_CAP) { atomicAdd(&(bar)[XB_TMO], 1u); break; } } } } while (0)

struct XcdBarrier {
    unsigned* bar; unsigned x;
    volatile LAS unsigned* st;
};

__device__ __forceinline__ XcdBarrier xcd_barrier_post(unsigned* bar, volatile LAS unsigned* st) {
    XcdBarrier b; b.bar = bar; b.x = xb_xcc_id(); b.st = st;
    if (threadIdx.x == 0) (void)xb_add(&bar[XB_XCNT(b.x)], 1u);
    return b;
}
__device__ __forceinline__ void xcd_barrier_complete(unsigned* bar, unsigned x, unsigned& nloc, unsigned& nx) {
    const unsigned G = gridDim.x * gridDim.y * gridDim.z;
    unsigned sum, cnt, mine, sp = 0u;
    for (;;) {
        sum = 0u; cnt = 0u; mine = 0u;
#pragma unroll
        for (unsigned j = 0; j < 16; ++j) { const unsigned c = xb_ld(&bar[XB_XCNT(j)]); sum += c; cnt += (c > 0u) ? 1u : 0u; mine = (j == x) ? c : mine; }
        if (sum == G) break;
        __builtin_amdgcn_s_sleep(1);
        if ((++sp & 255u) == 0u) { if (xb_ld(&bar[XB_TMO])) break; if (sp > XB_SPIN_CAP) { atomicAdd(&bar[XB_TMO], 1u); break; } }
    }
    nloc = mine > 0u ? mine : 1u; nx = cnt > 0u ? cnt : 1u;
}

__device__ __forceinline__ void xcd_barrier(const XcdBarrier& b) {
    asm volatile("s_waitcnt vmcnt(0)" ::: "memory");
    __syncthreads();
    if (threadIdx.x == 0) {
        unsigned* bar = b.bar;
        __builtin_amdgcn_s_waitcnt(0);
        unsigned nloc = b.st[0], nx = b.st[1];
        if (nloc == 0u) { xcd_barrier_complete(bar, b.x, nloc, nx); b.st[0] = nloc; b.st[1] = nx; }
        const unsigned old = xb_add(&bar[XB_XSUB(b.x)], 1u);
        const unsigned gen = old / nloc;
        if (old + 1u == (gen + 1u) * nloc) {
            __builtin_amdgcn_fence(__ATOMIC_RELEASE, "agent");
            asm volatile("s_waitcnt vmcnt(0)" ::: "memory");
            const unsigned og = xb_add(&bar[XB_TOP], 1u);
            const unsigned tg = og / nx;
            if (og + 1u == (tg + 1u) * nx) xb_add(&bar[XB_TOPGEN], 1u);
            else XB_SPIN(xb_ld(&bar[XB_TOPGEN]) == tg, bar);
            __builtin_amdgcn_fence(__ATOMIC_ACQUIRE, "agent");
            xb_add(&bar[XB_XGEN(b.x)], 1u);
            asm volatile("s_waitcnt vmcnt(0)" ::: "memory");
        } else {
            XB_SPIN(xb_ld(&bar[XB_XGEN(b.x)]) == gen, bar);
            __builtin_amdgcn_fence(__ATOMIC_ACQUIRE, "agent");
            asm volatile("s_waitcnt vmcnt(0)" ::: "memory");
        }
    }
    __syncthreads();
}

template <bool COOP>
__global__ void __launch_bounds__(NTHR, 2) mk_fwd(Args args) {
    extern __shared__ __attribute__((aligned(16))) unsigned char lds_raw[];
    Frame F;
    F.lds = (LAS unsigned char*)lds_raw; F.MISC = (volatile LAS unsigned*)(F.lds + MISC_OFF);
    F.tid = threadIdx.x; F.lane = F.tid & 63; F.wave = __builtin_amdgcn_readfirstlane(F.tid >> 6); F.G = gridDim.x; F.bid = blockIdx.x;
    F.in = args.in; F.out = args.out; F.ws = args.ws;
    unsigned char* ws = args.ws;
    const int lo = args.lo, hi = args.hi, bid = F.bid, G = F.G;
#define IN(k) (lo <= (k) && (k) < hi)
    XcdBarrier bar; bar.bar = (unsigned*)(ws + WS_CTL) + 4096; bar.x = 0; bar.st = nullptr;
    if (COOP) { if (F.tid < 2) F.MISC[8 + F.tid] = 0u; __syncthreads(); bar = xcd_barrier_post((unsigned*)(ws + WS_CTL) + 4096, F.MISC + 8); }
    unsigned long long* tsb = (unsigned long long*)(ws + WS_CTL + 32768);
    if (MK_TS >= 0 && bid == 0 && F.tid == 0) tsb[0] = __builtin_amdgcn_s_memrealtime();
#define SEAM(k) do { if (COOP) { if (IN(k) && IN((k) + 1)) { if (lo < 0) cg::this_grid().sync(); else xcd_barrier(bar); } } \
        if (MK_TS >= 0 && bid == 0 && F.tid == 0) tsb[(k) + 1] = __builtin_amdgcn_s_memrealtime(); } while (0)
    using pg8::Gemm; using pg8::StaticOrder; using pg8::gemm_phase;
    bf16* XB = (bf16*)(ws + WS_XB); bf16* Hh = (bf16*)(ws + WS_H); bf16* R = (bf16*)(ws + WS_R); float* PART = (float*)(ws + WS_PART);

    if (IN(0)) for (int rep = 0; rep < (MK_REP == 0 ? 2 : 1); ++rep) { if (rep) xcd_barrier(bar); p0_prologue(F); } SEAM(0);
    if (IN(1)) for (int rep = 0; rep < (MK_REP == 1 ? 2 : 1); ++rep) { if (rep) xcd_barrier(bar);
        { Gemm g{XB, (const bf16*)(ws + WS_WIN), MT, DIN, DM}; StaticOrder S; S.init(MT, DIN, G, bid, DM); pg8::EpiBf16S E{Hh, DIN, nullptr};
          gemm_phase<pg8::EpiBf16S, StaticOrder, true, true>(F.lds, g, S, E); }
        { Gemm g{(const bf16*)(ws + WS_MB), (const bf16*)(ws + WS_WKV), 1024, 4096, DM}; StaticOrder S; S.init(1024, 4096, G, (bid + G - 66) % G, DM);
          pg8::EpiMemKV E{F.out + O_MK, F.out + O_MV, (bf16*)(ws + WS_KB)};
          gemm_phase<pg8::EpiMemKV, StaticOrder, true, true>(F.lds, g, S, E); }
        { Gemm g{(const bf16*)(ws + WS_WKV) + (size_t)2048 * DM, (const bf16*)(ws + WS_MB), 2048, 1024, DM}; StaticOrder S; S.init(2048, 1024, G, (bid + G - 130) % G, DM);
          pg8::EpiBf16S E{(bf16*)(ws + WS_VTB), 1024, nullptr};
          gemm_phase<pg8::EpiBf16S, StaticOrder, true, true>(F.lds, g, S, E); }
    } SEAM(1);
    if (IN(2)) for (int rep = 0; rep < (MK_REP == 2 ? 2 : 1); ++rep) { if (rep) xcd_barrier(bar); p2_prep(F); } SEAM(2);
    if (IN(3)) for (int rep = 0; rep < (MK_REP == 3 ? 2 : 1); ++rep) { if (rep) xcd_barrier(bar); p3_scans(F, rep); } SEAM(3);
    if (IN(4)) for (int rep = 0; rep < (MK_REP == 4 ? 2 : 1); ++rep) { if (rep) xcd_barrier(bar);
        { Gemm g{(const bf16*)(ws + WS_YGB), (const bf16*)(ws + WS_WGLU), MT, DSSM, DSSM}; StaticOrder S; S.init(MT, DSSM, G, bid, DSSM);
          pg8::EpiGlu E{(const bf16*)(ws + WS_YGB), 1024, F.in[19], (bf16*)(ws + WS_MIX), 2048};
          gemm_phase<pg8::EpiGlu, StaticOrder, true, true>(F.lds, g, S, E); }
        p4_post(F, rep);
    } SEAM(4);
    if (IN(5)) for (int rep = 0; rep < (MK_REP == 5 ? 2 : 1); ++rep) { if (rep) xcd_barrier(bar); Gemm g{(const bf16*)(ws + WS_MIX), (const bf16*)(ws + WS_WOUT), MT, DM, DM}; pg8::MixOrder S; S.init(MP, DM, G, bid, DM, 8, 256);
        pg8::EpiRes E{F.in[0], F.in[1], nullptr, R, DM, ALPHA, PART};
        gemm_phase<pg8::EpiRes, pg8::MixOrder, true, true>(F.lds, g, S, E); } SEAM(5);
    if (IN(6)) for (int rep = 0; rep < (MK_REP == 6 ? 2 : 1); ++rep) { if (rep) xcd_barrier(bar); ln_rows(F, R, F.in[32], F.in[33], nullptr, XB, F.in[1], nullptr, PART, 8); } SEAM(6);
    if (IN(7)) for (int rep = 0; rep < (MK_REP == 7 ? 2 : 1); ++rep) { if (rep) xcd_barrier(bar); Gemm g{XB, (const bf16*)(ws + WS_WQ), MT, DM, DM}; pg8::MixOrder S; S.init(MP, DM, G, bid, DM, 8, 256);
        pg8::EpiBf16S E{(bf16*)(ws + WS_QB), DM, PART};
        gemm_phase<pg8::EpiBf16S, pg8::MixOrder, true, true>(F.lds, g, S, E); } SEAM(7);
    if (IN(8)) for (int rep = 0; rep < (MK_REP == 8 ? 2 : 1); ++rep) { if (rep) xcd_barrier(bar); p8_attn(F); } SEAM(8);
    if (IN(9)) for (int rep = 0; rep < (MK_REP == 9 ? 2 : 1); ++rep) { if (rep) xcd_barrier(bar); Gemm g{(const bf16*)(ws + WS_OB), (const bf16*)(ws + WS_WO), MT, DM, DM}; pg8::MixOrder S; S.init(MP, DM, G, bid, DM, 8, 256);
        pg8::EpiRes E{nullptr, nullptr, XB, R, DM, ALPHA, PART};
        gemm_phase<pg8::EpiRes, pg8::MixOrder, true, true>(F.lds, g, S, E); } SEAM(9);
    if (IN(10)) for (int rep = 0; rep < (MK_REP == 10 ? 2 : 1); ++rep) { if (rep) xcd_barrier(bar); ln_rows(F, R, F.in[38], F.in[39], nullptr, XB, nullptr, XB + (size_t)MP * DM, PART, 8); } SEAM(10);
    if (IN(11)) for (int rep = 0; rep < (MK_REP == 11 ? 2 : 1); ++rep) { if (rep) xcd_barrier(bar); Gemm g{XB, (const bf16*)(ws + WS_WGU), MT, 2 * DFF, DM}; StaticOrder S; S.init(MT, 2 * DFF, G, bid, DM);
        pg8::EpiSwiGLU E{(bf16*)(ws + WS_HFF), DFF};
        gemm_phase<pg8::EpiSwiGLU, StaticOrder, true, true>(F.lds, g, S, E); } SEAM(11);
    if (IN(12)) for (int rep = 0; rep < (MK_REP == 12 ? 2 : 1); ++rep) { if (rep) xcd_barrier(bar); Gemm g{(const bf16*)(ws + WS_HFF), (const bf16*)(ws + WS_WDN), MT, DM, DFF}; pg8::MixOrder S; S.init(MP, DM, G, bid, DFF, 11, 512);
        pg8::EpiRes E{nullptr, nullptr, XB, R, DM, ALPHA, PART};
        gemm_phase<pg8::EpiRes, pg8::MixOrder, true, true>(F.lds, g, S, E); } SEAM(12);
    if (IN(13)) for (int rep = 0; rep < (MK_REP == 13 ? 2 : 1); ++rep) { if (rep) xcd_barrier(bar); ln_rows(F, R, F.in[43], F.in[44], F.out + O_Y, nullptr, nullptr, XB + (size_t)MP * DM, PART, 11); }
    if (MK_TS >= 0 && bid == 0) {
        if (F.tid == 0) tsb[NPHASE] = __builtin_amdgcn_s_memrealtime();
        __syncthreads();
        const int k0 = MK_TS >= 200 ? 3 : (MK_TS >= 100 ? 0 : MK_TS), k1 = MK_TS >= 200 ? MK_TS - 183 : (MK_TS >= 100 ? NPHASE : MK_TS + 1);
        const float t_us = (float)(tsb[k1] - tsb[k0]) * 0.01f; const float sc = 1.0f + sqrtf(t_us * 1e-6f);
        for (int i = F.tid; i < 16384; i += NTHR) F.out[O_SRE_P + i] *= sc; }
#undef IN
#undef SEAM
}

#ifndef MK_COOP
#define MK_COOP 0
#endif
#ifndef MK_PH_HI
#define MK_PH_HI NPHASE
#endif
extern "C" void kernel_launch(void* const* d_in, const int* in_sizes, int n_in, void* d_out, int out_size, void* d_ws, size_t ws_size, hipStream_t stream) {
    static int grid = 0;
    if (grid == 0) {
        if (n_in != 45 || out_size != (int)O_END || ws_size < WS_END) { fprintf(stderr, "kernel_launch: unexpected shapes (n_in %d out %d ws %zu)\n", n_in, out_size, ws_size); grid = -1; return; }
        int dev = 0, cus = 0, per_cu = 0;
        (void)hipGetDevice(&dev); (void)hipDeviceGetAttribute(&cus, hipDeviceAttributeMultiprocessorCount, dev);
        (void)hipFuncSetAttribute((const void*)mk_fwd<(MK_COOP != 0)>, hipFuncAttributeMaxDynamicSharedMemorySize, LDS_BYTES);
        (void)hipOccupancyMaxActiveBlocksPerMultiprocessor(&per_cu, (const void*)mk_fwd<(MK_COOP != 0)>, NTHR, LDS_BYTES);
        (void)hipGetLastError();
        if (per_cu < 1) { fprintf(stderr, "kernel_launch: occupancy query says %d blocks per CU\n", per_cu); per_cu = 1; }
        grid = cus;
    }
    if (grid < 0) return;
    (void)hipMemsetAsync((char*)d_ws + WS_CTL, 0, 65536, stream);
    if (MK_PH_HI < NPHASE) (void)hipMemsetAsync(d_out, 0, (size_t)out_size * 4, stream);
#ifdef MK_DUMP_OFF
#ifndef MK_DUMP_BYTES
#define MK_DUMP_BYTES ((size_t)MT * DM * 4)
#endif
#define MK_DUMP_AFTER (void)hipMemcpyAsync(d_out, (char*)d_ws + (MK_DUMP_OFF), MK_DUMP_BYTES, hipMemcpyDeviceToDevice, stream);
#else
#define MK_DUMP_AFTER
#endif
    Args a{};
    for (int i = 0; i < 45; ++i) a.in[i] = (const float*)d_in[i];
    a.out = (float*)d_out; a.ws = (unsigned char*)d_ws;
#if MK_COOP
    a.lo = 0; a.hi = MK_PH_HI;
    void* kargs[] = {&a};
    hipError_t e = hipLaunchCooperativeKernel((const void*)mk_fwd<true>, dim3(grid), dim3(NTHR), kargs, LDS_BYTES, stream);
    if (e != hipSuccess) fprintf(stderr, "cooperative launch failed: %s (grid %d)\n", hipGetErrorString(e), grid);
#else
    for (int p = 0; p < MK_PH_HI; ++p) { a.lo = p; a.hi = p + 1; hipLaunchKernelGGL(mk_fwd<false>, dim3(grid), dim3(NTHR), LDS_BYTES, stream, a); }
#endif
    MK_DUMP_AFTER
}
```

```cpp
#include <hip/hip_runtime.h>
#include <hip/hip_cooperative_groups.h>
#include <cstdio>
#include <cstdint>
namespace cg = cooperative_groups;
#define MK_COOP 1
namespace pg8 {
#define PG8_LAS __attribute__((address_space(3)))
typedef unsigned short bf16_t;
typedef short bf16x8 __attribute__((ext_vector_type(8)));
typedef float f32x4 __attribute__((ext_vector_type(4)));
typedef unsigned u32x4 __attribute__((ext_vector_type(4)));
constexpr int BM = 256, BK = 64, HALF = 128, HTB = HALF * BK * 2  , STAGE_BYTES = 8 * HTB, NXCD = 8, WGM = 8;

__host__ __device__ __forceinline__ int lds_byte(int r, int c) { const int st = (r >> 4) * 2 + (c >> 5), rr = r & 15, cc = c & 31, ob = rr * 64 + cc * 2; return st * 1024 + (ob ^ (((ob >> 9) & 1) << 5)); }
__host__ __device__ __forceinline__ void stage_rc(int b, int& R, int& C) { const int st = b / 1024, sb = b % 1024, swz = sb ^ (((sb >> 9) & 1) << 5); R = (st >> 1) * 16 + swz / 64; C = (st & 1) * 32 + (swz % 64) / 2; }
__host__ __device__ __forceinline__ int perm32(int rho) { const int n = rho >> 4, i = rho & 15; return 8 * (i >> 2) + 4 * n + (i & 3); }

struct Unit { int pm, pn, koff, nt, ks; };
struct Gemm { const bf16_t* A; const bf16_t* Bt; int M, N, K; };

struct StaticOrder {
    int nM, nN, nwg, G, c, ntk;
    __host__ __device__ void init(int M, int N, int G_, int c_, int K_) { nM = M / BM; nN = N / BM; nwg = nM * nN; G = G_; c = c_; ntk = K_ / BK; }
    __host__ __device__ bool next(int i, Unit& u) const {
        const long L = (long)i * G + c; if (L >= nwg) return false;
        int wgid = (int)L; { const int q = nwg / NXCD, r = nwg % NXCD, xcd = wgid % NXCD, off = wgid / NXCD; wgid = (xcd < r ? xcd * (q + 1) : r * (q + 1) + (xcd - r) * q) + off; }
        const int nig = WGM * nN, gid = wgid / nig, fm = gid * WGM, gsz = (nM - fm) < WGM ? (nM - fm) : WGM;
        u.pm = fm + ((wgid % nig) % gsz); u.pn = (wgid % nig) / gsz; u.koff = 0; u.nt = ntk; u.ks = -1; return true;
    }
    __device__ __forceinline__ void a_ready(const Unit&) const {}
    __device__ __forceinline__ void done(const Unit&) const {}
};
struct MixOrder {
    StaticOrder so; int c, nsplit, ksz, nN, pm0;
    __host__ __device__ void init(int M0, int N, int G_, int c_, int K_, int nsplit_, int ksz_) { so.init(M0, N, G_, c_, K_); c = c_; nsplit = nsplit_; ksz = ksz_; nN = N / BM; pm0 = M0 / BM; }
    __host__ __device__ bool next(int i, Unit& u) const {
        if (i == 0) return so.next(0, u);
        if (i == 1) { const int per = 2 * nN; if (c >= nsplit * per) return false; const int tile = c % per, ks = c / per;
            u.pm = pm0 + tile / nN; u.pn = tile % nN; u.koff = ks * ksz; u.nt = ksz / BK; u.ks = ks; return true; }
        return false;
    }
    __device__ __forceinline__ void a_ready(const Unit&) const {}
    __device__ __forceinline__ void done(const Unit&) const {}
};
typedef float f32x2_cv __attribute__((ext_vector_type(2))); typedef __bf16 bf16x2_cv __attribute__((ext_vector_type(2)));
__device__ __forceinline__ unsigned cvt_pk_bf16(float lo, float hi) { const f32x2_cv v = {lo, hi}; const bf16x2_cv b = __builtin_convertvector(v, bf16x2_cv); return __builtin_bit_cast(unsigned, b); }

__device__ __forceinline__ float bf_lo(unsigned w) { return __builtin_bit_cast(float, w << 16); }
__device__ __forceinline__ float bf_hi(unsigned w) { return __builtin_bit_cast(float, w & 0xffff0000u); }
__device__ __forceinline__ u32x4 pack8(const f32x4 a, const f32x4 b) { u32x4 w; w.x = cvt_pk_bf16(a[0], a[1]); w.y = cvt_pk_bf16(a[2], a[3]); w.z = cvt_pk_bf16(b[0], b[1]); w.w = cvt_pk_bf16(b[2], b[3]); return w; }
__device__ __forceinline__ float sigmoidf_(float x) { return __builtin_amdgcn_rcpf(1.0f + __expf(-x)); }

struct EpiF32 {
    static constexpr bool PERM = true, AFTER_DRAIN = false;
    float* O; int ldc;
    __device__ __forceinline__ void operator()(const f32x4 (&acc)[2][2][4][2], const Unit& u, int wr, int wc, int fr, int fq) const {
        const int row0 = u.pm * BM + wr * 64 + fr, col0 = u.pn * BM + wc * 32 + 8 * fq;
#pragma unroll
        for (int ai = 0; ai < 2; ++ai)
#pragma unroll
            for (int m = 0; m < 4; ++m) { float* rowp = O + (size_t)(row0 + ai * HALF + m * 16) * ldc + col0;
#pragma unroll
                for (int bj = 0; bj < 2; ++bj) { *(f32x4*)(rowp + bj * HALF) = acc[ai][bj][m][0]; *(f32x4*)(rowp + bj * HALF + 4) = acc[ai][bj][m][1]; } }
    }
};
struct EpiMemKV {
    static constexpr bool PERM = true, AFTER_DRAIN = false;
    float* outK; float* outV; bf16_t* Kb;
    __device__ __forceinline__ void operator()(const f32x4 (&acc)[2][2][4][2], const Unit& u, int wr, int wc, int fr, int fq) const {
        const int row0 = u.pm * BM + wr * 64 + fr; const int colt = u.pn * BM; const bool isV = colt >= 2048;
        float* o = isV ? outV : outK; const int col0 = (isV ? colt - 2048 : colt) + wc * 32 + 8 * fq;
#pragma unroll
        for (int ai = 0; ai < 2; ++ai)
#pragma unroll
            for (int m = 0; m < 4; ++m)
#pragma unroll
                for (int bj = 0; bj < 2; ++bj) { const size_t off = (size_t)(row0 + ai * HALF + m * 16) * 2048 + col0 + bj * HALF;
                    __builtin_nontemporal_store(acc[ai][bj][m][0], (f32x4*)(o + off)); __builtin_nontemporal_store(acc[ai][bj][m][1], (f32x4*)(o + off + 4));
                    if (!isV) *(u32x4*)(Kb + off) = pack8(acc[ai][bj][m][0], acc[ai][bj][m][1]); }
    }
};
struct EpiBf16S {
    static constexpr bool PERM = true, AFTER_DRAIN = false;
    bf16_t* O; int ldc; float* part;
    __device__ __forceinline__ void operator()(const f32x4 (&acc)[2][2][4][2], const Unit& u, int wr, int wc, int fr, int fq) const {
        const int row0 = u.pm * BM + wr * 64 + fr, col0 = u.pn * BM + wc * 32 + 8 * fq;
        if (u.ks >= 0) {
#pragma unroll
            for (int ai = 0; ai < 2; ++ai)
#pragma unroll
                for (int m = 0; m < 4; ++m) { float* rowp = part + ((size_t)u.ks * 512 + (row0 + ai * HALF + m * 16 - 8192)) * ldc + col0;
#pragma unroll
                    for (int bj = 0; bj < 2; ++bj) { *(f32x4*)(rowp + bj * HALF) = acc[ai][bj][m][0]; *(f32x4*)(rowp + bj * HALF + 4) = acc[ai][bj][m][1]; } }
            return; }
#pragma unroll
        for (int ai = 0; ai < 2; ++ai)
#pragma unroll
            for (int m = 0; m < 4; ++m) { bf16_t* rowp = O + (size_t)(row0 + ai * HALF + m * 16) * ldc + col0;
#pragma unroll
                for (int bj = 0; bj < 2; ++bj) *(u32x4*)(rowp + bj * HALF) = pack8(acc[ai][bj][m][0], acc[ai][bj][m][1]); }
    }
};
struct EpiGlu {
    static constexpr bool PERM = true, AFTER_DRAIN = false;
    const bf16_t* Y; int ldy; const float* bias; bf16_t* O; int ldo;
    __device__ __forceinline__ void operator()(const f32x4 (&acc)[2][2][4][2], const Unit& u, int wr, int wc, int fr, int fq) const {
        const int row0 = u.pm * BM + wr * 64 + fr, col0 = u.pn * BM + wc * 32 + 8 * fq;
#pragma unroll
        for (int bj = 0; bj < 2; ++bj) { const f32x4 b0 = *(const f32x4*)(bias + col0 + bj * HALF), b1 = *(const f32x4*)(bias + col0 + bj * HALF + 4);
#pragma unroll
            for (int ai = 0; ai < 2; ++ai)
#pragma unroll
                for (int m = 0; m < 4; ++m) { const int row = row0 + ai * HALF + m * 16;
                    const u32x4 yv = *(const u32x4*)(Y + (size_t)row * ldy + col0 + bj * HALF);
                    const f32x4 a0 = acc[ai][bj][m][0] + b0, a1 = acc[ai][bj][m][1] + b1; f32x4 z0, z1;
                    z0[0] = bf_lo(yv.x) * sigmoidf_(a0[0]); z0[1] = bf_hi(yv.x) * sigmoidf_(a0[1]); z0[2] = bf_lo(yv.y) * sigmoidf_(a0[2]); z0[3] = bf_hi(yv.y) * sigmoidf_(a0[3]);
                    z1[0] = bf_lo(yv.z) * sigmoidf_(a1[0]); z1[1] = bf_hi(yv.z) * sigmoidf_(a1[1]); z1[2] = bf_lo(yv.w) * sigmoidf_(a1[2]); z1[3] = bf_hi(yv.w) * sigmoidf_(a1[3]);
                    *(u32x4*)(O + (size_t)row * ldo + col0 + bj * HALF) = pack8(z0, z1); } }
    }
};
struct EpiRes {
    static constexpr bool PERM = true, AFTER_DRAIN = false;
    const float* base0; const float* base1; const bf16_t* bbase; bf16_t* O; int ld; float alpha; float* part;
    __device__ __forceinline__ void operator()(const f32x4 (&acc)[2][2][4][2], const Unit& u, int wr, int wc, int fr, int fq) const {
        const int row0 = u.pm * BM + wr * 64 + fr, col0 = u.pn * BM + wc * 32 + 8 * fq;
        if (u.ks >= 0) {
#pragma unroll
            for (int ai = 0; ai < 2; ++ai)
#pragma unroll
                for (int m = 0; m < 4; ++m) { float* rowp = part + ((size_t)u.ks * 512 + (row0 + ai * HALF + m * 16 - 8192)) * ld + col0;
#pragma unroll
                    for (int bj = 0; bj < 2; ++bj) { *(f32x4*)(rowp + bj * HALF) = acc[ai][bj][m][0]; *(f32x4*)(rowp + bj * HALF + 4) = acc[ai][bj][m][1]; } }
            return; }
        const bool lo = (u.pm * BM) < 8192; const float* bp = lo ? base0 : base1; const int rsub = lo ? 0 : 8192;
#pragma unroll
        for (int ai = 0; ai < 2; ++ai)
#pragma unroll
            for (int m = 0; m < 4; ++m) { const int row = row0 + ai * HALF + m * 16; bf16_t* orow = O + (size_t)row * ld + col0;
#pragma unroll
                for (int bj = 0; bj < 2; ++bj) { f32x4 x0, x1;
                    if (bbase) { const u32x4 bv = *(const u32x4*)(bbase + (size_t)row * ld + col0 + bj * HALF);
                        x0 = (f32x4){bf_lo(bv.x), bf_hi(bv.x), bf_lo(bv.y), bf_hi(bv.y)}; x1 = (f32x4){bf_lo(bv.z), bf_hi(bv.z), bf_lo(bv.w), bf_hi(bv.w)}; }
                    else { const float* brow = bp + (size_t)(row - rsub) * ld + col0 + bj * HALF; x0 = __builtin_nontemporal_load((const f32x4*)brow); x1 = __builtin_nontemporal_load((const f32x4*)(brow + 4)); }
                    *(u32x4*)(orow + bj * HALF) = pack8(x0 * alpha + acc[ai][bj][m][0], x1 * alpha + acc[ai][bj][m][1]); } }
    }
};
struct EpiSwiGLU {
    static constexpr bool PERM = true, AFTER_DRAIN = false;
    bf16_t* O; int ldo;
    __device__ __forceinline__ void operator()(const f32x4 (&acc)[2][2][4][2], const Unit& u, int wr, int wc, int fr, int fq) const {
        const int row0 = u.pm * BM + wr * 64 + fr, col0 = u.pn * HALF + wc * 32 + 8 * fq;
#pragma unroll
        for (int ai = 0; ai < 2; ++ai)
#pragma unroll
            for (int m = 0; m < 4; ++m) { f32x4 h0, h1;
#pragma unroll
                for (int j = 0; j < 4; ++j) { const float g0 = acc[ai][0][m][0][j], g1 = acc[ai][0][m][1][j];
                    h0[j] = g0 * sigmoidf_(g0) * acc[ai][1][m][0][j]; h1[j] = g1 * sigmoidf_(g1) * acc[ai][1][m][1][j]; }
                *(u32x4*)(O + (size_t)(row0 + ai * HALF + m * 16) * ldo + col0) = pack8(h0, h1); }
    }
};

template <class Epi, class Sched, bool ALIGN_EPI = false, bool SP2 = false>
__device__ __forceinline__ void gemm_phase(PG8_LAS unsigned char* lds, const Gemm g, const Sched& S, const Epi& E) {
    const int tid = threadIdx.x, wid = __builtin_amdgcn_readfirstlane(tid >> 6), lane = tid & 63, wr = wid >> 2, wc = wid & 3, fr = lane & 15, fq = lane >> 4;
    const int K = g.K;
    unsigned voffA[2], voffB[2];
#pragma unroll
    for (int i = 0; i < 2; ++i) { int R, C; stage_rc(tid * 16 + i * 8192, R, C); const int Rb = Epi::PERM ? ((R & ~31) + perm32(R & 31)) : R;
        voffA[i] = (unsigned)(R * K + C) * 2u; voffB[i] = (unsigned)(Rb * K + C) * 2u; }
    const size_t kstep = (size_t)(BK * 2);
    const size_t hstep = (size_t)HALF * K * 2;
    const size_t tstep = 2 * hstep;
    const unsigned ldsw = (unsigned)wid * 1024u;
    const int aoff = lds_byte(wr * 64 + fr, fq * 8), boff = lds_byte(wc * 32 + fr, fq * 8);
#define PG8_SA(b, h) (((b) * 2 + (h)) * HTB)
#define PG8_SB(b, h) ((4 + (b) * 2 + (h)) * HTB)
#define PG8_STAGE(bufoff, gbase, voff) do { _Pragma("unroll") for (int _i = 0; _i < 2; ++_i) \
        __builtin_amdgcn_global_load_lds((const unsigned*)((const char*)(gbase) + (voff)[_i]), (PG8_LAS unsigned*)(lds + (bufoff) + ldsw + _i * 8192), 16, 0, 0); } while (0)
#define PG8_LDA(dst, b, h) do { _Pragma("unroll") for (int m = 0; m < 4; ++m) _Pragma("unroll") for (int k = 0; k < 2; ++k) dst[m][k] = *(const PG8_LAS bf16x8*)(lds + PG8_SA(b, h) + aoff + m * 2048 + k * 1024); } while (0)
#define PG8_LDB(dst, b, h) do { _Pragma("unroll") for (int n = 0; n < 2; ++n) _Pragma("unroll") for (int k = 0; k < 2; ++k) dst[n][k] = *(const PG8_LAS bf16x8*)(lds + PG8_SB(b, h) + boff + n * 2048 + k * 1024); } while (0)
#define PG8_MMA(ai, bj, At, Bt) do { __builtin_amdgcn_s_setprio(1); _Pragma("unroll") for (int m = 0; m < 4; ++m) _Pragma("unroll") for (int n = 0; n < 2; ++n) _Pragma("unroll") for (int k = 0; k < 2; ++k) \
        acc[ai][bj][m][n] = __builtin_amdgcn_mfma_f32_16x16x32_bf16(Bt[n][k], At[m][k], acc[ai][bj][m][n], 0, 0, 0); __builtin_amdgcn_s_setprio(0); } while (0)
#define PG8_WAIT_V(n) asm volatile("s_waitcnt vmcnt(" #n ")" ::: "memory")
#define PG8_WAIT_L(n) asm volatile("s_waitcnt lgkmcnt(" #n ")" ::: "memory")
#define PG8_BAR __builtin_amdgcn_s_barrier()
#define PG8_SCHED __builtin_amdgcn_sched_barrier(0)
    Unit cur, nxt; int ui = 0;
    if (!S.next(0, cur)) return;
    f32x4 acc[2][2][4][2];
#pragma unroll
    for (int a = 0; a < 2; ++a)
#pragma unroll
        for (int b = 0; b < 2; ++b)
#pragma unroll
            for (int m = 0; m < 4; ++m)
#pragma unroll
                for (int n = 0; n < 2; ++n) acc[a][b][m][n] = (f32x4){0.f, 0.f, 0.f, 0.f};
    bf16x8 At[4][2], B0[2][2], B1[2][2];
    const char* cA = (const char*)g.A + (size_t)cur.pm * tstep + (size_t)cur.koff * 2; const char* cB = (const char*)g.Bt + (size_t)cur.pn * tstep + (size_t)cur.koff * 2;
    S.a_ready(cur);
    if constexpr (SP2) {
        PG8_STAGE(PG8_SB(0, 0), cB, voffB); PG8_STAGE(PG8_SB(0, 1), cB + hstep, voffB); PG8_STAGE(PG8_SA(0, 0), cA, voffA); PG8_STAGE(PG8_SA(0, 1), cA + hstep, voffA);
        if (wr == 1) PG8_BAR;
        PG8_WAIT_V(2); PG8_BAR;
        PG8_STAGE(PG8_SB(1, 0), cB + kstep, voffB); PG8_STAGE(PG8_SA(1, 0), cA + kstep, voffA); PG8_STAGE(PG8_SB(1, 1), cB + hstep + kstep, voffB);
        PG8_WAIT_V(6); PG8_BAR;
    } else {
        PG8_STAGE(PG8_SB(0, 0), cB, voffB); PG8_STAGE(PG8_SA(0, 0), cA, voffA); PG8_STAGE(PG8_SB(0, 1), cB + hstep, voffB); PG8_STAGE(PG8_SA(0, 1), cA + hstep, voffA);
        if (wr == 1) PG8_BAR;
        PG8_WAIT_V(4); PG8_BAR;
        PG8_STAGE(PG8_SB(1, 0), cB + kstep, voffB); PG8_STAGE(PG8_SA(1, 0), cA + kstep, voffA); PG8_STAGE(PG8_SB(1, 1), cB + hstep + kstep, voffB);
        PG8_WAIT_V(6); PG8_BAR;
    }
    for (;;) {
        const bool has_next = S.next(ui + 1, nxt);
        const char* nA = has_next ? (const char*)g.A + (size_t)nxt.pm * tstep + (size_t)nxt.koff * 2 : cA; const char* nB = has_next ? (const char*)g.Bt + (size_t)nxt.pn * tstep + (size_t)nxt.koff * 2 : cB;
        const int nt = cur.nt;
        for (int t = 0; t < nt; t += 2) {
            const bool last = (t == nt - 2);
            const char* a1 = cA + (size_t)(t + 1) * kstep;
            const char* a2 = last ? nA : cA + (size_t)(t + 2) * kstep; const char* b2 = last ? nB : cB + (size_t)(t + 2) * kstep;
            const char* a3 = a2 + kstep; const char* b3 = b2 + kstep;
            if (last && has_next) S.a_ready(nxt);
            if constexpr (SP2) {
            PG8_LDB(B0, 0, 0); PG8_LDB(B1, 0, 1); PG8_SCHED; PG8_LDA(At, 0, 0); PG8_STAGE(PG8_SA(1, 1), a1 + hstep, voffA);
            PG8_WAIT_V(8); PG8_WAIT_L(0); PG8_BAR; PG8_MMA(0, 0, At, B0); PG8_MMA(0, 1, At, B1); PG8_BAR; PG8_SCHED;
            PG8_LDA(At, 0, 1); PG8_STAGE(PG8_SB(0, 0), b2, voffB); PG8_STAGE(PG8_SB(0, 1), b2 + hstep, voffB); PG8_STAGE(PG8_SA(0, 0), a2, voffA);
            PG8_WAIT_V(8); PG8_WAIT_L(0); PG8_BAR; PG8_MMA(1, 0, At, B0); PG8_MMA(1, 1, At, B1); PG8_BAR; PG8_SCHED;
            PG8_LDB(B0, 1, 0); PG8_LDB(B1, 1, 1); PG8_SCHED; PG8_LDA(At, 1, 0); PG8_STAGE(PG8_SA(0, 1), a2 + hstep, voffA);
            PG8_WAIT_V(8); PG8_WAIT_L(0); PG8_BAR; PG8_MMA(0, 0, At, B0); PG8_MMA(0, 1, At, B1); PG8_BAR; PG8_SCHED;
            PG8_LDA(At, 1, 1); PG8_STAGE(PG8_SB(1, 0), b3, voffB); PG8_STAGE(PG8_SB(1, 1), b3 + hstep, voffB); PG8_STAGE(PG8_SA(1, 0), a3, voffA);
            PG8_WAIT_V(8); PG8_WAIT_L(0); PG8_BAR; PG8_MMA(1, 0, At, B0); PG8_MMA(1, 1, At, B1); PG8_BAR; PG8_SCHED;
            } else {
            PG8_LDB(B0, 0, 0); PG8_SCHED; PG8_LDA(At, 0, 0); PG8_STAGE(PG8_SA(1, 1), a1 + hstep, voffA);
            PG8_WAIT_L(8); PG8_BAR; PG8_WAIT_L(0); PG8_MMA(0, 0, At, B0); PG8_BAR; PG8_SCHED;
            PG8_LDB(B1, 0, 1); PG8_STAGE(PG8_SB(0, 0), b2, voffB);
            PG8_BAR; PG8_WAIT_L(0); PG8_MMA(0, 1, At, B1); PG8_BAR;
            PG8_LDA(At, 0, 1); PG8_STAGE(PG8_SA(0, 0), a2, voffA);
            PG8_BAR; PG8_WAIT_L(0); PG8_MMA(1, 0, At, B0); PG8_BAR; PG8_SCHED;
            PG8_STAGE(PG8_SB(0, 1), b2 + hstep, voffB);
            PG8_WAIT_V(6); PG8_BAR; PG8_MMA(1, 1, At, B1); PG8_BAR;
            PG8_LDB(B0, 1, 0); PG8_SCHED; PG8_LDA(At, 1, 0); PG8_STAGE(PG8_SA(0, 1), a2 + hstep, voffA);
            PG8_WAIT_L(8); PG8_BAR; PG8_WAIT_L(0); PG8_MMA(0, 0, At, B0); PG8_BAR; PG8_SCHED;
            PG8_LDB(B1, 1, 1); PG8_STAGE(PG8_SB(1, 0), b3, voffB);
            PG8_BAR; PG8_WAIT_L(0); PG8_MMA(0, 1, At, B1); PG8_BAR;
            PG8_LDA(At, 1, 1); PG8_STAGE(PG8_SA(1, 0), a3, voffA);
            PG8_BAR; PG8_WAIT_L(0); PG8_MMA(1, 0, At, B0); PG8_BAR; PG8_SCHED;
            PG8_STAGE(PG8_SB(1, 1), b3 + hstep, voffB);
            PG8_WAIT_V(6); PG8_BAR; PG8_MMA(1, 1, At, B1); PG8_BAR;
            }
        }
        if constexpr (ALIGN_EPI) { if (wr == 0) PG8_BAR; }
        if constexpr (!Epi::AFTER_DRAIN) { E(acc, cur, wr, wc, fr, fq); S.done(cur); }
        if (!has_next) break;
#pragma unroll
        for (int a = 0; a < 2; ++a)
#pragma unroll
            for (int b = 0; b < 2; ++b)
#pragma unroll
                for (int m = 0; m < 4; ++m)
#pragma unroll
                    for (int n = 0; n < 2; ++n) acc[a][b][m][n] = (f32x4){0.f, 0.f, 0.f, 0.f};
        cur = nxt; cA = nA; cB = nB; ++ui;
        if constexpr (ALIGN_EPI) { if (wr == 1) PG8_BAR; }
    }
    PG8_WAIT_V(0);
    if constexpr (!ALIGN_EPI) { if (wr == 0) PG8_BAR; }
    PG8_BAR;
    if constexpr (Epi::AFTER_DRAIN) { E.fused(acc, cur, wr, wc, fr, fq, lds, wid, lane); S.done(cur); }
#undef PG8_SA
#undef PG8_SB
#undef PG8_STAGE
#undef PG8_LDA
#undef PG8_LDB
#undef PG8_MMA
#undef PG8_WAIT_V
#undef PG8_WAIT_L
#undef PG8_BAR
#undef PG8_SCHED
}
}

#ifndef MK_REP
#define MK_REP -1
#endif
#ifndef MK_TS
#define MK_TS -1
#endif
constexpr int NWAVES = 8, NTHR = 512;
constexpr int MT = 8704, MP = 8192, DM = 2048, DIN = 4352, DSSM = 1024, DRW = 1024, DSH = 3328, DFF = 5632, NMEM = 256;
constexpr float ALPHA = 1.189207115002721f;
constexpr float LN_EPS = 1e-5f, GN_EPS = 64e-5f;
constexpr size_t O_Y = 0, O_SRE_P = (size_t)MT * DM, O_SIM_P = O_SRE_P + 16384, O_WKV_P = O_SIM_P + 16384, O_SH_P = O_WKV_P + 262144, O_MK = O_SH_P + 4 * DSH,
                 O_MV = O_MK + 2097152, O_SRE_S = O_MV + 2097152, O_SIM_S = O_SRE_S + 524288, O_WKV_S = O_SIM_S + 524288, O_SH_S = O_WKV_S + 8388608, O_END = O_SH_S + 128 * DSH;
static_assert(O_END == 32191488, "output size");
constexpr size_t MiB = 1u << 20;
constexpr size_t WS_CTL = 0, WS_WIN = 1 * MiB, WS_WGLU = 18 * MiB, WS_WOUT = 20 * MiB, WS_WQ = 28 * MiB, WS_WKV = 36 * MiB, WS_WO = 52 * MiB, WS_WGU = 60 * MiB, WS_WDN = 104 * MiB,
                 WS_W2T = 126 * MiB, WS_A2T = WS_W2T + 131072, WS_G2T = WS_W2T + 262144, WS_KB = 127 * MiB, WS_VTB = 131 * MiB, WS_XB = 135 * MiB, WS_MB = 169 * MiB,
                 WS_H = 173 * MiB, WS_R = WS_H, WS_X = WS_H + 72 * MiB, WS_PREP = 318 * MiB, WS_BONUS = 706 * MiB, WS_QB = WS_PREP, WS_OB = WS_PREP + 34 * MiB, WS_HFF = WS_PREP + 68 * MiB,
                 WS_YR = 557 * MiB, WS_YGB = 591 * MiB, WS_MIX = 608 * MiB, WS_PART = 642 * MiB, WS_BON4 = 706 * MiB, WS_END = 709 * MiB;
constexpr size_t PREP_STRIDE = 34 * MiB;
constexpr int LDS_BYTES = 135168;
constexpr int MISC_OFF = 131072;
constexpr int NPHASE = 14;

#define LAS __attribute__((address_space(3)))
typedef unsigned short bf16;
typedef unsigned v4u __attribute__((ext_vector_type(4)));
typedef unsigned v2u __attribute__((ext_vector_type(2)));
typedef float f32x4 __attribute__((ext_vector_type(4)));
typedef float f32x2 __attribute__((ext_vector_type(2)));
typedef float f32x16 __attribute__((ext_vector_type(16)));
typedef short bf16x8 __attribute__((ext_vector_type(8)));
#define LDS_WAIT() asm volatile("s_waitcnt lgkmcnt(0)" ::: "memory")

__device__ __forceinline__ unsigned pk2(float lo, float hi) { return pg8::cvt_pk_bf16(lo, hi); }
__device__ __forceinline__ bf16x8 pack_bf8(const f32x4 a, const f32x4 b) { v4u w; w.x = pk2(a[0], a[1]); w.y = pk2(a[2], a[3]); w.z = pk2(b[0], b[1]); w.w = pk2(b[2], b[3]); return __builtin_bit_cast(bf16x8, w); }
__device__ __forceinline__ f32x4 ldbf4(const bf16* p) { const v2u w = *(const v2u*)p; return (f32x4){pg8::bf_lo(w.x), pg8::bf_hi(w.x), pg8::bf_lo(w.y), pg8::bf_hi(w.y)}; }
__device__ __forceinline__ void stnt4(float* p, const f32x4 x) { __builtin_nontemporal_store(x, (f32x4*)p); }
__device__ __forceinline__ f32x4 ldnt4(const float* p) { return __builtin_nontemporal_load((const f32x4*)p); }
__device__ __forceinline__ float wave_sum(float v) {
#pragma unroll
    for (int o = 1; o < 64; o <<= 1) v += __shfl_xor(v, o);
    return v;
}
__device__ __forceinline__ float wave_max(float v) {
#pragma unroll
    for (int o = 1; o < 64; o <<= 1) v = fmaxf(v, __shfl_xor(v, o));
    return v;
}
template <int CTRL> __device__ __forceinline__ float dpp_f(float x) { return __builtin_bit_cast(float, __builtin_amdgcn_update_dpp(0, __builtin_bit_cast(int, x), CTRL, 0xf, 0xf, false)); }
__device__ __forceinline__ float sum16(float x) { x += dpp_f<0xB1>(x); x += dpp_f<0x4E>(x); x += dpp_f<0x141>(x); x += dpp_f<0x140>(x); return x; }
__device__ __forceinline__ float sigm(float x) { return __builtin_amdgcn_rcpf(1.0f + __expf(-x)); }
__device__ __forceinline__ float tanh_(float x) { return 1.0f - 2.0f * __builtin_amdgcn_rcpf(1.0f + __expf(2.0f * x)); }
__device__ __forceinline__ float gelu_tanh(float x) { const float u = 1.5957691216057308f * (x + 0.044715f * x * x * x); return x * __builtin_amdgcn_rcpf(1.0f + __expf(-u)); }
#define MFMA16(a, b, c) __builtin_amdgcn_mfma_f32_16x16x32_bf16((a), (b), (c), 0, 0, 0)
#define MFMA32(a, b, c) __builtin_amdgcn_mfma_f32_32x32x16_bf16((a), (b), (c), 0, 0, 0)

struct Args { const float* in[45]; float* out; unsigned char* ws; int lo, hi; };

struct Frame {
    LAS unsigned char* lds; volatile LAS unsigned* MISC;
    int tid, lane, wave, G, bid;
    const float* const* in; float* out; unsigned char* ws;
};

__device__ __forceinline__ void tr_item(const float* W, int K, int N, bf16* WT, int drow0, int k0, int n0, LAS float* scr, int lane) {
    const int kr = lane >> 4, nq = lane & 15;
    f32x4 t[8];
#pragma unroll
    for (int i = 0; i < 8; ++i) t[i] = ldnt4(W + (size_t)(k0 + 4 * i + kr) * N + n0 + 4 * nq);
#pragma unroll
    for (int i = 0; i < 8; ++i) { const int row = 4 * i + kr, c = i >> 1; *(LAS f32x4*)(scr + row * 68 + ((4 * nq + 8 * c) & 63)) = t[i]; }
    LDS_WAIT(); asm volatile("" ::: "memory");
    const int c = lane & 3;
#pragma unroll
    for (int p = 0; p < 4; ++p) { const int n = (lane >> 2) + 16 * p; const LAS float* s = scr + (8 * c) * 68 + ((n + 8 * c) & 63);
        v4u o; o.x = pk2(s[0 * 68], s[1 * 68]); o.y = pk2(s[2 * 68], s[3 * 68]); o.z = pk2(s[4 * 68], s[5 * 68]); o.w = pk2(s[6 * 68], s[7 * 68]);
        *(v4u*)(WT + (size_t)(drow0 + n) * K + k0 + 8 * c) = o; }
    LDS_WAIT(); asm volatile("" ::: "memory");
}
__device__ __forceinline__ void p0_prologue(Frame& F) {
    LAS float* scr = (LAS float*)(F.lds + F.wave * 16384);
    const int gw = F.bid * NWAVES + F.wave, NGW = F.G * NWAVES, lane = F.lane;
    unsigned char* ws = F.ws;
#define TR_MAT(Wp, Kk, Nn, Dst, ROWMAP) { const int nblk = (Nn) / 64, cnt = ((Kk) / 32) * nblk; if (r < cnt) { const int kb = r / nblk, n0 = (r % nblk) * 64; \
        tr_item((Wp), (Kk), (Nn), (bf16*)(Dst), (ROWMAP), kb * 32, n0, scr, lane); continue; } r -= cnt; }
    constexpr int NITEMS = 32 * 136 + 2 * 32 * 64 + 32 + 32 + 64;
    for (int it = gw; it < NITEMS; it += NGW) {
        int r = it;
        TR_MAT(F.in[9], DM, DIN, ws + WS_WIN, n0)
        TR_MAT(F.in[35], DM, DM, ws + WS_WKV, n0)
        TR_MAT(F.in[36], DM, DM, ws + WS_WKV, 2048 + n0)
        TR_MAT(F.in[22], 64, DRW, ws + WS_W2T, n0)
        TR_MAT(F.in[24], 64, DRW, ws + WS_A2T, n0)
        TR_MAT(F.in[25], 128, DRW, ws + WS_G2T, n0)
    }
#undef TR_MAT
    const size_t gt = (size_t)F.bid * NTHR + F.tid, NGT = (size_t)F.G * NTHR;
    { const f32x4* xp = (const f32x4*)F.in[0]; const f32x4* xs = (const f32x4*)F.in[1]; v4u* xb = (v4u*)(ws + WS_XB);
      const size_t np = (size_t)MP * DM / 8, nt = (size_t)MT * DM / 8;
      for (size_t i0 = gt; i0 < nt; i0 += 4 * NGT) {
          f32x4 a[4], b[4];
#pragma unroll
          for (int u = 0; u < 4; ++u) { const size_t i = i0 + (size_t)u * NGT; if (i < nt) { const f32x4* s_ = i < np ? xp + 2 * i : xs + 2 * (i - np); a[u] = ldnt4((const float*)s_); b[u] = ldnt4((const float*)(s_ + 1)); } }
#pragma unroll
          for (int u = 0; u < 4; ++u) { const size_t i = i0 + (size_t)u * NGT; if (i < nt) xb[i] = pg8::pack8(a[u], b[u]); } } }
    { const f32x4* mp = (const f32x4*)F.in[2]; v4u* mb = (v4u*)(ws + WS_MB); const size_t nm = (size_t)1024 * DM / 8;
      for (size_t i = gt; i < nm; i += NGT) { const f32x4 a = ldnt4((const float*)(mp + 2 * i)), b = ldnt4((const float*)(mp + 2 * i + 1)); mb[i] = pg8::pack8(a, b); } }
}

constexpr int N_TR_LATE = 16 * 32 + 3 * 32 * 64 + 2 * 32 * 176 + 88 * 64;
__device__ __forceinline__ void tr_late_item(Frame& F, int r, LAS float* scr) {
    constexpr int C0 = 16 * 32, C1 = 32 * 64, C4 = 32 * 176;
    int id, rr = r;
    if (rr < C0) id = 0; else { rr -= C0; if (rr < 3 * C1) { id = 1 + rr / C1; rr = rr % C1; } else { rr -= 3 * C1; if (rr < 2 * C4) { id = 4 + rr / C4; rr = rr % C4; } else { rr -= 2 * C4; id = 6; } } }
    const int K = id == 0 ? DSSM : (id == 6 ? DFF : DM), N = id == 0 ? DSSM : ((id == 4 || id == 5) ? DFF : DM);
    const int src = id == 0 ? 18 : id == 1 ? 31 : id == 2 ? 34 : id == 3 ? 37 : id == 4 ? 40 : id == 5 ? 41 : 42;
    const size_t dsto = id == 0 ? WS_WGLU : id == 1 ? WS_WOUT : id == 2 ? WS_WQ : id == 3 ? WS_WO : id == 6 ? WS_WDN : WS_WGU;
    const int nblk = N / 64, kb = rr / nblk, n0 = (rr % nblk) * 64;
    const int drow0 = (id == 4 || id == 5) ? 256 * (n0 / 128) + (n0 % 128) + (id == 5 ? 128 : 0) : n0;
    tr_item(F.in[src], K, N, (bf16*)(F.ws + dsto), drow0, kb * 32, n0, scr, F.lane);
}

__device__ __forceinline__ void p2_prep(Frame& F) {
    const bf16* H = (const bf16*)(F.ws + WS_H);
    const float* mu = F.in[20]; const float* w0 = F.in[21]; const float* a0 = F.in[23]; const float* k_k = F.in[26]; const float* k_a = F.in[27]; const float* r_k = F.in[28];
    const bf16* W2T = (const bf16*)(F.ws + WS_W2T); const bf16* A2T = (const bf16*)(F.ws + WS_A2T); const bf16* G2T = (const bf16*)(F.ws + WS_G2T);
    float* PR = (float*)(F.ws + WS_PREP); constexpr size_t PS = PREP_STRIDE / 4;
    float* BON = (float*)(F.ws + WS_BONUS);
    const int lane = F.lane, fr = lane & 15, fq = lane >> 4, tid = F.tid, w = F.wave;
    LAS bf16* ACT = (LAS bf16*)F.lds;
    LAS float* PRE = (LAS float*)(F.lds + 8448);
    struct CSet { f32x4 mr, mk, mv, w04, a04, kk4, ka4, rk4, r[2], k[2], v[2], rq[2], kq[2], vq[2]; };
#define P2_ALOAD(item_, X0, X1, Q0, Q1) do { const int tk_ = tid >> 5, c8_ = (tid & 31) * 8, m_ = ((item_) >> 1) * 16 + tk_; \
        const bf16* prow_ = H + (size_t)m_ * DIN + 1024 + 3072 + c8_; const bool prompt_ = m_ < MP; const int t_ = prompt_ ? (m_ & 2047) : ((m_ - MP) & 3); \
        X0 = ldbf4(prow_); X1 = ldbf4(prow_ + 4); \
        if (t_ > 0) { Q0 = ldbf4(prow_ - DIN); Q1 = ldbf4(prow_ - DIN + 4); } \
        else if (prompt_) { Q0 = (f32x4){0.f, 0.f, 0.f, 0.f}; Q1 = Q0; } \
        else { const float* qrow_ = F.in[6] + (size_t)((m_ - MP) >> 2) * DSH + 3072 + c8_; Q0 = *(const f32x4*)qrow_; Q1 = *(const f32x4*)(qrow_ + 4); } } while (0)
#define P2_CLOAD(CS, tile_, half_, j_) do { const int col_ = 512 * (half_) + 4 * lane + 256 * (j_); \
        CS.mr = *(const f32x4*)(mu + col_); CS.mk = *(const f32x4*)(mu + 1024 + col_); CS.mv = *(const f32x4*)(mu + 2048 + col_); \
        CS.w04 = *(const f32x4*)(w0 + col_); CS.a04 = *(const f32x4*)(a0 + col_); CS.kk4 = *(const f32x4*)(k_k + col_); CS.ka4 = *(const f32x4*)(k_a + col_); CS.rk4 = *(const f32x4*)(r_k + col_); \
        _Pragma("unroll") for (int tq_ = 0; tq_ < 2; ++tq_) { const int m_ = (tile_) * 16 + 2 * w + tq_; const bf16* prow_ = H + (size_t)m_ * DIN + 1024 + col_; \
            const bool prompt_ = m_ < MP; const int t_ = prompt_ ? (m_ & 2047) : ((m_ - MP) & 3); \
            CS.r[tq_] = ldbf4(prow_); CS.k[tq_] = ldbf4(prow_ + 1024); CS.v[tq_] = ldbf4(prow_ + 2048); \
            if (t_ > 0) { CS.rq[tq_] = ldbf4(prow_ - DIN); CS.kq[tq_] = ldbf4(prow_ - DIN + 1024); CS.vq[tq_] = ldbf4(prow_ - DIN + 2048); } \
            else if (prompt_) { CS.rq[tq_] = (f32x4){0.f, 0.f, 0.f, 0.f}; CS.kq[tq_] = CS.rq[tq_]; CS.vq[tq_] = CS.rq[tq_]; } \
            else { const float* qrow_ = F.in[6] + (size_t)((m_ - MP) >> 2) * DSH + col_; CS.rq[tq_] = *(const f32x4*)qrow_; CS.kq[tq_] = *(const f32x4*)(qrow_ + 1024); CS.vq[tq_] = *(const f32x4*)(qrow_ + 2048); } } } while (0)
#define P2_CCOMP(CS, tile_, half_, j_) do { const int lc_ = 4 * lane + 256 * (j_), col_ = 512 * (half_) + lc_, hd_ = 8 * (half_) + 4 * (j_) + (lane >> 4); \
        _Pragma("unroll") for (int tq_ = 0; tq_ < 2; ++tq_) { const int tk_ = 2 * w + tq_, m_ = (tile_) * 16 + tk_; \
            const f32x4 r4 = CS.r[tq_] + (CS.rq[tq_] - CS.r[tq_]) * CS.mr, k4 = CS.k[tq_] + (CS.kq[tq_] - CS.k[tq_]) * CS.mk, v4 = CS.v[tq_] + (CS.vq[tq_] - CS.v[tq_]) * CS.mv; \
            const f32x4 pW = *(const LAS f32x4*)(PRE + (0 * 16 + tk_) * 516 + lc_), pA = *(const LAS f32x4*)(PRE + (1 * 16 + tk_) * 516 + lc_), pG = *(const LAS f32x4*)(PRE + (2 * 16 + tk_) * 516 + lc_); \
            f32x4 dec, a, km, kkr; float ss = 0.f; \
            _Pragma("unroll") for (int e = 0; e < 4; ++e) {   \
                dec[e] = __expf(-0.6065306597126334f * sigm(CS.w04[e] + pW[e])); a[e] = sigm(CS.a04[e] + pA[e]); km[e] = k4[e] * (1.0f + (a[e] - 1.0f) * CS.ka4[e]); \
                kkr[e] = k4[e] * CS.kk4[e]; ss += kkr[e] * kkr[e]; } \
            ss = sum16(ss); \
            const float inv = rsqrtf(fmaxf(ss, 1e-24f)); \
            const f32x4 kk = kkr * inv, bb = kk * a; \
            float bon = (r4[0] * km[0] * CS.rk4[0] + r4[1] * km[1] * CS.rk4[1]) + (r4[2] * km[2] * CS.rk4[2] + r4[3] * km[3] * CS.rk4[3]); \
            float br = (bb[0] * r4[0] + bb[1] * r4[1]) + (bb[2] * r4[2] + bb[3] * r4[3]); \
            float kr = (km[0] * r4[0] + km[1] * r4[1]) + (km[2] * r4[2] + km[3] * r4[3]); \
            bon = sum16(bon); br = sum16(br); kr = sum16(kr); \
            const size_t o = (size_t)m_ * 1024 + col_; \
            *(f32x4*)(PR + 0 * PS + o) = dec * r4; *(f32x4*)(PR + 1 * PS + o) = dec; *(f32x4*)(PR + 2 * PS + o) = km; *(f32x4*)(PR + 3 * PS + o) = v4; \
            *(f32x4*)(PR + 4 * PS + o) = -kk; *(f32x4*)(PR + 5 * PS + o) = bb; *(f32x4*)(PR + 6 * PS + o) = pG; \
            if ((lane & 15) == 0) *(f32x4*)(BON + ((size_t)m_ * 16 + hd_) * 4) = (f32x4){bon, br, kr, 0.f}; } } while (0)
    const int NIT = 2 * (MT / 16);
    f32x4 ax0, ax1, aq0, aq1;
    if (F.bid < NIT) P2_ALOAD(F.bid, ax0, ax1, aq0, aq1);
    for (int item = F.bid; item < NIT; item += F.G) {
        const int tile = item >> 1, half = item & 1;
        { const int tk = tid >> 5, c8 = (tid & 31) * 8;
          const f32x4 m0 = *(const f32x4*)(mu + 3072 + c8), m1 = *(const f32x4*)(mu + 3072 + c8 + 4);
          f32x4 x0 = ax0 + (aq0 - ax0) * m0, x1 = ax1 + (aq1 - ax1) * m1;
          if (c8 < 64) {
#pragma unroll
              for (int j = 0; j < 4; ++j) { x0[j] = tanh_(x0[j]); x1[j] = tanh_(x1[j]); }
          } else if (c8 >= 128) {
#pragma unroll
              for (int j = 0; j < 4; ++j) { x0[j] = sigm(x0[j]); x1[j] = sigm(x1[j]); } }
          *(LAS bf16x8*)(ACT + tk * 264 + c8) = pack_bf8(x0, x1); }
        CSet c0; P2_CLOAD(c0, tile, half, 0);
        __syncthreads();
        bf16x8 bw[2], ba[2], bg[4];
#pragma unroll
        for (int kc = 0; kc < 2; ++kc) { bw[kc] = *(const LAS bf16x8*)(ACT + fr * 264 + 32 * kc + 8 * fq); ba[kc] = *(const LAS bf16x8*)(ACT + fr * 264 + 64 + 32 * kc + 8 * fq); }
#pragma unroll
        for (int kc = 0; kc < 4; ++kc) bg[kc] = *(const LAS bf16x8*)(ACT + fr * 264 + 128 + 32 * kc + 8 * fq);
        { const int hd = 8 * half + w;
#pragma unroll
          for (int ct = 0; ct < 4; ++ct) { const int c = 64 * hd + 16 * ct + fr;
              f32x4 aW = (f32x4){0.f, 0.f, 0.f, 0.f}, aA = aW, aG = aW;
#pragma unroll
              for (int kc = 0; kc < 2; ++kc) { aW = MFMA16(*(const bf16x8*)(W2T + c * 64 + 32 * kc + 8 * fq), bw[kc], aW);
                                                aA = MFMA16(*(const bf16x8*)(A2T + c * 64 + 32 * kc + 8 * fq), ba[kc], aA); }
#pragma unroll
              for (int kc = 0; kc < 4; ++kc) aG = MFMA16(*(const bf16x8*)(G2T + c * 128 + 32 * kc + 8 * fq), bg[kc], aG);
              const int lc = 64 * w + 16 * ct + 4 * fq;
              *(LAS f32x4*)(PRE + (0 * 16 + fr) * 516 + lc) = aW; *(LAS f32x4*)(PRE + (1 * 16 + fr) * 516 + lc) = aA; *(LAS f32x4*)(PRE + (2 * 16 + fr) * 516 + lc) = aG; } }
        CSet c1; P2_CLOAD(c1, tile, half, 1);
        if (item + F.G < NIT) P2_ALOAD(item + F.G, ax0, ax1, aq0, aq1);
        __syncthreads();
        P2_CCOMP(c0, tile, half, 0);
        P2_CCOMP(c1, tile, half, 1);
        __syncthreads();
    }
#undef P2_ALOAD
#undef P2_CLOAD
#undef P2_CCOMP
    { const int gt = F.bid * NTHR + F.tid, NGT = F.G * NTHR;
      for (int i = gt; i < 132 * (DSH / 4); i += NGT) { const int s = i / (DSH / 4), c4 = i % (DSH / 4);
          const int m = s < 4 ? s * 2048 + 2047 : MP + 4 * (s - 4) + 3;
          float* o = s < 4 ? F.out + O_SH_P + (size_t)s * DSH : F.out + O_SH_S + (size_t)(s - 4) * DSH;
          stnt4(o + 4 * c4, ldbf4(H + (size_t)m * DIN + 1024 + 4 * c4)); } }
}

__device__ __forceinline__ void grp_bar(volatile LAS unsigned* cnt, unsigned& gen, int lane) {
    gen += 4u; LDS_WAIT();
    if (lane == 0) (void)__hip_atomic_fetch_add((LAS unsigned*)cnt, 1u, __ATOMIC_RELAXED, __HIP_MEMORY_SCOPE_WORKGROUP);
    while (*cnt < gen) __builtin_amdgcn_s_sleep(1);
    asm volatile("" ::: "memory");
}
__device__ __forceinline__ void rwkv_scan_prompt(Frame& F, int b, int h, int quarter) {
    const float* PR = (const float*)(F.ws + WS_PREP); constexpr size_t PS = PREP_STRIDE / 4;
    const float* BON = (const float*)(F.ws + WS_BONUS);
    float* YR = (float*)(F.ws + WS_YR);
    const int tid = F.tid, lane = F.lane, rr = lane >> 4, kq = lane & 15, v = 16 * quarter + 4 * F.wave + rr, m0 = b * 2048;
    constexpr int SST = 388, BST = 16 * SST;
    LAS float* buf = (LAS float*)F.lds;
    volatile LAS unsigned* cnt = F.MISC + 16; unsigned gen = 0u;
    f32x4 S = (f32x4){0.f, 0.f, 0.f, 0.f};
    const int step_l = tid >> 4, part = tid & 15;
    f32x4 stP[6], sbP, stQ[6], sbQ;
#define RW_GLOAD(c, ST, SB) do { const size_t off_ = (size_t)(m0 + (c) * 16 + step_l) * 1024 + h * 64 + 4 * part; \
        ST[0] = *(const f32x4*)(PR + 1 * PS + off_); ST[1] = *(const f32x4*)(PR + 4 * PS + off_); ST[2] = *(const f32x4*)(PR + 5 * PS + off_); \
        ST[3] = *(const f32x4*)(PR + 2 * PS + off_); ST[4] = *(const f32x4*)(PR + 0 * PS + off_); ST[5] = *(const f32x4*)(PR + 3 * PS + off_); \
        if (part == 0) SB = *(const f32x4*)(BON + ((size_t)(m0 + (c) * 16 + step_l) * 16 + h) * 4); } while (0)
#define RW_LSTORE(bi, ST, SB) do { LAS float* d_ = buf + (bi) * BST + step_l * SST + 4 * part; _Pragma("unroll") for (int q = 0; q < 6; ++q) *(LAS f32x4*)(d_ + q * 64) = ST[q]; \
        if (part == 0) *(LAS f32x4*)(d_ + 384) = SB; } while (0)
#define RW_LREAD(sb_, W_, NK_, B_, K_, WR_, VV_, SC_) do { W_ = *(const LAS f32x4*)((sb_) + 4 * kq); NK_ = *(const LAS f32x4*)((sb_) + 64 + 4 * kq); B_ = *(const LAS f32x4*)((sb_) + 128 + 4 * kq); \
        K_ = *(const LAS f32x4*)((sb_) + 192 + 4 * kq); WR_ = *(const LAS f32x4*)((sb_) + 256 + 4 * kq); VV_ = (sb_)[320 + v]; SC_ = *(const LAS f32x4*)((sb_) + 384); } while (0)
#define RW_CHUNK(c, cb) do { float yk = 0.f; f32x4 nw, nnk, nb, nk, nwr, nsc; float nvv; \
        RW_LREAD((cb), nw, nnk, nb, nk, nwr, nvv, nsc); \
        _Pragma("unroll") for (int s = 0; s < 16; ++s) { \
            const f32x4 w4 = nw, nk4 = nnk, b4 = nb, k4 = nk, wr4 = nwr, sc = nsc; const float vv = nvv; \
            if (s + 1 < 16) RW_LREAD((cb) + (s + 1) * SST, nw, nnk, nb, nk, nwr, nvv, nsc); \
            float sa = (S[0] * nk4[0] + S[1] * nk4[1]) + (S[2] * nk4[2] + S[3] * nk4[3]); \
            float p = (S[0] * wr4[0] + S[1] * wr4[1]) + (S[2] * wr4[2] + S[3] * wr4[3]); \
            sa += dpp_f<0xB1>(sa); p += dpp_f<0xB1>(p); sa += dpp_f<0x4E>(sa); p += dpp_f<0x4E>(p); \
            sa += dpp_f<0x141>(sa); p += dpp_f<0x141>(p); sa += dpp_f<0x140>(sa); p += dpp_f<0x140>(p); \
            S = S * w4 + (b4 * sa + k4 * vv); \
            const float y = p + sa * sc[1] + vv * sc[2]; \
            yk = (kq == s) ? y : yk; } \
        YR[(size_t)(m0 + 16 * (c) + kq) * 1024 + h * 64 + v] = yk; } while (0)
    sbP = (f32x4){0.f, 0.f, 0.f, 0.f}; sbQ = sbP;
    RW_GLOAD(0, stP, sbP); RW_LSTORE(0, stP, sbP); RW_GLOAD(1, stP, sbP); RW_GLOAD(2, stQ, sbQ); grp_bar(cnt, gen, lane);
    for (int c = 0; c < 128; c += 2) {
        RW_CHUNK(c, buf);
        RW_LSTORE(1, stP, sbP); grp_bar(cnt, gen, lane);
        if (c + 3 < 128) RW_GLOAD(c + 3, stP, sbP);
        RW_CHUNK(c + 1, buf + BST);
        if (c + 2 < 128) RW_LSTORE(0, stQ, sbQ);
        grp_bar(cnt, gen, lane);
        if (c + 4 < 128) RW_GLOAD(c + 4, stQ, sbQ);
    }
#undef RW_CHUNK
#undef RW_GLOAD
#undef RW_LSTORE
#undef RW_LREAD
    stnt4(F.out + O_WKV_P + (size_t)(b * 16 + h) * 4096 + v * 64 + 4 * kq, S);
}
__device__ __forceinline__ void rwkv_sample_item(Frame& F, int b, int h) {
    const float* PR = (const float*)(F.ws + WS_PREP); constexpr size_t PS = PREP_STRIDE / 4;
    const float* BON = (const float*)(F.ws + WS_BONUS);
    float* YR = (float*)(F.ws + WS_YR);
    const int lane = F.lane, rr = lane >> 4, kq = lane & 15, m0 = MP + 4 * b;
    const float* s_in = F.in[5] + (size_t)(b * 16 + h) * 4096; float* s_out = F.out + O_WKV_S + (size_t)(b * 16 + h) * 4096;
    f32x4 w4[4], nk4[4], b4[4], k4[4], wr4[4], sc[4];
#pragma unroll
    for (int t = 0; t < 4; ++t) { const size_t off = (size_t)(m0 + t) * 1024 + h * 64 + 4 * kq;
        w4[t] = *(const f32x4*)(PR + 1 * PS + off); nk4[t] = *(const f32x4*)(PR + 4 * PS + off); b4[t] = *(const f32x4*)(PR + 5 * PS + off);
        k4[t] = *(const f32x4*)(PR + 2 * PS + off); wr4[t] = *(const f32x4*)(PR + 0 * PS + off); sc[t] = *(const f32x4*)(BON + ((size_t)(m0 + t) * 16 + h) * 4); }
#pragma unroll 4
    for (int rg = 0; rg < 16; ++rg) { const int v = 4 * rg + rr;
        f32x4 S = ldnt4(s_in + v * 64 + 4 * kq);
        float vv[4];
#pragma unroll
        for (int t = 0; t < 4; ++t) vv[t] = PR[3 * PS + (size_t)(m0 + t) * 1024 + h * 64 + v];
        float yk = 0.f;
#pragma unroll
        for (int t = 0; t < 4; ++t) {
            float sa = (S[0] * nk4[t][0] + S[1] * nk4[t][1]) + (S[2] * nk4[t][2] + S[3] * nk4[t][3]);
            float p = (S[0] * wr4[t][0] + S[1] * wr4[t][1]) + (S[2] * wr4[t][2] + S[3] * wr4[t][3]);
            sa = sum16(sa); p = sum16(p);
            S = S * w4[t] + (b4[t] * sa + k4[t] * vv[t]);
            const float y = p + sa * sc[t][1] + vv[t] * sc[t][2];
            yk = (kq == t) ? y : yk;
        }
        if (kq < 4) YR[(size_t)(m0 + kq) * 1024 + h * 64 + v] = yk;
        stnt4(s_out + v * 64 + 4 * kq, S); }
}

template <int SEG> __device__ __forceinline__ void ssm_item(Frame& F, int g, int sel) {
    const bf16* H = (const bf16*)(F.ws + WS_H);
    bf16* YG = (bf16*)(F.ws + WS_YGB);
    const int lane = F.lane, n = lane & 31, hh = lane >> 5, fr = lane & 15, fq = lane >> 4;
    LAS bf16* ldsS = (LAS bf16*)(F.lds + 50176 + F.wave * 8704);
    const float dt = __expf(F.in[17][g]);
    float lr[2], li[2]; bf16x8 Bre[2], Bim[2];
#pragma unroll
    for (int pp = 0; pp < 2; ++pp) { const int p = 2 * n + pp; const float are = F.in[10][g * 64 + p], aim = F.in[11][g * 64 + p];
        const float mag = expf(are * dt), ang = aim * dt; float sn, cs; sincosf(ang, &sn, &cs); lr[pp] = mag * cs; li[pp] = mag * sn;
        const float sh = sinf(0.5f * ang); const float xr = expm1f(are * dt) * cs - 2.0f * sh * sh, xi = mag * sn;
        const float den = 1.0f / (are * are + aim * aim); const float qr = (xr * are + xi * aim) * den, qi = (xi * are - xr * aim) * den;
        const float* brp = F.in[12] + (size_t)(g * 64 + p) * 16 + 8 * hh; const float* bip = F.in[13] + (size_t)(g * 64 + p) * 16 + 8 * hh;
        const f32x4 br0 = *(const f32x4*)brp, br1 = *(const f32x4*)(brp + 4), bi0 = *(const f32x4*)bip, bi1 = *(const f32x4*)(bip + 4);
        Bre[pp] = pack_bf8(br0 * qr - bi0 * qi, br1 * qr - bi1 * qi); Bim[pp] = pack_bf8(bi0 * qr + br0 * qi, bi1 * qr + br1 * qi); }
    bf16x8 Cop[4];
#pragma unroll
    for (int kc = 0; kc < 4; ++kc) { const float* cp = (kc < 2 ? F.in[14] : F.in[15]) + (size_t)(g * 16 + fr) * 64 + 32 * (kc & 1) + 8 * fq; const float sg = kc < 2 ? 1.0f : -1.0f;
        Cop[kc] = pack_bf8(*(const f32x4*)cp * sg, *(const f32x4*)(cp + 4) * sg); }
    const f32x4 d4 = *(const f32x4*)(F.in[16] + 16 * g + 4 * fq);
    float sre[2] = {0.f, 0.f}, sim[2] = {0.f, 0.f};
    const int ntile = SEG == 16 ? 128 : 1;
    const int hr = (n >> 2) & 1, ir = 4 * (n >> 3) + (n & 3);
#define SSM_AROW(t_) (SEG == 16 ? (2 * sel + hr) * 2048 + (t_) * 16 + ir : MP + 4 * (8 * sel + 4 * hr + (ir >> 2)) + (ir & 3))
#define SSM_OROW(t_, rg_) (SEG == 16 ? (2 * sel + (rg_)) * 2048 + (t_) * 16 + fr : MP + 4 * (8 * sel + 4 * (rg_) + (fr >> 2)) + (fr & 3))
#define SSM_LOAD(t_, A0, A1_, U0, U1) do { A0 = *(const bf16x8*)(H + (size_t)SSM_AROW(t_) * DIN + 16 * g + 8 * hh); A1_ = A0; \
        U0 = *(const v2u*)(H + (size_t)SSM_OROW(t_, 0) * DIN + 16 * g + 4 * fq); U1 = *(const v2u*)(H + (size_t)SSM_OROW(t_, 1) * DIN + 16 * g + 4 * fq); } while (0)
    bf16x8 pa0[2], pa1[2]; v2u pu0[2], pu1[2];
    SSM_LOAD(0, pa0[0], pa1[0], pu0[0], pu1[0]);
    if (ntile > 1) SSM_LOAD(1, pa0[1], pa1[1], pu0[1], pu1[1]); else { pa0[1] = pa0[0]; pa1[1] = pa1[0]; pu0[1] = pu0[0]; pu1[1] = pu1[0]; }
    for (int tile = 0; tile < ntile; ++tile) {
        const bf16x8 ca0 = pa0[0]; const v2u cu[2] = {pu0[0], pu1[0]};
        pa0[0] = pa0[1]; pa1[0] = pa1[1]; pu0[0] = pu0[1]; pu1[0] = pu1[1];
        if (tile + 2 < ntile) SSM_LOAD(tile + 2, pa0[1], pa1[1], pu0[1], pu1[1]);
        const bf16x8 A1 = ca0;
        const f32x16 z16 = {0.f, 0.f, 0.f, 0.f, 0.f, 0.f, 0.f, 0.f, 0.f, 0.f, 0.f, 0.f, 0.f, 0.f, 0.f, 0.f};
        f32x16 aRe[2], aIm[2];
#pragma unroll
        for (int pp = 0; pp < 2; ++pp) { aRe[pp] = MFMA32(A1, Bre[pp], z16); aIm[pp] = MFMA32(A1, Bim[pp], z16); }
#pragma unroll
        for (int i = 0; i < 16; ++i) {
            if (SEG == 4 && (i & 3) == 0) { const int batch = 8 * sel + 4 * hh + (i >> 2); const size_t so = (size_t)(batch * 64 + g) * 64 + 2 * n;
                const f32x2 a = *(const f32x2*)(F.in[3] + so), b = *(const f32x2*)(F.in[4] + so); sre[0] = a[0]; sre[1] = a[1]; sim[0] = b[0]; sim[1] = b[1]; }
#pragma unroll
            for (int pp = 0; pp < 2; ++pp) { const float nr = lr[pp] * sre[pp] - li[pp] * sim[pp] + aRe[pp][i], ni = lr[pp] * sim[pp] + li[pp] * sre[pp] + aIm[pp][i]; sre[pp] = nr; sim[pp] = ni; }
            *(LAS unsigned*)(ldsS + (16 * hh + i) * 136 + 2 * n) = pk2(sre[0], sre[1]);
            *(LAS unsigned*)(ldsS + (16 * hh + i) * 136 + 64 + 2 * n) = pk2(sim[0], sim[1]);
            if (SEG == 4 && (i & 3) == 3) { const int batch = 8 * sel + 4 * hh + (i >> 2); const size_t so = (size_t)(batch * 64 + g) * 64 + 2 * n;
                *(f32x2*)(F.out + O_SRE_S + so) = (f32x2){sre[0], sre[1]}; *(f32x2*)(F.out + O_SIM_S + so) = (f32x2){sim[0], sim[1]}; }
        }
        LDS_WAIT(); asm volatile("" ::: "memory");
#pragma unroll
        for (int rg = 0; rg < 2; ++rg) {
            f32x4 aY = (f32x4){0.f, 0.f, 0.f, 0.f};
#pragma unroll
            for (int kc = 0; kc < 4; ++kc) aY = MFMA16(Cop[kc], *(const LAS bf16x8*)(ldsS + (16 * rg + fr) * 136 + 32 * kc + 8 * fq), aY);
            const int orow = SSM_OROW(tile, rg);
            const f32x4 u4 = (f32x4){pg8::bf_lo(cu[rg].x), pg8::bf_hi(cu[rg].x), pg8::bf_lo(cu[rg].y), pg8::bf_hi(cu[rg].y)};
            const f32x4 y = aY + d4 * u4;
            v2u w; w.x = pk2(gelu_tanh(y[0]), gelu_tanh(y[1])); w.y = pk2(gelu_tanh(y[2]), gelu_tanh(y[3]));
            *(v2u*)(YG + (size_t)orow * 1024 + 16 * g + 4 * fq) = w;
        }
        LDS_WAIT(); asm volatile("" ::: "memory");
    }
    if (SEG == 16) { const size_t so = (size_t)((2 * sel + hh) * 64 + g) * 64 + 2 * n;
        *(f32x2*)(F.out + O_SRE_P + so) = (f32x2){sre[0], sre[1]}; *(f32x2*)(F.out + O_SIM_P + so) = (f32x2){sim[0], sim[1]}; }
}

__device__ __forceinline__ void p3_scans(Frame& F, int rep) {
    unsigned* ctr = (unsigned*)(F.ws + WS_CTL) + 128 * rep;
    constexpr int N_SP = 128, N_RS = 2048, N_SS = 1024, TOTAL = N_SP + N_RS + N_SS + N_TR_LATE;
    if (F.tid == 0) F.MISC[16] = 0u;
    __syncthreads();
    if (F.wave < 4) { __builtin_amdgcn_s_setprio(3); for (int it = F.bid; it < 256; it += F.G) rwkv_scan_prompt(F, it >> 6, (it >> 2) & 15, it & 3); __builtin_amdgcn_s_setprio(0); }
    if (MK_TS >= 200 && F.bid == 0 && F.tid == 0) ((unsigned long long*)(F.ws + WS_CTL + 32768))[20] = __builtin_amdgcn_s_memrealtime();
    (void)ctr;
    if (F.wave >= 4) {
        const int q = (F.wave - 4) * F.G + F.bid, NQ = 4 * F.G;
        if (q < N_SP) { __builtin_amdgcn_s_setprio(2); ssm_item<16>(F, q >> 1, q & 1); __builtin_amdgcn_s_setprio(0); }
        else { const int i0 = q - N_SP, st = NQ - N_SP;
            for (int it = i0; it < N_RS; it += st) rwkv_sample_item(F, it >> 4, it & 15);
            for (int it = i0; it < N_SS; it += st) ssm_item<4>(F, it >> 4, it & 15);
            for (int it = i0; it < N_TR_LATE; it += st) tr_late_item(F, it, (LAS float*)(F.lds + 50176 + F.wave * 8704)); }
    }
    if (MK_TS >= 200 && F.bid == 0 && F.tid == 256) ((unsigned long long*)(F.ws + WS_CTL + 32768))[21] = __builtin_amdgcn_s_memrealtime();
}

__device__ __forceinline__ void p4_post(Frame& F, int rep) {
    unsigned* ctr = (unsigned*)(F.ws + WS_CTL) + 64 + 128 * rep;
    const float* PR = (const float*)(F.ws + WS_PREP); constexpr size_t PS = PREP_STRIDE / 4;
    const float* YR = (const float*)(F.ws + WS_YR); const float* BON = (const float*)(F.ws + WS_BONUS);
    const float* lg = F.in[29]; const float* lb = F.in[30];
    bf16* MIX = (bf16*)(F.ws + WS_MIX);
    const int lane = F.lane;
    for (;;) {
        __syncthreads();
        if (F.tid == 0) F.MISC[0] = atomicAdd(ctr, 1u);
        __syncthreads();
        const int it = (int)F.MISC[0];
        if (it >= MT / 16) break;
#pragma unroll
        for (int q = 0; q < 2; ++q) { const int m = it * 16 + 2 * F.wave + q;
#pragma unroll
            for (int j = 0; j < 4; ++j) { const int col = 256 * j + 4 * lane, hd = 4 * j + (lane >> 4); const size_t o = (size_t)m * 1024 + col;
                const f32x4 y = *(const f32x4*)(YR + o);
                const float mean = sum16((y[0] + y[1]) + (y[2] + y[3])) * (1.0f / 64.0f);
                const f32x4 d = y - mean;
                const float var = sum16((d[0] * d[0] + d[1] * d[1]) + (d[2] * d[2] + d[3] * d[3])) * (1.0f / 64.0f);
                const float rstd = rsqrtf(var + GN_EPS), bon = BON[((size_t)m * 16 + hd) * 4];
                const f32x4 v4 = *(const f32x4*)(PR + 3 * PS + o), g4 = *(const f32x4*)(PR + 6 * PS + o), lg4 = *(const f32x4*)(lg + col), lb4 = *(const f32x4*)(lb + col);
                const f32x4 ov = (d * rstd * lg4 + lb4 + v4 * bon) * g4;
                v2u w; w.x = pk2(ov[0], ov[1]); w.y = pk2(ov[2], ov[3]);
                *(v2u*)(MIX + (size_t)m * 2048 + 1024 + col) = w; } }
    }
}

__device__ __forceinline__ void ln_rows(Frame& F, const bf16* src, const float* gam, const float* bet, float* dstf, bf16* dstb, const float* sbase_f, const bf16* sbase_b, const float* part, int nsplit) {
    const int gw = F.bid * NWAVES + F.wave, NGW = F.G * NWAVES, lane = F.lane;
    const bool has_s = (gw & 3) == 0 && (gw >> 2) < (MT - MP);
#define LN_UNPK(W_, A_, B_) do { A_ = (f32x4){pg8::bf_lo(W_.x), pg8::bf_hi(W_.x), pg8::bf_lo(W_.y), pg8::bf_hi(W_.y)}; B_ = (f32x4){pg8::bf_lo(W_.z), pg8::bf_hi(W_.z), pg8::bf_lo(W_.w), pg8::bf_hi(W_.w)}; } while (0)
    for (int it = has_s ? -1 : 0; it < MP / NGW; it += (it < 0 ? 1 : 2)) {
        const int row0 = it < 0 ? MP + (gw >> 2) : gw + it * NGW, row1 = it < 0 ? row0 : row0 + NGW;
        f32x4 v[2][8];
        if (it < 0) {
            if (sbase_f) { const f32x4* sb = (const f32x4*)(sbase_f + (size_t)(row0 - MP) * DM) + 2 * lane;
#pragma unroll
                for (int j = 0; j < 4; ++j) { v[0][2 * j] = sb[128 * j] * ALPHA; v[0][2 * j + 1] = sb[128 * j + 1] * ALPHA; } }
            else { const v4u* sb = (const v4u*)(sbase_b + (size_t)(row0 - MP) * DM) + lane;
#pragma unroll
                for (int j = 0; j < 4; ++j) { const v4u w = sb[64 * j]; LN_UNPK(w, v[0][2 * j], v[0][2 * j + 1]); v[0][2 * j] = v[0][2 * j] * ALPHA; v[0][2 * j + 1] = v[0][2 * j + 1] * ALPHA; } }
#pragma unroll 4
            for (int ks = 0; ks < nsplit; ++ks) { const f32x4* pp = (const f32x4*)(part + ((size_t)ks * 512 + (row0 - MP)) * DM) + 2 * lane;
#pragma unroll
                for (int j = 0; j < 4; ++j) { v[0][2 * j] += pp[128 * j]; v[0][2 * j + 1] += pp[128 * j + 1]; } }
#pragma unroll
            for (int j = 0; j < 8; ++j) v[1][j] = v[0][j];
        } else { const v4u* s0 = (const v4u*)(src + (size_t)row0 * DM) + lane; const v4u* s1 = (const v4u*)(src + (size_t)row1 * DM) + lane;
#pragma unroll
            for (int j = 0; j < 4; ++j) { const v4u w0 = s0[64 * j], w1 = s1[64 * j]; LN_UNPK(w0, v[0][2 * j], v[0][2 * j + 1]); LN_UNPK(w1, v[1][2 * j], v[1][2 * j + 1]); } }
        float sm0 = 0.f, sm1 = 0.f;
#pragma unroll
        for (int j = 0; j < 8; ++j) { sm0 += (v[0][j][0] + v[0][j][1]) + (v[0][j][2] + v[0][j][3]); sm1 += (v[1][j][0] + v[1][j][1]) + (v[1][j][2] + v[1][j][3]); }
#pragma unroll
        for (int o = 1; o < 64; o <<= 1) { sm0 += __shfl_xor(sm0, o); sm1 += __shfl_xor(sm1, o); }
        const float mean0 = sm0 * (1.0f / DM), mean1 = sm1 * (1.0f / DM); float q0 = 0.f, q1 = 0.f;
#pragma unroll
        for (int j = 0; j < 8; ++j) { v[0][j] = v[0][j] - mean0; v[1][j] = v[1][j] - mean1;
            q0 += (v[0][j][0] * v[0][j][0] + v[0][j][1] * v[0][j][1]) + (v[0][j][2] * v[0][j][2] + v[0][j][3] * v[0][j][3]);
            q1 += (v[1][j][0] * v[1][j][0] + v[1][j][1] * v[1][j][1]) + (v[1][j][2] * v[1][j][2] + v[1][j][3] * v[1][j][3]); }
#pragma unroll
        for (int o = 1; o < 64; o <<= 1) { q0 += __shfl_xor(q0, o); q1 += __shfl_xor(q1, o); }
        const float rstd0 = rsqrtf(q0 * (1.0f / DM) + LN_EPS), rstd1 = rsqrtf(q1 * (1.0f / DM) + LN_EPS);
#pragma unroll
        for (int j = 0; j < 4; ++j) { const int c8 = 8 * (lane + 64 * j);
            const f32x4 g0 = *(const f32x4*)(gam + c8), g1 = *(const f32x4*)(gam + c8 + 4), b0 = *(const f32x4*)(bet + c8), b1 = *(const f32x4*)(bet + c8 + 4);
            const f32x4 o00 = v[0][2 * j] * rstd0 * g0 + b0, o01 = v[0][2 * j + 1] * rstd0 * g1 + b1, o10 = v[1][2 * j] * rstd1 * g0 + b0, o11 = v[1][2 * j + 1] * rstd1 * g1 + b1;
            if (dstf) { float* d0 = dstf + (size_t)row0 * DM + c8; __builtin_nontemporal_store(o00, (f32x4*)d0); __builtin_nontemporal_store(o01, (f32x4*)(d0 + 4));
                if (it >= 0) { float* d1 = dstf + (size_t)row1 * DM + c8; __builtin_nontemporal_store(o10, (f32x4*)d1); __builtin_nontemporal_store(o11, (f32x4*)(d1 + 4)); } }
            if (dstb) { *(v4u*)(dstb + (size_t)row0 * DM + c8) = pg8::pack8(o00, o01); if (it >= 0) *(v4u*)(dstb + (size_t)row1 * DM + c8) = pg8::pack8(o10, o11); } }
    }
#undef LN_UNPK
}

__device__ __forceinline__ void attn_prompt_unit(Frame& F, int b, int h, int qt) {
    const bf16* Qb = (const bf16*)(F.ws + WS_QB); const bf16* Kb = (const bf16*)(F.ws + WS_KB); const bf16* VT = (const bf16*)(F.ws + WS_VTB);
    bf16* Ob = (bf16*)(F.ws + WS_OB);
    const int lane = F.lane, fr = lane & 15, fq = lane >> 4, tid = F.tid;
    const int m = b * 2048 + qt * 128 + 16 * F.wave + fr;
    constexpr int BUFB = 33792;
    v4u stg[2][4];
#define AT_GLOAD(ch, ST) do { _Pragma("unroll") for (int i_ = 0; i_ < 4; ++i_) { const int seg_ = i_ * 512 + tid; \
        if ((ch) < 8) { const int r_ = seg_ >> 6, sg_ = seg_ & 63; ST[i_] = *(const v4u*)(Kb + (size_t)(b * NMEM + 32 * (ch) + r_) * DM + h * 512 + sg_ * 8); } \
        else { const int r_ = seg_ >> 5, sg_ = seg_ & 31; ST[i_] = *(const v4u*)(VT + (size_t)(h * 512 + 64 * ((ch) - 8) + r_) * 1024 + b * NMEM + sg_ * 8); } } } while (0)
#define AT_LSTORE(ch, ST) do { LAS unsigned char* d_ = F.lds + ((ch) & 1) * BUFB; _Pragma("unroll") for (int i_ = 0; i_ < 4; ++i_) { const int seg_ = i_ * 512 + tid; \
        if ((ch) < 8) { const int r_ = seg_ >> 6, sg_ = seg_ & 63; *(LAS v4u*)(d_ + r_ * 1040 + sg_ * 16) = ST[i_]; } \
        else { const int r_ = seg_ >> 5, sg_ = seg_ & 31; *(LAS v4u*)(d_ + r_ * 528 + sg_ * 16) = ST[i_]; } } } while (0)
    AT_GLOAD(0, stg[0]); AT_GLOAD(1, stg[1]);
    bf16x8 Qf[16];
#pragma unroll
    for (int kc = 0; kc < 16; ++kc) Qf[kc] = *(const bf16x8*)(Qb + (size_t)m * DM + h * 512 + 32 * kc + 8 * fq);
    AT_LSTORE(0, stg[0]); __syncthreads();
    f32x4 s[8][2]; bf16x8 Pf[8];
#pragma unroll
    for (int ch = 0; ch < 16; ++ch) {
        if (ch + 2 < 16) AT_GLOAD(ch + 2, stg[ch & 1]);
        const LAS unsigned char* cb = F.lds + (ch & 1) * BUFB;
        if (ch < 8) {
#pragma unroll
            for (int sb = 0; sb < 2; ++sb) { const LAS unsigned char* krow = cb + (8 * (fr >> 2) + 4 * sb + (fr & 3)) * 1040 + 16 * fq; f32x4 acc = (f32x4){0.f, 0.f, 0.f, 0.f};
#pragma unroll
                for (int kc = 0; kc < 16; ++kc) acc = MFMA16(*(const LAS bf16x8*)(krow + 64 * kc), Qf[kc], acc);
                s[ch & 7][sb] = acc; }
            if (ch == 7) {
                float mx = -3.0e38f;
#pragma unroll
                for (int c = 0; c < 8; ++c)
#pragma unroll
                    for (int sb = 0; sb < 2; ++sb)
#pragma unroll
                        for (int j = 0; j < 4; ++j) mx = fmaxf(mx, s[c][sb][j]);
                mx = fmaxf(mx, __shfl_xor(mx, 16)); mx = fmaxf(mx, __shfl_xor(mx, 32));
                const float sc2 = 0.044194173824159216f * 1.4426950408889634f;
                float sum = 0.f;
#pragma unroll
                for (int c = 0; c < 8; ++c)
#pragma unroll
                    for (int sb = 0; sb < 2; ++sb)
#pragma unroll
                        for (int j = 0; j < 4; ++j) { const float p = exp2f((s[c][sb][j] - mx) * sc2); s[c][sb][j] = p; sum += p; }
                sum += __shfl_xor(sum, 16); sum += __shfl_xor(sum, 32);
                const float inv = 1.0f / sum;
#pragma unroll
                for (int c = 0; c < 8; ++c) Pf[c] = pack_bf8(s[c][0] * inv, s[c][1] * inv);
            }
        } else {
#pragma unroll
            for (int dl = 0; dl < 4; ++dl) { const LAS unsigned char* vrow = cb + (16 * dl + fr) * 528 + 16 * fq; f32x4 acc = (f32x4){0.f, 0.f, 0.f, 0.f};
#pragma unroll
                for (int c = 0; c < 8; ++c) acc = MFMA16(*(const LAS bf16x8*)(vrow + 64 * c), Pf[c], acc);
                v2u w; w.x = pk2(acc[0], acc[1]); w.y = pk2(acc[2], acc[3]);
                *(v2u*)(Ob + (size_t)m * DM + h * 512 + 64 * (ch - 8) + 16 * dl + 4 * fq) = w; }
        }
        if (ch + 1 < 16) AT_LSTORE(ch + 1, stg[(ch + 1) & 1]);
        __syncthreads();
    }
#undef AT_GLOAD
#undef AT_LSTORE
}
__device__ __forceinline__ void attn_sample_unit(Frame& F, int b, int h) {
    bf16* Ob = (bf16*)(F.ws + WS_OB);
    const float* CK = F.in[7]; const float* CV = F.in[8];
    const int lane = F.lane, fr = lane & 15, fq = lane >> 4, w = F.wave, tid = F.tid;
    LAS float* Pw = (LAS float*)F.lds + w * 128;
    LAS float* ML = (LAS float*)(F.lds + 4096);
    LAS float* red = (LAS float*)(F.lds + 8192);
    LAS bf16* qs = (LAS bf16*)(F.lds + 73728);
    { const float* PART = (const float*)(F.ws + WS_PART); const int q = tid >> 7, d4 = (tid & 127) * 4; f32x4 o = (f32x4){0.f, 0.f, 0.f, 0.f};
      f32x4 pv[8];
#pragma unroll
      for (int ks = 0; ks < 8; ++ks) pv[ks] = *(const f32x4*)(PART + ((size_t)ks * 512 + 4 * b + q) * DM + h * 512 + d4);
#pragma unroll
      for (int ks = 0; ks < 8; ++ks) o += pv[ks];
      v2u pw; pw.x = pk2(o[0], o[1]); pw.y = pk2(o[2], o[3]); *(LAS v2u*)(qs + q * 512 + d4) = pw; }
    __syncthreads();
    bf16x8 Qf[16];
#pragma unroll
    for (int kc = 0; kc < 16; ++kc) { const bf16x8 z = {0, 0, 0, 0, 0, 0, 0, 0};
        Qf[kc] = fr < 4 ? *(const LAS bf16x8*)(qs + fr * 512 + 32 * kc + 8 * fq) : z; }
    f32x4 sc[2];
#pragma unroll
    for (int tl = 0; tl < 2; ++tl) { const int mem = 32 * w + 16 * tl + fr; const float* krow = CK + (size_t)(b * NMEM + mem) * DM + h * 512 + 8 * fq; f32x4 acc = (f32x4){0.f, 0.f, 0.f, 0.f};
#pragma unroll
        for (int kc = 0; kc < 16; ++kc) acc = MFMA16(pack_bf8(ldnt4(krow + 32 * kc), ldnt4(krow + 32 * kc + 4)), Qf[kc], acc);
        sc[tl] = acc * 0.044194173824159216f; }
    float mx = fmaxf(fmaxf(fmaxf(sc[0][0], sc[0][1]), fmaxf(sc[0][2], sc[0][3])), fmaxf(fmaxf(sc[1][0], sc[1][1]), fmaxf(sc[1][2], sc[1][3])));
    mx = fmaxf(mx, __shfl_xor(mx, 16)); mx = fmaxf(mx, __shfl_xor(mx, 32));
    float ls = 0.f;
#pragma unroll
    for (int tl = 0; tl < 2; ++tl)
#pragma unroll
        for (int j = 0; j < 4; ++j) { const float p = __expf(sc[tl][j] - mx); sc[tl][j] = p; ls += p; }
    ls += __shfl_xor(ls, 16); ls += __shfl_xor(ls, 32);
    if (fr < 4) {
#pragma unroll
        for (int tl = 0; tl < 2; ++tl)
#pragma unroll
            for (int j = 0; j < 4; ++j) Pw[(16 * tl + 4 * fq + j) * 4 + fr] = sc[tl][j];
        if (fq == 0) { ML[(w * 4 + fr) * 2] = mx; ML[(w * 4 + fr) * 2 + 1] = ls; } }
    LDS_WAIT(); asm volatile("" ::: "memory");
    f32x4 a0[4], a1[4];
#pragma unroll
    for (int q = 0; q < 4; ++q) { a0[q] = (f32x4){0.f, 0.f, 0.f, 0.f}; a1[q] = a0[q]; }
#pragma unroll 2
    for (int i = 0; i < 32; ++i) { const int mem = 32 * w + i; const float* vrow = CV + (size_t)(b * NMEM + mem) * DM + h * 512;
        const f32x4 v0 = ldnt4(vrow + 4 * lane), v1 = ldnt4(vrow + 256 + 4 * lane); const f32x4 p4 = *(const LAS f32x4*)(Pw + i * 4);
#pragma unroll
        for (int q = 0; q < 4; ++q) { a0[q] += v0 * p4[q]; a1[q] += v1 * p4[q]; } }
#pragma unroll
    for (int q = 0; q < 4; ++q) { *(LAS f32x4*)(red + (w * 4 + q) * 512 + 4 * lane) = a0[q]; *(LAS f32x4*)(red + (w * 4 + q) * 512 + 256 + 4 * lane) = a1[q]; }
    __syncthreads();
    { const int q = tid >> 7, d4 = (tid & 127) * 4; float M = -3.0e38f;
#pragma unroll
      for (int ww = 0; ww < 8; ++ww) M = fmaxf(M, ML[(ww * 4 + q) * 2]);
      float L = 0.f; f32x4 o = (f32x4){0.f, 0.f, 0.f, 0.f};
#pragma unroll
      for (int ww = 0; ww < 8; ++ww) { const float e = __expf(ML[(ww * 4 + q) * 2] - M); L += ML[(ww * 4 + q) * 2 + 1] * e; o += *(const LAS f32x4*)(red + (ww * 4 + q) * 512 + d4) * e; }
      const float inv = 1.0f / L; o = o * inv;
      v2u pw; pw.x = pk2(o[0], o[1]); pw.y = pk2(o[2], o[3]);
      *(v2u*)(Ob + (size_t)(MP + 4 * b + q) * DM + h * 512 + d4) = pw; }
    __syncthreads();
}
__device__ __forceinline__ void p8_attn(Frame& F) {
#ifndef MK_ATT_SKIP
#define MK_ATT_SKIP 0
#endif
    for (int rp = 0; rp < (MK_REP == 80 ? 2 : 1); ++rp) for (int u = F.bid; u < 512; u += F.G) attn_sample_unit(F, u >> 2, u & 3);
    for (int rp = 0; rp < (MK_REP == 81 ? 2 : 1); ++rp) for (int u = F.bid; u < 256; u += F.G) attn_prompt_unit(F, u >> 6, (u >> 4) & 3, u & 15);
}

#define XB_TMO      128
#define XB_XCNT(j)  (256  + 64 * (j))
#define XB_XSUB(j)  (1280 + 64 * (j))
#define XB_XGEN(j)  (2304 + 64 * (j))
#define XB_TOP      3328
#define XB_TOPGEN   3392
#define XCD_BAR_WORDS 3456
#define XB_SPIN_CAP (1u << 18)

__device__ __forceinline__ unsigned xb_ld(unsigned* p)              { return __hip_atomic_load(p, __ATOMIC_RELAXED, __HIP_MEMORY_SCOPE_AGENT); }
__device__ __forceinline__ unsigned xb_add(unsigned* p, unsigned v) { return __hip_atomic_fetch_add(p, v, __ATOMIC_RELAXED, __HIP_MEMORY_SCOPE_AGENT); }
__device__ __forceinline__ unsigned xb_xcc_id() { return (unsigned)__builtin_amdgcn_s_getreg((3 << 11) | 20) & 0xFu; }
#define XB_SPIN(cond, bar) do { unsigned _sp = 0; while (cond) { __builtin_amdgcn_s_sleep(1); \
    if ((++_sp & 255u) == 0u) { if (xb_ld(&(bar)[XB_TMO])) break; if (_sp > XB_SPIN_CAP) { atomicAdd(&(bar)[XB_TMO], 1u); break; } } } } while (0)

struct XcdBarrier {
    unsigned* bar; unsigned x;
    volatile LAS unsigned* st;
};

__device__ __forceinline__ XcdBarrier xcd_barrier_post(unsigned* bar, volatile LAS unsigned* st) {
    XcdBarrier b; b.bar = bar; b.x = xb_xcc_id(); b.st = st;
    if (threadIdx.x == 0) (void)xb_add(&bar[XB_XCNT(b.x)], 1u);
    return b;
}
__device__ __forceinline__ void xcd_barrier_complete(unsigned* bar, unsigned x, unsigned& nloc, unsigned& nx) {
    const unsigned G = gridDim.x * gridDim.y * gridDim.z;
    unsigned sum, cnt, mine, sp = 0u;
    for (;;) {
        sum = 0u; cnt = 0u; mine = 0u;
#pragma unroll
        for (unsigned j = 0; j < 16; ++j) { const unsigned c = xb_ld(&bar[XB_XCNT(j)]); sum += c; cnt += (c > 0u) ? 1u : 0u; mine = (j == x) ? c : mine; }
        if (sum == G) break;
        __builtin_amdgcn_s_sleep(1);
        if ((++sp & 255u) == 0u) { if (xb_ld(&bar[XB_TMO])) break; if (sp > XB_SPIN_CAP) { atomicAdd(&bar[XB_TMO], 1u); break; } }
    }
    nloc = mine > 0u ? mine : 1u; nx = cnt > 0u ? cnt : 1u;
}

__device__ __forceinline__ void xcd_barrier(const XcdBarrier& b) {
    asm volatile("s_waitcnt vmcnt(0)" ::: "memory");
    __syncthreads();
    if (threadIdx.x == 0) {
        unsigned* bar = b.bar;
        __builtin_amdgcn_s_waitcnt(0);
        unsigned nloc = b.st[0], nx = b.st[1];
        if (nloc == 0u) { xcd_barrier_complete(bar, b.x, nloc, nx); b.st[0] = nloc; b.st[1] = nx; }
        const unsigned old = xb_add(&bar[XB_XSUB(b.x)], 1u);
        const unsigned gen = old / nloc;
        if (old + 1u == (gen + 1u) * nloc) {
            __builtin_amdgcn_fence(__ATOMIC_RELEASE, "agent");
            asm volatile("s_waitcnt vmcnt(0)" ::: "memory");
            const unsigned og = xb_add(&bar[XB_TOP], 1u);
            const unsigned tg = og / nx;
            if (og + 1u == (tg + 1u) * nx) xb_add(&bar[XB_TOPGEN], 1u);
            else XB_SPIN(xb_ld(&bar[XB_TOPGEN]) == tg, bar);
            __builtin_amdgcn_fence(__ATOMIC_ACQUIRE, "agent");
            xb_add(&bar[XB_XGEN(b.x)], 1u);
            asm volatile("s_waitcnt vmcnt(0)" ::: "memory");
        } else {
            XB_SPIN(xb_ld(&bar[XB_XGEN(b.x)]) == gen, bar);
            __builtin_amdgcn_fence(__ATOMIC_ACQUIRE, "agent");
            asm volatile("s_waitcnt vmcnt(0)" ::: "memory");
        }
    }
    __syncthreads();
}

template <bool COOP>
__global__ void __launch_bounds__(NTHR, 2) mk_fwd(Args args) {
    extern __shared__ __attribute__((aligned(16))) unsigned char lds_raw[];
    Frame F;
    F.lds = (LAS unsigned char*)lds_raw; F.MISC = (volatile LAS unsigned*)(F.lds + MISC_OFF);
    F.tid = threadIdx.x; F.lane = F.tid & 63; F.wave = __builtin_amdgcn_readfirstlane(F.tid >> 6); F.G = gridDim.x; F.bid = blockIdx.x;
    F.in = args.in; F.out = args.out; F.ws = args.ws;
    unsigned char* ws = args.ws;
    const int lo = args.lo, hi = args.hi, bid = F.bid, G = F.G;
#define IN(k) (lo <= (k) && (k) < hi)
    XcdBarrier bar; bar.bar = (unsigned*)(ws + WS_CTL) + 4096; bar.x = 0; bar.st = nullptr;
    if (COOP) { if (F.tid < 2) F.MISC[8 + F.tid] = 0u; __syncthreads(); bar = xcd_barrier_post((unsigned*)(ws + WS_CTL) + 4096, F.MISC + 8); }
    unsigned long long* tsb = (unsigned long long*)(ws + WS_CTL + 32768);
    if (MK_TS >= 0 && bid == 0 && F.tid == 0) tsb[0] = __builtin_amdgcn_s_memrealtime();
#define SEAM(k) do { if (COOP) { if (IN(k) && IN((k) + 1)) { if (lo < 0) cg::this_grid().sync(); else xcd_barrier(bar); } } \
        if (MK_TS >= 0 && bid == 0 && F.tid == 0) tsb[(k) + 1] = __builtin_amdgcn_s_memrealtime(); } while (0)
    using pg8::Gemm; using pg8::StaticOrder; using pg8::gemm_phase;
    bf16* XB = (bf16*)(ws + WS_XB); bf16* Hh = (bf16*)(ws + WS_H); bf16* R = (bf16*)(ws + WS_R); float* PART = (float*)(ws + WS_PART);

    if (IN(0)) for (int rep = 0; rep < (MK_REP == 0 ? 2 : 1); ++rep) { if (rep) xcd_barrier(bar); p0_prologue(F); } SEAM(0);
    if (IN(1)) for (int rep = 0; rep < (MK_REP == 1 ? 2 : 1); ++rep) { if (rep) xcd_barrier(bar);
        { Gemm g{XB, (const bf16*)(ws + WS_WIN), MT, DIN, DM}; StaticOrder S; S.init(MT, DIN, G, bid, DM); pg8::EpiBf16S E{Hh, DIN, nullptr};
          gemm_phase<pg8::EpiBf16S, StaticOrder, true, true>(F.lds, g, S, E); }
        { Gemm g{(const bf16*)(ws + WS_MB), (const bf16*)(ws + WS_WKV), 1024, 4096, DM}; StaticOrder S; S.init(1024, 4096, G, (bid + G - 66) % G, DM);
          pg8::EpiMemKV E{F.out + O_MK, F.out + O_MV, (bf16*)(ws + WS_KB)};
          gemm_phase<pg8::EpiMemKV, StaticOrder, true, true>(F.lds, g, S, E); }
        { Gemm g{(const bf16*)(ws + WS_WKV) + (size_t)2048 * DM, (const bf16*)(ws + WS_MB), 2048, 1024, DM}; StaticOrder S; S.init(2048, 1024, G, (bid + G - 130) % G, DM);
          pg8::EpiBf16S E{(bf16*)(ws + WS_VTB), 1024, nullptr};
          gemm_phase<pg8::EpiBf16S, StaticOrder, true, true>(F.lds, g, S, E); }
    } SEAM(1);
    if (IN(2)) for (int rep = 0; rep < (MK_REP == 2 ? 2 : 1); ++rep) { if (rep) xcd_barrier(bar); p2_prep(F); } SEAM(2);
    if (IN(3)) for (int rep = 0; rep < (MK_REP == 3 ? 2 : 1); ++rep) { if (rep) xcd_barrier(bar); p3_scans(F, rep); } SEAM(3);
    if (IN(4)) for (int rep = 0; rep < (MK_REP == 4 ? 2 : 1); ++rep) { if (rep) xcd_barrier(bar);
        { Gemm g{(const bf16*)(ws + WS_YGB), (const bf16*)(ws + WS_WGLU), MT, DSSM, DSSM}; StaticOrder S; S.init(MT, DSSM, G, bid, DSSM);
          pg8::EpiGlu E{(const bf16*)(ws + WS_YGB), 1024, F.in[19], (bf16*)(ws + WS_MIX), 2048};
          gemm_phase<pg8::EpiGlu, StaticOrder, true, true>(F.lds, g, S, E); }
        p4_post(F, rep);
    } SEAM(4);
    if (IN(5)) for (int rep = 0; rep < (MK_REP == 5 ? 2 : 1); ++rep) { if (rep) xcd_barrier(bar); Gemm g{(const bf16*)(ws + WS_MIX), (const bf16*)(ws + WS_WOUT), MT, DM, DM}; pg8::MixOrder S; S.init(MP, DM, G, bid, DM, 8, 256);
        pg8::EpiRes E{F.in[0], F.in[1], nullptr, R, DM, ALPHA, PART};
        gemm_phase<pg8::EpiRes, pg8::MixOrder, true, true>(F.lds, g, S, E); } SEAM(5);
    if (IN(6)) for (int rep = 0; rep < (MK_REP == 6 ? 2 : 1); ++rep) { if (rep) xcd_barrier(bar); ln_rows(F, R, F.in[32], F.in[33], nullptr, XB, F.in[1], nullptr, PART, 8); } SEAM(6);
    if (IN(7)) for (int rep = 0; rep < (MK_REP == 7 ? 2 : 1); ++rep) { if (rep) xcd_barrier(bar); Gemm g{XB, (const bf16*)(ws + WS_WQ), MT, DM, DM}; pg8::MixOrder S; S.init(MP, DM, G, bid, DM, 8, 256);
        pg8::EpiBf16S E{(bf16*)(ws + WS_QB), DM, PART};
        gemm_phase<pg8::EpiBf16S, pg8::MixOrder, true, true>(F.lds, g, S, E); } SEAM(7);
    if (IN(8)) for (int rep = 0; rep < (MK_REP == 8 ? 2 : 1); ++rep) { if (rep) xcd_barrier(bar); p8_attn(F); } SEAM(8);
    if (IN(9)) for (int rep = 0; rep < (MK_REP == 9 ? 2 : 1); ++rep) { if (rep) xcd_barrier(bar); Gemm g{(const bf16*)(ws + WS_OB), (const bf16*)(ws + WS_WO), MT, DM, DM}; pg8::MixOrder S; S.init(MP, DM, G, bid, DM, 8, 256);
        pg8::EpiRes E{nullptr, nullptr, XB, R, DM, ALPHA, PART};
        gemm_phase<pg8::EpiRes, pg8::MixOrder, true, true>(F.lds, g, S, E); } SEAM(9);
    if (IN(10)) for (int rep = 0; rep < (MK_REP == 10 ? 2 : 1); ++rep) { if (rep) xcd_barrier(bar); ln_rows(F, R, F.in[38], F.in[39], nullptr, XB, nullptr, XB + (size_t)MP * DM, PART, 8); } SEAM(10);
    if (IN(11)) for (int rep = 0; rep < (MK_REP == 11 ? 2 : 1); ++rep) { if (rep) xcd_barrier(bar); Gemm g{XB, (const bf16*)(ws + WS_WGU), MT, 2 * DFF, DM}; StaticOrder S; S.init(MT, 2 * DFF, G, bid, DM);
        pg8::EpiSwiGLU E{(bf16*)(ws + WS_HFF), DFF};
        gemm_phase<pg8::EpiSwiGLU, StaticOrder, true, true>(F.lds, g, S, E); } SEAM(11);
    if (IN(12)) for (int rep = 0; rep < (MK_REP == 12 ? 2 : 1); ++rep) { if (rep) xcd_barrier(bar); Gemm g{(const bf16*)(ws + WS_HFF), (const bf16*)(ws + WS_WDN), MT, DM, DFF}; pg8::MixOrder S; S.init(MP, DM, G, bid, DFF, 11, 512);
        pg8::EpiRes E{nullptr, nullptr, XB, R, DM, ALPHA, PART};
        gemm_phase<pg8::EpiRes, pg8::MixOrder, true, true>(F.lds, g, S, E); } SEAM(12);
    if (IN(13)) for (int rep = 0; rep < (MK_REP == 13 ? 2 : 1); ++rep) { if (rep) xcd_barrier(bar); ln_rows(F, R, F.in[43], F.in[44], F.out + O_Y, nullptr, nullptr, XB + (size_t)MP * DM, PART, 11); }
    if (MK_TS >= 0 && bid == 0) {
        if (F.tid == 0) tsb[NPHASE] = __builtin_amdgcn_s_memrealtime();
        __syncthreads();
        const int k0 = MK_TS >= 200 ? 3 : (MK_TS >= 100 ? 0 : MK_TS), k1 = MK_TS >= 200 ? MK_TS - 183 : (MK_TS >= 100 ? NPHASE : MK_TS + 1);
        const float t_us = (float)(tsb[k1] - tsb[k0]) * 0.01f; const float sc = 1.0f + sqrtf(t_us * 1e-6f);
        for (int i = F.tid; i < 16384; i += NTHR) F.out[O_SRE_P + i] *= sc; }
#undef IN
#undef SEAM
}

#ifndef MK_COOP
#define MK_COOP 0
#endif
#ifndef MK_PH_HI
#define MK_PH_HI NPHASE
#endif
extern "C" void kernel_launch(void* const* d_in, const int* in_sizes, int n_in, void* d_out, int out_size, void* d_ws, size_t ws_size, hipStream_t stream) {
    static int grid = 0;
    if (grid == 0) {
        if (n_in != 45 || out_size != (int)O_END || ws_size < WS_END) { fprintf(stderr, "kernel_launch: unexpected shapes (n_in %d out %d ws %zu)\n", n_in, out_size, ws_size); grid = -1; return; }
        int dev = 0, cus = 0, per_cu = 0;
        (void)hipGetDevice(&dev); (void)hipDeviceGetAttribute(&cus, hipDeviceAttributeMultiprocessorCount, dev);
        (void)hipFuncSetAttribute((const void*)mk_fwd<(MK_COOP != 0)>, hipFuncAttributeMaxDynamicSharedMemorySize, LDS_BYTES);
        (void)hipOccupancyMaxActiveBlocksPerMultiprocessor(&per_cu, (const void*)mk_fwd<(MK_COOP != 0)>, NTHR, LDS_BYTES);
        (void)hipGetLastError();
        if (per_cu < 1) { fprintf(stderr, "kernel_launch: occupancy query says %d blocks per CU\n", per_cu); per_cu = 1; }
        grid = cus;
    }
    if (grid < 0) return;
    (void)hipMemsetAsync((char*)d_ws + WS_CTL, 0, 65536, stream);
    if (MK_PH_HI < NPHASE) (void)hipMemsetAsync(d_out, 0, (size_t)out_size * 4, stream);
#ifdef MK_DUMP_OFF
#ifndef MK_DUMP_BYTES
#define MK_DUMP_BYTES ((size_t)MT * DM * 4)
#endif
#define MK_DUMP_AFTER (void)hipMemcpyAsync(d_out, (char*)d_ws + (MK_DUMP_OFF), MK_DUMP_BYTES, hipMemcpyDeviceToDevice, stream);
#else
#define MK_DUMP_AFTER
#endif
    Args a{};
    for (int i = 0; i < 45; ++i) a.in[i] = (const float*)d_in[i];
    a.out = (float*)d_out; a.ws = (unsigned char*)d_ws;
#if MK_COOP
    a.lo = 0; a.hi = MK_PH_HI;
    void* kargs[] = {&a};
    hipError_t e = hipLaunchCooperativeKernel((const void*)mk_fwd<true>, dim3(grid), dim3(NTHR), kargs, LDS_BYTES, stream);
    if (e != hipSuccess) fprintf(stderr, "cooperative launch failed: %s (grid %d)\n", hipGetErrorString(e), grid);
#else
    for (int p = 0; p < MK_PH_HI; ++p) { a.lo = p; a.hi = p + 1; hipLaunchKernelGGL(mk_fwd<false>, dim3(grid), dim3(NTHR), LDS_BYTES, stream, a); }
#endif
    MK_DUMP_AFTER
}
```
